# Optimizing an MI355X kernel written in HIP

```python
import jax, jax.numpy as jnp
from jax import lax
import numpy as np

D_MODEL = 1024
BATCH = 8
SEQ = 4096
DEPTH = 1
DEC_BATCH = 4
DEC_SEQ = 4096
PAST_LEN = 128

HEAD_DIM = 64
GRID_W = 64
NA_HEADS = 8
NA_KH = 8
NA_KW = 16
NA_WIDTH = NA_HEADS * HEAD_DIM
SW_HEADS = 8
SW_KV_HEADS = 2
SW_GROUP = SW_HEADS // SW_KV_HEADS
SW_WIDTH = SW_HEADS * HEAD_DIM
SW_KV_WIDTH = SW_KV_HEADS * HEAD_DIM
WINDOW = 128
WIN_BLOCK = 128
ROPE_THETA = 10000.0
NORM_EPS = 1e-6
SPLIT_SIZES = (NA_WIDTH, NA_WIDTH, NA_WIDTH, NA_WIDTH,
               SW_WIDTH, SW_KV_WIDTH, SW_KV_WIDTH, SW_WIDTH,
               D_MODEL, D_MODEL)
IN_WIDTH = sum(SPLIT_SIZES)

kernel_name = "hybrid_na_swa_gated_encoder"


def rms_norm(x, g):
    xf = x.astype(jnp.float32)
    y = xf * lax.rsqrt(jnp.mean(xf * xf, axis=-1, keepdims=True) + NORM_EPS)
    return (y * g.astype(jnp.float32)).astype(x.dtype)


def rotary(x):
    S, d = x.shape[1], x.shape[-1]
    half = d // 2
    inv = ROPE_THETA ** (-jnp.arange(half, dtype=jnp.float32) / half)
    ang = jnp.arange(S, dtype=jnp.float32)[:, None] * inv[None, :]
    cos = jnp.cos(ang)[None, :, None, :]
    sin = jnp.sin(ang)[None, :, None, :]
    xf = x.astype(jnp.float32)
    x1, x2 = xf[..., :half], xf[..., half:]
    out = jnp.concatenate([x1 * cos - x2 * sin, x2 * cos + x1 * sin], axis=-1)
    return out.astype(x.dtype)


def neighbourhood_attention(q, k, v, rpb):
    B, S, H, d = q.shape
    rows = S // GRID_W
    kh = min(NA_KH, rows)
    r = jnp.arange(rows)
    krow = jnp.clip(r - kh // 2, 0, rows - kh)[:, None] + jnp.arange(kh)[None, :]
    c = jnp.arange(GRID_W)
    cs = jnp.clip(c - NA_KW // 2, 0, GRID_W - NA_KW)
    col_in = (c[None, :] >= cs[:, None]) & (c[None, :] < cs[:, None] + NA_KW)
    dr = krow - r[:, None] + (NA_KH - 1)
    dc = jnp.clip(c[None, :] - c[:, None], -(NA_KW - 1), NA_KW - 1) + (NA_KW - 1)
    bias = rpb[:, dr[:, None, :, None], dc[None, :, None, :]].astype(jnp.float32)
    q5 = q.reshape(B, rows, GRID_W, H, d)
    kg = k.reshape(B, rows, GRID_W, H, d)[:, krow]
    vg = v.reshape(B, rows, GRID_W, H, d)[:, krow]
    s = jnp.einsum('brqhd,brkwhd->bhrqkw', q5, kg).astype(jnp.float32) * (d ** -0.5)
    s = s + bias[None]
    s = jnp.where(col_in[:, None, :], s, -jnp.inf)
    p = jax.nn.softmax(s, axis=(-2, -1))
    o = jnp.einsum('bhrqkw,brkwhd->brqhd', p.astype(v.dtype), vg)
    return o.reshape(B, S, H * d)


def window_attention(q, k, v, sink):
    B, S, H, d = q.shape
    kvh = k.shape[2]
    g = H // kvh
    nb = S // WIN_BLOCK
    pad = ((0, 0), (WIN_BLOCK, WIN_BLOCK), (0, 0), (0, 0))
    kp = jnp.pad(k, pad).reshape(B, nb + 2, WIN_BLOCK, kvh, d)
    vp = jnp.pad(v, pad).reshape(B, nb + 2, WIN_BLOCK, kvh, d)
    kb = jnp.concatenate([kp[:, :-2], kp[:, 1:-1], kp[:, 2:]], axis=2)
    vb = jnp.concatenate([vp[:, :-2], vp[:, 1:-1], vp[:, 2:]], axis=2)
    qb = q.reshape(B, nb, WIN_BLOCK, kvh, g, d)
    s = jnp.einsum('bnqkgd,bnckd->bnkgqc', qb, kb).astype(jnp.float32) * (d ** -0.5)
    qi = jnp.arange(WIN_BLOCK)
    kj = jnp.arange(3 * WIN_BLOCK)
    rel = kj[None, :] - WIN_BLOCK - qi[:, None]
    kpos = jnp.arange(nb)[:, None] * WIN_BLOCK + kj[None, :] - WIN_BLOCK
    mask = (jnp.abs(rel) <= WINDOW)[None] & ((kpos >= 0) & (kpos < S))[:, None, :]
    s = jnp.where(mask[None, :, None, None], s, -jnp.inf)
    sk = sink.reshape(kvh, g).astype(jnp.float32)[None, None, :, :, None, None]
    m = jnp.maximum(jnp.max(s, axis=-1, keepdims=True), sk)
    p = jnp.exp(s - m)
    l = jnp.sum(p, axis=-1, keepdims=True) + jnp.exp(sk - m)
    o = jnp.einsum('bnkgqc,bnckd->bnqkgd', (p / l).astype(v.dtype), vb)
    return o.reshape(B, S, H * d)


def layer(x, norm_g, w_in, qn_a, kn_a, rpb_a, qn_b, kn_b, sink_b, w_out_a, w_out_b, w_o):
    B, S, _ = x.shape
    h = rms_norm(x, norm_g)
    proj = h @ w_in
    offsets = []
    acc = 0
    for n in SPLIT_SIZES[:-1]:
        acc += n
        offsets.append(acc)
    q_a, k_a, v_a, z_a, q_b, k_b, v_b, z_b, g_a, g_b = jnp.split(proj, offsets, axis=-1)
    q_a = rms_norm(q_a.reshape(B, S, NA_HEADS, HEAD_DIM), qn_a)
    k_a = rms_norm(k_a.reshape(B, S, NA_HEADS, HEAD_DIM), kn_a)
    v_a = v_a.reshape(B, S, NA_HEADS, HEAD_DIM)
    y_a = neighbourhood_attention(q_a, k_a, v_a, rpb_a) * jax.nn.silu(z_a)
    q_b = rotary(rms_norm(q_b.reshape(B, S, SW_HEADS, HEAD_DIM), qn_b))
    k_b = rotary(rms_norm(k_b.reshape(B, S, SW_KV_HEADS, HEAD_DIM), kn_b))
    v_b = v_b.reshape(B, S, SW_KV_HEADS, HEAD_DIM)
    y_b = window_attention(q_b, k_b, v_b, sink_b) * jax.nn.silu(z_b)
    merged = jax.nn.sigmoid(g_a) * (y_a @ w_out_a) + jax.nn.sigmoid(g_b) * (y_b @ w_out_b)
    return x + merged @ w_o


def setup_inputs(seed: int = 0) -> dict:
    key = jax.random.key(seed)
    ks = jax.random.split(key, 14)
    f = jnp.float32
    return {
        "x_prompt": jax.random.normal(ks[0], (BATCH, SEQ, D_MODEL), f),
        "x_sample": jax.random.normal(ks[1], (DEC_BATCH, DEC_SEQ, D_MODEL), f),
        "norm_g": 1.0 + 0.05 * jax.random.normal(ks[2], (DEPTH, D_MODEL), f),
        "w_in": jax.random.normal(ks[3], (DEPTH, D_MODEL, IN_WIDTH), f) * D_MODEL ** -0.5,
        "qn_a": 1.0 + 0.05 * jax.random.normal(ks[4], (DEPTH, HEAD_DIM), f),
        "kn_a": 1.0 + 0.05 * jax.random.normal(ks[5], (DEPTH, HEAD_DIM), f),
        "rpb_a": 0.1 * jax.random.normal(ks[6], (DEPTH, NA_HEADS, 2 * NA_KH - 1, 2 * NA_KW - 1), f),
        "qn_b": 1.0 + 0.05 * jax.random.normal(ks[7], (DEPTH, HEAD_DIM), f),
        "kn_b": 1.0 + 0.05 * jax.random.normal(ks[8], (DEPTH, HEAD_DIM), f),
        "sink_b": 0.5 * jax.random.normal(ks[9], (DEPTH, SW_HEADS), f),
        "w_out_a": jax.random.normal(ks[10], (DEPTH, NA_WIDTH, D_MODEL), f) * NA_WIDTH ** -0.5,
        "w_out_b": jax.random.normal(ks[11], (DEPTH, SW_WIDTH, D_MODEL), f) * SW_WIDTH ** -0.5,
        "w_o": jax.random.normal(ks[12], (DEPTH, D_MODEL, D_MODEL), f) * D_MODEL ** -0.5,
    }


def reference(x_prompt, x_sample, norm_g, w_in, qn_a, kn_a, rpb_a, qn_b, kn_b, sink_b, w_out_a, w_out_b, w_o):
    y_prompt = x_prompt
    y_sample = x_sample
    for l in range(DEPTH):
        y_prompt = layer(y_prompt, norm_g[l], w_in[l], qn_a[l], kn_a[l], rpb_a[l], qn_b[l], kn_b[l],
                         sink_b[l], w_out_a[l], w_out_b[l], w_o[l])
        y_sample = layer(y_sample, norm_g[l], w_in[l], qn_a[l], kn_a[l], rpb_a[l], qn_b[l], kn_b[l],
                         sink_b[l], w_out_a[l], w_out_b[l], w_o[l])
    return (y_prompt, y_sample)
```

```cpp
#include <hip/hip_runtime.h>
#include <hip/hip_cooperative_groups.h>
#include <cstdio>
namespace cg = cooperative_groups;

#ifndef N_LAUNCHES
#define N_LAUNCHES 1
#endif

#define LAS __attribute__((address_space(3)))
typedef unsigned short bf16_t;
typedef short bf16x8 __attribute__((ext_vector_type(8)));
typedef short bf16x4 __attribute__((ext_vector_type(4)));
typedef float f32x4 __attribute__((ext_vector_type(4)));
typedef unsigned u32x4 __attribute__((ext_vector_type(4)));
typedef unsigned u32x2 __attribute__((ext_vector_type(2)));

constexpr int T = 49152, TP = 32768, D = 1024, NIN = 5376, SEQ = 4096;
constexpr float LOG2E = 1.4426950408889634f;
constexpr float QSCALE = 0.125f * LOG2E;
constexpr float NORM_EPS = 1e-6f;
constexpr size_t MiB = 1u << 20;
constexpr size_t WS_WIN = 0, WS_WAB = 11 * MiB, WS_WO = 13 * MiB, WS_ROPE = 15 * MiB, WS_XB = 17 * MiB, WS_QA = 113 * MiB, WS_KA = 161 * MiB, WS_QB = 209 * MiB,
                 WS_ZA = 257 * MiB, WS_ZB = 305 * MiB, WS_VAT = 353 * MiB, WS_KB = 401 * MiB, WS_VBT = 413 * MiB, WS_END = 425 * MiB;
constexpr size_t WS_CTL = 11 * MiB - 65536, CTL_BYTES = 16384;
constexpr size_t WS_Y = WS_XB;
constexpr size_t WS_MG = WS_QA;
constexpr int LDS_BYTES = 155648;

typedef __bf16 bf16x2_t __attribute__((ext_vector_type(2)));
typedef float f32x2_t __attribute__((ext_vector_type(2)));
__device__ __forceinline__ unsigned cvt_pk_bf16(float lo, float hi) { const f32x2_t v = {lo, hi}; const bf16x2_t r = __builtin_convertvector(v, bf16x2_t); return __builtin_bit_cast(unsigned, r); }
__device__ __forceinline__ float bf_lo(unsigned w) { return __uint_as_float(w << 16); }
__device__ __forceinline__ float bf_hi(unsigned w) { return __uint_as_float(w & 0xffff0000u); }
__device__ __forceinline__ float fast_sigmoid(float v) { return __builtin_amdgcn_rcpf(1.0f + __builtin_amdgcn_exp2f(-v * LOG2E)); }

namespace pg8 {
constexpr int BM = 256, BK = 64, HALF = 128, HTB = HALF * BK * 2, STAGE_BYTES = 8 * HTB, NXCD = 8, WGM = 8, K = 1024;
__device__ __forceinline__ int lds_byte(int r, int c) { const int st = (r >> 4) * 2 + (c >> 5), rr = r & 15, cc = c & 31, ob = rr * 64 + cc * 2; return st * 1024 + (ob ^ (((ob >> 9) & 1) << 5)); }
__device__ __forceinline__ void stage_rc(int b, int& R, int& C) { const int st = b / 1024, sb = b % 1024, swz = sb ^ (((sb >> 9) & 1) << 5); R = (st >> 1) * 16 + swz / 64; C = (st & 1) * 32 + (swz % 64) / 2; }
__device__ __forceinline__ int perm32(int rho) { const int n = rho >> 4, i = rho & 15; return 8 * (i >> 2) + 4 * n + (i & 3); }
struct Unit { int pm, pn; };
struct StaticOrder {
    int nM, nN, nwg, G, c;
    __device__ void init(int M, int N, int G_, int c_) { nM = M / BM; nN = N / BM; nwg = nM * nN; G = G_; c = c_; }
    __device__ bool next(int i, Unit& u) const {
        const long L = (long)i * G + c; if (L >= nwg) return false;
        int wgid = (int)L; { const int q = nwg / NXCD, r = nwg % NXCD, xcd = wgid % NXCD, off = wgid / NXCD; wgid = (xcd < r ? xcd * (q + 1) : r * (q + 1) + (xcd - r) * q) + off; }
        const int nig = WGM * nN, gid = wgid / nig, fm = gid * WGM, gsz = (nM - fm) < WGM ? (nM - fm) : WGM;
        u.pm = fm + ((wgid % nig) % gsz); u.pn = (wgid % nig) / gsz; return true;
    }
};
template <class Epi, class Sched>
__device__ __forceinline__ void gemm_phase(LAS unsigned char* lds, const Sched& S, const Epi& E, bool natural = false) {
    const int tid = threadIdx.x, wid = __builtin_amdgcn_readfirstlane(tid >> 6), lane = tid & 63, wr = wid >> 2, wc = wid & 3, fr = lane & 15, fq = lane >> 4;
    constexpr int nt = K / BK;
    unsigned voffA[2], voffB0[2], voffB1[2];
#pragma unroll
    for (int i = 0; i < 2; ++i) { int R, C; stage_rc(tid * 16 + i * 8192, R, C);
        const int Rb = 64 * (R >> 5) + (natural ? (R & 31) : perm32(R & 31));
        voffA[i] = (unsigned)(R * K + C) * 2u; voffB0[i] = (unsigned)(Rb * K + C) * 2u; voffB1[i] = (unsigned)((Rb + 32) * K + C) * 2u; }
    constexpr size_t kstep = (size_t)(BK * 2);
    constexpr size_t hstep = (size_t)HALF * K * 2;
    const unsigned ldsw = (unsigned)wid * 1024u;
    const int aoff = lds_byte(wr * 64 + fr, fq * 8), boff = lds_byte(wc * 32 + fr, fq * 8);
#define PG8_SA(b, h) (((b) * 2 + (h)) * HTB)
#define PG8_SB(b, h) ((4 + (b) * 2 + (h)) * HTB)
#define PG8_STAGE(bufoff, gbase, voff) do { _Pragma("unroll") for (int _i = 0; _i < 2; ++_i) \
        __builtin_amdgcn_global_load_lds((const unsigned*)((const char*)(gbase) + (voff)[_i]), (LAS unsigned*)(lds + (bufoff) + ldsw + _i * 8192), 16, 0, 0); } while (0)
#define PG8_LDA(dst, b, h) do { _Pragma("unroll") for (int m = 0; m < 4; ++m) _Pragma("unroll") for (int k = 0; k < 2; ++k) dst[m][k] = *(const LAS bf16x8*)(lds + PG8_SA(b, h) + aoff + m * 2048 + k * 1024); } while (0)
#define PG8_LDB(dst, b, h) do { _Pragma("unroll") for (int n = 0; n < 2; ++n) _Pragma("unroll") for (int k = 0; k < 2; ++k) dst[n][k] = *(const LAS bf16x8*)(lds + PG8_SB(b, h) + boff + n * 2048 + k * 1024); } while (0)
#define PG8_MMA(ai, bj, At, Bt) do { __builtin_amdgcn_s_setprio(1); _Pragma("unroll") for (int m = 0; m < 4; ++m) _Pragma("unroll") for (int n = 0; n < 2; ++n) _Pragma("unroll") for (int k = 0; k < 2; ++k) \
        acc[ai][bj][m][n] = __builtin_amdgcn_mfma_f32_16x16x32_bf16(Bt[n][k], At[m][k], acc[ai][bj][m][n], 0, 0, 0); __builtin_amdgcn_s_setprio(0); } while (0)
#define PG8_WAIT_V(n) asm volatile("s_waitcnt vmcnt(" #n ")" ::: "memory")
#define PG8_WAIT_L(n) asm volatile("s_waitcnt lgkmcnt(" #n ")" ::: "memory")
#define PG8_BAR __builtin_amdgcn_s_barrier()
#define PG8_SCHED __builtin_amdgcn_sched_barrier(0)
    Unit cur, nxt; int ui = 0;
    if (!S.next(0, cur)) return;
    f32x4 acc[2][2][4][2];
#pragma unroll
    for (int a = 0; a < 2; ++a)
#pragma unroll
        for (int b = 0; b < 2; ++b)
#pragma unroll
            for (int m = 0; m < 4; ++m)
#pragma unroll
                for (int n = 0; n < 2; ++n) acc[a][b][m][n] = (f32x4){0.f, 0.f, 0.f, 0.f};
    bf16x8 At[4][2], B0[2][2], B1[2][2];
    const char* cA; const char* cB; S.ptrs(cur, cA, cB);
    PG8_STAGE(PG8_SB(0, 0), cB, voffB0); PG8_STAGE(PG8_SB(0, 1), cB, voffB1); PG8_STAGE(PG8_SA(0, 0), cA, voffA); PG8_STAGE(PG8_SA(0, 1), cA + hstep, voffA);
    if (wr == 1) PG8_BAR;
    PG8_WAIT_V(2); PG8_BAR;
    PG8_STAGE(PG8_SB(1, 0), cB + kstep, voffB0); PG8_STAGE(PG8_SA(1, 0), cA + kstep, voffA); PG8_STAGE(PG8_SB(1, 1), cB + kstep, voffB1);
    PG8_WAIT_V(6); PG8_BAR;
    for (;;) {
        const bool has_next = S.next(ui + 1, nxt);
        const char* nA = cA; const char* nB = cB; if (has_next) S.ptrs(nxt, nA, nB);
        for (int t = 0; t < nt; t += 2) {
            const bool last = (t == nt - 2);
            const char* a1 = cA + (size_t)(t + 1) * kstep;
            const char* a2 = last ? nA : cA + (size_t)(t + 2) * kstep; const char* b2 = last ? nB : cB + (size_t)(t + 2) * kstep;
            const char* a3 = a2 + kstep; const char* b3 = b2 + kstep;
            if constexpr (Epi::MIDHOOK) { if (t == nt / 2) E.mid(acc, cur, wr, wc, fr, fq); }
            PG8_LDB(B0, 0, 0); PG8_LDB(B1, 0, 1); PG8_SCHED; PG8_LDA(At, 0, 0); PG8_STAGE(PG8_SA(1, 1), a1 + hstep, voffA);
            PG8_WAIT_V(8); PG8_WAIT_L(0); PG8_BAR; PG8_MMA(0, 0, At, B0); PG8_MMA(0, 1, At, B1); PG8_BAR; PG8_SCHED;
            PG8_LDA(At, 0, 1); PG8_STAGE(PG8_SB(0, 0), b2, voffB0); PG8_STAGE(PG8_SB(0, 1), b2, voffB1); PG8_STAGE(PG8_SA(0, 0), a2, voffA);
            PG8_WAIT_V(8); PG8_WAIT_L(0); PG8_BAR; PG8_MMA(1, 0, At, B0); PG8_MMA(1, 1, At, B1); PG8_BAR; PG8_SCHED;
            PG8_LDB(B0, 1, 0); PG8_LDB(B1, 1, 1); PG8_SCHED; PG8_LDA(At, 1, 0); PG8_STAGE(PG8_SA(0, 1), a2 + hstep, voffA);
            PG8_WAIT_V(8); PG8_WAIT_L(0); PG8_BAR; PG8_MMA(0, 0, At, B0); PG8_MMA(0, 1, At, B1); PG8_BAR; PG8_SCHED;
            PG8_LDA(At, 1, 1); PG8_STAGE(PG8_SB(1, 0), b3, voffB0); PG8_STAGE(PG8_SB(1, 1), b3, voffB1); PG8_STAGE(PG8_SA(1, 0), a3, voffA);
            PG8_WAIT_V(8); PG8_WAIT_L(0); PG8_BAR; PG8_MMA(1, 0, At, B0); PG8_MMA(1, 1, At, B1); PG8_BAR; PG8_SCHED;
        }
        if (wr == 0) PG8_BAR;
        E(acc, cur, wr, wc, fr, fq);
        if (!has_next) break;
#pragma unroll
        for (int a = 0; a < 2; ++a)
#pragma unroll
            for (int b = 0; b < 2; ++b)
#pragma unroll
                for (int m = 0; m < 4; ++m)
#pragma unroll
                    for (int n = 0; n < 2; ++n) acc[a][b][m][n] = (f32x4){0.f, 0.f, 0.f, 0.f};
        cur = nxt; cA = nA; cB = nB; ++ui;
        if (wr == 1) PG8_BAR;
    }
    PG8_WAIT_V(0);
    PG8_BAR;
#undef PG8_SA
#undef PG8_SB
#undef PG8_STAGE
#undef PG8_LDA
#undef PG8_LDB
#undef PG8_MMA
#undef PG8_WAIT_V
#undef PG8_WAIT_L
#undef PG8_BAR
#undef PG8_SCHED
}
}
using pg8::Unit;
typedef f32x4 AccT[2][2][4][2];

__device__ const float ROPE_IREV[32] = {1.591549367e-01f, 1.193493679e-01f, 8.949939907e-02f, 6.711508334e-02f, 5.032921210e-02f, 3.774158657e-02f, 2.830219641e-02f, 2.122365311e-02f,
    1.591549441e-02f, 1.193493698e-02f, 8.949940093e-03f, 6.711508147e-03f, 5.032920744e-03f, 3.774158657e-03f, 2.830219688e-03f, 2.122365171e-03f,
    1.591549371e-03f, 1.193493721e-03f, 8.949940093e-04f, 6.711508031e-04f, 5.032921326e-04f, 3.774158540e-04f, 2.830219746e-04f, 2.122365258e-04f,
    1.591549517e-04f, 1.193493663e-04f, 8.949940093e-05f, 6.711508468e-05f, 5.032921035e-05f, 3.774158540e-05f, 2.830219637e-05f, 2.122365368e-05f};
struct SchedA : pg8::StaticOrder {
    const char* XB; const char* W;
    __device__ __forceinline__ void ptrs(const Unit& u, const char*& cA, const char*& cB) const {
        const char* x = XB + (size_t)u.pm * (256 * 1024 * 2); const char* w = W + (size_t)u.pn * (256 * 1024 * 2);
        if (u.pn >= 19) { cA = w; cB = x; } else { cA = x; cB = w; }
    }
};
struct SchedP : pg8::StaticOrder {
    const char* A; const char* W;
    __device__ __forceinline__ void ptrs(const Unit& u, const char*& cA, const char*& cB) const { cA = A + (size_t)u.pm * (256 * 1024 * 2); cB = W + (size_t)u.pn * (256 * 1024 * 2); }
};

struct EpiA {
    static constexpr bool MIDHOOK = false;
    unsigned char* ws; bf16_t* GA;
    const float *qn_a, *kn_a, *qn_b, *kn_b;
    __device__ __forceinline__ void mid(AccT&, const Unit&, int, int, int, int) const {}
    __device__ __forceinline__ void qk(const AccT& acc, int row0, int wr, int fr, int fq, bf16_t* dst, int ld, int colh, const float* w, float scale, bool rope) const {
        f32x4 wv[2][2];
        int fq8 = 8 * fq; asm volatile("" : "+v"(fq8));
#pragma unroll
        for (int bj = 0; bj < 2; ++bj)
#pragma unroll
            for (int n = 0; n < 2; ++n) wv[bj][n] = *(const f32x4*)(w + 32 * bj + fq8 + 4 * n) * scale;
        f32x4 irev[2];
#pragma unroll
        for (int n = 0; n < 2; ++n) irev[n] = rope ? *(const f32x4*)(ROPE_IREV + fq8 + 4 * n) : (f32x4){0.f, 0.f, 0.f, 0.f};
#pragma unroll
        for (int ai = 0; ai < 2; ++ai)
#pragma unroll
            for (int m = 0; m < 4; ++m) {
                const int r = row0 + 128 * ai + 64 * wr + 16 * m + fr;
                f32x4 v[2][2]; float ss = 0.f;
#pragma unroll
                for (int bj = 0; bj < 2; ++bj)
#pragma unroll
                    for (int n = 0; n < 2; ++n) { v[bj][n] = acc[ai][bj][m][n]; const f32x4 x = v[bj][n]; ss += (x[0] * x[0] + x[1] * x[1]) + (x[2] * x[2] + x[3] * x[3]); }
                ss += __shfl_xor(ss, 16); ss += __shfl_xor(ss, 32);
                const float inv = __builtin_amdgcn_rsqf(ss * (1.0f / 64.0f) + NORM_EPS);
#pragma unroll
                for (int bj = 0; bj < 2; ++bj)
#pragma unroll
                    for (int n = 0; n < 2; ++n) v[bj][n] = v[bj][n] * inv * wv[bj][n];
                if (rope) {
                    const float fp = (float)(r & (SEQ - 1));
#pragma unroll
                    for (int n = 0; n < 2; ++n) {
                        f32x4 c, s;
#pragma unroll
                        for (int j = 0; j < 4; ++j) { const float fr_ = __builtin_amdgcn_fractf(fp * irev[n][j]); c[j] = __builtin_amdgcn_cosf(fr_); s[j] = __builtin_amdgcn_sinf(fr_); }
                        const f32x4 x1 = v[0][n], x2 = v[1][n];
                        v[0][n] = x1 * c - x2 * s; v[1][n] = x2 * c + x1 * s;
                    }
                }
                bf16_t* rowp = dst + (size_t)r * ld + colh + 8 * fq;
#pragma unroll
                for (int bj = 0; bj < 2; ++bj) { u32x4 o; o.x = cvt_pk_bf16(v[bj][0][0], v[bj][0][1]); o.y = cvt_pk_bf16(v[bj][0][2], v[bj][0][3]); o.z = cvt_pk_bf16(v[bj][1][0], v[bj][1][1]); o.w = cvt_pk_bf16(v[bj][1][2], v[bj][1][3]);
                    *(u32x4*)(rowp + 32 * bj) = o; }
            }
    }
    __device__ __forceinline__ void act(const AccT& acc, int row0, int wr, int wc, int fr, int fq, bf16_t* dst, int ld, int col0) const {
#pragma unroll
        for (int ai = 0; ai < 2; ++ai)
#pragma unroll
            for (int m = 0; m < 4; ++m) {
                const int r = row0 + 128 * ai + 64 * wr + 16 * m + fr;
                bf16_t* rowp = dst + (size_t)r * ld + col0 + 64 * wc + 8 * fq;
#pragma unroll
                for (int bj = 0; bj < 2; ++bj) { unsigned w[4];
#pragma unroll
                    for (int n = 0; n < 2; ++n)
#pragma unroll
                        for (int h = 0; h < 2; ++h) { const f32x2_t x = {acc[ai][bj][m][n][2 * h], acc[ai][bj][m][n][2 * h + 1]};
                            const f32x2_t t = x * (-LOG2E); f32x2_t e; e[0] = __builtin_amdgcn_exp2f(t[0]); e[1] = __builtin_amdgcn_exp2f(t[1]);
                            const f32x2_t d = e + 1.0f; f32x2_t sg; sg[0] = __builtin_amdgcn_rcpf(d[0]); sg[1] = __builtin_amdgcn_rcpf(d[1]);
                            const f32x2_t o = x * sg; w[2 * n + h] = cvt_pk_bf16(o[0], o[1]); }
                    u32x4 wv; wv.x = w[0]; wv.y = w[1]; wv.z = w[2]; wv.w = w[3];
                    *(u32x4*)(rowp + 32 * bj) = wv; }
            }
    }
    __device__ __forceinline__ void operator()(AccT& acc, const Unit& u, int wr, int wc, int fr, int fq) const {
        const int pn = u.pn, row0 = u.pm * 256;
        bf16_t* const QA = (bf16_t*)(ws + WS_QA); bf16_t* const KA = (bf16_t*)(ws + WS_KA); bf16_t* const QB = (bf16_t*)(ws + WS_QB); bf16_t* const KB = (bf16_t*)(ws + WS_KB);
        bf16_t* const VBT = (bf16_t*)(ws + WS_VBT); bf16_t* const ZA = (bf16_t*)(ws + WS_ZA); bf16_t* const ZB = (bf16_t*)(ws + WS_ZB); bf16_t* const VAT = (bf16_t*)(ws + WS_VAT);
        bf16_t* const GB = GA + (size_t)T * 1024;
        if (pn < 2) qk(acc, row0, wr, fr, fq, QA, 512, 256 * pn + 64 * wc, qn_a, QSCALE, false);
        else if (pn < 4) qk(acc, row0, wr, fr, fq, KA, 512, 256 * (pn - 2) + 64 * wc, kn_a, 1.0f, false);
        else if (pn < 6) qk(acc, row0, wr, fr, fq, QB, 512, 256 * (pn - 4) + 64 * wc, qn_b, QSCALE, true);
        else if (pn == 6) {
            if (wc < 2) qk(acc, row0, wr, fr, fq, KB, 128, 64 * wc, kn_b, 1.0f, true);
            else {
#pragma unroll
                for (int ai = 0; ai < 2; ++ai)
#pragma unroll
                    for (int m = 0; m < 4; ++m) {
                        const int r = row0 + 128 * ai + 64 * wr + 16 * m + fr;
                        bf16_t* base = VBT + ((size_t)(r >> 3) * 128 + 64 * (wc - 2) + 8 * fq) * 8 + (r & 7);
#pragma unroll
                        for (int bj = 0; bj < 2; ++bj)
#pragma unroll
                            for (int n = 0; n < 2; ++n) { const f32x4 x = acc[ai][bj][m][n];
                                const unsigned p0 = cvt_pk_bf16(x[0], x[1]), p1 = cvt_pk_bf16(x[2], x[3]);
                                bf16_t* q = base + (32 * bj + 4 * n) * 8;
                                q[0] = (bf16_t)(p0 & 0xffffu); q[8] = (bf16_t)(p0 >> 16); q[16] = (bf16_t)(p1 & 0xffffu); q[24] = (bf16_t)(p1 >> 16); }
                    }
            }
        }
        else if (pn < 9) act(acc, row0, wr, wc, fr, fq, ZA, 512, 256 * (pn - 7));
        else if (pn < 11) act(acc, row0, wr, wc, fr, fq, ZB, 512, 256 * (pn - 9));
        else if (pn < 19) {
#pragma unroll
            for (int ai = 0; ai < 2; ++ai)
#pragma unroll
                for (int m = 0; m < 4; ++m) {
                    const int r = row0 + 128 * ai + 64 * wr + 16 * m + fr;
                    unsigned Rw[4], Sw[4];
#pragma unroll
                    for (int n = 0; n < 2; ++n)
#pragma unroll
                        for (int h = 0; h < 2; ++h) { const f32x2_t a2 = {acc[ai][0][m][n][2 * h], acc[ai][0][m][n][2 * h + 1]}, b2 = {acc[ai][1][m][n][2 * h], acc[ai][1][m][n][2 * h + 1]};
                            const f32x2_t ta = a2 * (-LOG2E), tb = b2 * (-LOG2E); f32x2_t ea, eb;
                            ea[0] = __builtin_amdgcn_exp2f(ta[0]); ea[1] = __builtin_amdgcn_exp2f(ta[1]); eb[0] = __builtin_amdgcn_exp2f(tb[0]); eb[1] = __builtin_amdgcn_exp2f(tb[1]);
                            const f32x2_t ua = ea + 1.0f, ub = eb + 1.0f, pr = ua * ub; f32x2_t t; t[0] = __builtin_amdgcn_rcpf(pr[0]); t[1] = __builtin_amdgcn_rcpf(pr[1]);
                            const f32x2_t S2 = t * ua, R2 = t * ub * ub;
                            Sw[2 * n + h] = cvt_pk_bf16(S2[0], S2[1]); Rw[2 * n + h] = cvt_pk_bf16(R2[0], R2[1]); }
                    const size_t off = (size_t)r * 1024 + 128 * (pn - 11) + 32 * wc + 8 * fq;
                    u32x4 w; w.x = Rw[0]; w.y = Rw[1]; w.z = Rw[2]; w.w = Rw[3];
                    *(u32x4*)(GA + off) = w;
                    w.x = Sw[0]; w.y = Sw[1]; w.z = Sw[2]; w.w = Sw[3];
                    *(u32x4*)(GB + off) = w;
                }
        }
        else {
            const int c0 = 256 * (pn - 19);
#pragma unroll
            for (int ai = 0; ai < 2; ++ai)
#pragma unroll
                for (int m = 0; m < 4; ++m) {
                    const int c = c0 + 128 * ai + 64 * wr + 16 * m + fr;
#pragma unroll
                    for (int bj = 0; bj < 2; ++bj) {
                        const int t0 = row0 + 64 * wc + 32 * bj + 8 * fq;
                        const f32x4 x0 = acc[ai][bj][m][0], x1 = acc[ai][bj][m][1];
                        u32x4 o; o.x = cvt_pk_bf16(x0[0], x0[1]); o.y = cvt_pk_bf16(x0[2], x0[3]); o.z = cvt_pk_bf16(x1[0], x1[1]); o.w = cvt_pk_bf16(x1[2], x1[3]);
                        *(u32x4*)(VAT + ((size_t)(t0 >> 3) * 512 + c) * 8) = o; }
                }
        }
    }
};

struct EpiC1 {
    static constexpr bool MIDHOOK = true;
    const bf16_t *GA, *GB; bf16_t* MG;
    __device__ __forceinline__ void mid(AccT& acc, const Unit& u, int wr, int wc, int fr, int fq) const {
        unsigned base = (unsigned)((u.pm * 256 + 64 * wr + fr) * 1024 + u.pn * 256 + 64 * wc + 8 * fq) * 2u;
        asm volatile("" : "+v"(base));
#pragma unroll
        for (int ai = 0; ai < 2; ++ai)
#pragma unroll
            for (int m = 0; m < 4; ++m) {
#pragma unroll
                for (int bj = 0; bj < 2; ++bj) {
                    const unsigned off = base + (unsigned)((128 * ai + 16 * m) * 1024 + 32 * bj) * 2u;
                    const u32x4 a = *(const u32x4*)((const char*)GA + off);
                    f32x4 r0, r1;
                    r0[0] = bf_lo(a.x); r0[1] = bf_hi(a.x); r0[2] = bf_lo(a.y); r0[3] = bf_hi(a.y);
                    r1[0] = bf_lo(a.z); r1[1] = bf_hi(a.z); r1[2] = bf_lo(a.w); r1[3] = bf_hi(a.w);
                    acc[ai][bj][m][0] *= r0; acc[ai][bj][m][1] *= r1;
                }

            }
    }
    __device__ __forceinline__ void operator()(AccT& acc, const Unit& u, int wr, int wc, int fr, int fq) const {
        unsigned base = (unsigned)((u.pm * 256 + 64 * wr + fr) * 1024 + u.pn * 256 + 64 * wc + 8 * fq) * 2u;
        asm volatile("" : "+v"(base));
        u32x4 sv[2][4][2];
#pragma unroll
        for (int ai = 0; ai < 2; ++ai)
#pragma unroll
            for (int m = 0; m < 4; ++m)
#pragma unroll
                for (int bj = 0; bj < 2; ++bj) sv[ai][m][bj] = *(const u32x4*)((const char*)GB + base + (unsigned)((128 * ai + 16 * m) * 1024 + 32 * bj) * 2u);
#pragma unroll
        for (int ai = 0; ai < 2; ++ai)
#pragma unroll
            for (int m = 0; m < 4; ++m) {
#pragma unroll
                for (int bj = 0; bj < 2; ++bj) {
                    const unsigned off = base + (unsigned)((128 * ai + 16 * m) * 1024 + 32 * bj) * 2u;
                    const u32x4 b = sv[ai][m][bj];
                    const f32x4 x0 = acc[ai][bj][m][0], x1 = acc[ai][bj][m][1];
                    u32x4 o; o.x = cvt_pk_bf16(x0[0] * bf_lo(b.x), x0[1] * bf_hi(b.x)); o.y = cvt_pk_bf16(x0[2] * bf_lo(b.y), x0[3] * bf_hi(b.y));
                    o.z = cvt_pk_bf16(x1[0] * bf_lo(b.z), x1[1] * bf_hi(b.z)); o.w = cvt_pk_bf16(x1[2] * bf_lo(b.w), x1[3] * bf_hi(b.w));
                    *(u32x4*)((char*)MG + off) = o;
                }
            }
    }
};
struct EpiC2 {
    static constexpr bool MIDHOOK = false;
    const float *xp, *xs; float* out;
    __device__ __forceinline__ void mid(AccT&, const Unit&, int, int, int, int) const {}
    __device__ __forceinline__ void operator()(AccT& acc, const Unit& u, int wr, int wc, int fr, int fq) const {
        const int row0 = u.pm * 256;
        const char* xb = (const char*)(row0 < TP ? xp + (size_t)row0 * 1024 : xs + (size_t)(row0 - TP) * 1024);
        char* ob = (char*)(out + (size_t)row0 * 1024);
        unsigned base = (unsigned)((64 * wr + fr) * 1024 + u.pn * 256 + 64 * wc + 4 * fq) * 4u;
        asm volatile("" : "+v"(base));
#pragma unroll
        for (int ai = 0; ai < 2; ++ai) {
            f32x4 xv[4][2][2];
#pragma unroll
            for (int m = 0; m < 4; ++m)
#pragma unroll
                for (int bj = 0; bj < 2; ++bj)
#pragma unroll
                    for (int n = 0; n < 2; ++n) xv[m][bj][n] = *(const f32x4*)(xb + base + (unsigned)((128 * ai + 16 * m) * 1024 + 32 * bj + 16 * n) * 4u);
#pragma unroll
            for (int m = 0; m < 4; ++m)
#pragma unroll
                for (int bj = 0; bj < 2; ++bj)
#pragma unroll
                    for (int n = 0; n < 2; ++n) *(f32x4*)(ob + base + (unsigned)((128 * ai + 16 * m) * 1024 + 32 * bj + 16 * n) * 4u) = xv[m][bj][n] + acc[ai][bj][m][n];
            asm volatile("" ::: "memory");
        }
    }
};

__device__ __forceinline__ int map_col(int n) {
    if (n < 1024) return n;
    if (n < 1536) return 2048 + n - 1024;
    if (n < 1664) return 2560 + n - 1536;
    if (n < 1792) return 2688 + n - 1664;
    if (n < 2304) return 1536 + n - 1792;
    if (n < 2816) return 2816 + n - 2304;
    if (n < 4864) { const int w = n - 2816, tg = w >> 8, ww = w & 255, wcw = ww >> 6, bj = (ww >> 5) & 1, e = ww & 31;
        return (bj ? 4352 : 3328) + 128 * tg + 32 * wcw + e; }
    return 1024 + n - 4864;
}
__device__ __forceinline__ void p0_transpose_item(const float* W, int N, int ksrc0, int nsrc0, const float* ksc, bf16_t* WT, int nrow0, int kdst0, LAS float* scr, int lane) {
#pragma unroll 8
    for (int i = 0; i < 32; ++i) { const int kk = 2 * i + (lane >> 5); float v = W[(size_t)(ksrc0 + kk) * N + nsrc0 + (lane & 31)]; if (ksc) v *= ksc[ksrc0 + kk]; scr[kk * 33 + (lane & 31)] = v; }
    asm volatile("s_waitcnt lgkmcnt(0)" ::: "memory");
    const int c = lane & 7;
#pragma unroll
    for (int j = 0; j < 4; ++j) { const int n = (lane >> 3) + 8 * j; const LAS float* s = scr + (8 * c) * 33 + n;
        u32x4 o; o.x = cvt_pk_bf16(s[0 * 33], s[1 * 33]); o.y = cvt_pk_bf16(s[2 * 33], s[3 * 33]); o.z = cvt_pk_bf16(s[4 * 33], s[5 * 33]); o.w = cvt_pk_bf16(s[6 * 33], s[7 * 33]);
        *(u32x4*)(WT + (size_t)(nrow0 + n) * 1024 + kdst0 + 8 * c) = o; }
    asm volatile("s_waitcnt lgkmcnt(0)" ::: "memory");
}

struct Args { const float* in[13]; float* out; unsigned char* ws; int ph_lo, ph_hi; };

__device__ __forceinline__ void p0_load4(const Args& a, int m0, int NGW, int lane, f32x4 (&v)[4][4]) {
#pragma unroll
    for (int u = 0; u < 4; ++u) { const int m = min(m0 + u * NGW, T - 1);
        const float* xrow = m < TP ? a.in[0] + (size_t)m * 1024 : a.in[1] + (size_t)(m - TP) * 1024;
        const f32x4* xr = (const f32x4*)xrow + lane;
#pragma unroll
        for (int j = 0; j < 4; ++j) v[u][j] = xr[64 * j]; }
}
__device__ __forceinline__ void p0_proc4(bf16_t* XB, int m0, int NGW, int lane, const f32x4 (&v)[4][4]) {
    float s[4];
#pragma unroll
    for (int u = 0; u < 4; ++u) { float t = 0.f;
#pragma unroll
        for (int j = 0; j < 4; ++j) t += (v[u][j][0] * v[u][j][0] + v[u][j][1] * v[u][j][1]) + (v[u][j][2] * v[u][j][2] + v[u][j][3] * v[u][j][3]);
        s[u] = t; }
#pragma unroll
    for (int o = 1; o < 64; o <<= 1) {
#pragma unroll
        for (int u = 0; u < 4; ++u) s[u] += __shfl_xor(s[u], o); }
#pragma unroll
    for (int u = 0; u < 4; ++u) { const int m = m0 + u * NGW; if (m >= T) break;
        const float rstd = 1.0f / sqrtf(s[u] * (1.0f / 1024.0f) + NORM_EPS);
        u32x2* o8 = (u32x2*)(XB + (size_t)m * 1024) + lane;
#pragma unroll
        for (int j = 0; j < 4; ++j) { u32x2 w; w.x = cvt_pk_bf16(v[u][j][0] * rstd, v[u][j][1] * rstd); w.y = cvt_pk_bf16(v[u][j][2] * rstd, v[u][j][3] * rstd); o8[64 * j] = w; } }
}

__device__ __forceinline__ void p0_prologue(const Args& a, LAS unsigned char* lds, int wave, int lane) {
    if (wave < 4) {
        LAS float* scr = (LAS float*)(lds + wave * 16384);
        const int gw = blockIdx.x * 4 + wave, NGW = gridDim.x * 4;
        const float* w_in = a.in[3]; const float* w_oa = a.in[10]; const float* w_ob = a.in[11]; const float* w_o = a.in[12]; const float* ng = a.in[2];
        bf16_t* WIN = (bf16_t*)(a.ws + WS_WIN); bf16_t* WAB = (bf16_t*)(a.ws + WS_WAB); bf16_t* WO = (bf16_t*)(a.ws + WS_WO);
        constexpr int I_IN = 16 * 168, I_OA = 8 * 32, I_OB = 8 * 32, I_O = 16 * 32, NITEMS = I_IN + I_OA + I_OB + I_O;
        for (int it = gw; it < NITEMS; it += NGW) {
            int r = it;
            if (r < I_IN) { const int kb = r / 168, nb = r % 168; p0_transpose_item(w_in, NIN, 64 * kb, map_col(32 * nb), ng, WIN, 32 * nb, 64 * kb, scr, lane); continue; } r -= I_IN;
            if (r < I_OA) { const int kb = r / 32, nb = r % 32; p0_transpose_item(w_oa, 1024, 64 * kb, 32 * nb, nullptr, WAB, 32 * nb, 64 * kb, scr, lane); continue; } r -= I_OA;
            if (r < I_OB) { const int kb = r / 32, nb = r % 32; p0_transpose_item(w_ob, 1024, 64 * kb, 32 * nb, nullptr, WAB, 32 * nb, 512 + 64 * kb, scr, lane); continue; } r -= I_OB;
            { const int kb = r / 32, nb = r % 32; p0_transpose_item(w_o, 1024, 64 * kb, 32 * nb, nullptr, WO, 32 * nb, 64 * kb, scr, lane); }
        }
    } else {
        bf16_t* XB = (bf16_t*)(a.ws + WS_XB);
        const int gw = blockIdx.x * 4 + (wave - 4), NGW = gridDim.x * 4;
        f32x4 va[4][4], vb[4][4];
        int m0 = gw;
        if (m0 < T) p0_load4(a, m0, NGW, lane, va);
        while (m0 < T) {
            const int m1 = m0 + 4 * NGW; const bool has1 = m1 < T;
            if (has1) p0_load4(a, m1, NGW, lane, vb);
            p0_proc4(XB, m0, NGW, lane, va);
            if (!has1) break;
            const int m2 = m1 + 4 * NGW; const bool has2 = m2 < T;
            if (has2) p0_load4(a, m2, NGW, lane, va);
            p0_proc4(XB, m1, NGW, lane, vb);
            if (!has2) break;
            m0 = m2;
        }
    }
}

struct AttnP { const bf16_t *QA, *KA, *VAT, *ZA, *QB, *KB, *VBT, *ZB; bf16_t* Y; const float* sink; const float* rpb; };
constexpr int ATT_VOFF = 73728, ATT_RPB = 147456;
__device__ __forceinline__ int att_vpos(int d) { return (d & 32) | ((d & 4) << 2) | ((d & 24) >> 1) | (d & 3); }

template <bool SWA> struct AttStage { u32x4 k[SWA ? 6 : 9]; u32x4 v[SWA ? 6 : 9]; };

template <bool SWA>
__device__ __forceinline__ void att_decode(int item, int& b, int& h, int& x) {
    if (SWA) { x = item & 31; h = (item >> 5) & 1; b = item >> 6; }
    else { x = item & 31; h = (item >> 5) & 7; b = item >> 8; }
}
template <bool SWA>
__device__ __forceinline__ void att_load(const AttnP& P, int item, int tid, AttStage<SWA>& st) {
    constexpr int NCH = SWA ? 6 : 9, KLD = SWA ? 128 : 512;
    int b, h, x; att_decode<SWA>(item, b, h, x);
    const int tb = b * SEQ, kcol = h * 64;
    const bf16_t* Kp = SWA ? P.KB : P.KA; const bf16_t* VT = SWA ? P.VBT : P.VAT;
    const int base = SWA ? 128 * x - 128 : min(max(2 * x - 4, 0), 56);
#pragma unroll
    for (int i = 0; i < NCH; ++i) {
        const int idx = tid + 512 * i;
        { const int k = idx >> 3, c = idx & 7; int tok;
          if (SWA) tok = min(max(base + k, 0), SEQ - 1); else tok = min(base + (k >> 6), 63) * 64 + (k & 63);
          st.k[i] = *(const u32x4*)(Kp + (size_t)(tb + tok) * KLD + kcol + 8 * c); }
        { const int kb = idx >> 6, d = idx & 63; int tok;
          if (SWA) tok = min(max(base + 8 * kb, 0), SEQ - 8); else tok = min(base + (kb >> 3), 63) * 64 + 8 * (kb & 7);
          st.v[i] = *(const u32x4*)(VT + ((size_t)((tb + tok) >> 3) * KLD + kcol + d) * 8); }
    }
}
template <bool SWA>
__device__ __forceinline__ void att_store(LAS unsigned char* lds, int tid, const AttStage<SWA>& st) {
    constexpr int NCH = SWA ? 6 : 9;
#pragma unroll
    for (int i = 0; i < NCH; ++i) {
        const int idx = tid + 512 * i, k = idx >> 3, c = idx & 7;
        *(LAS u32x4*)(lds + k * 128 + ((c ^ ((k >> 1) & 7)) << 4)) = st.k[i];
        *(LAS u32x4*)(lds + ATT_VOFF + ((idx & ~63) + att_vpos(idx & 63)) * 16) = st.v[i];
    }
}

struct AttQZ { bf16x8 q0, q1; u32x4 z[2]; };
template <bool SWA>
__device__ __forceinline__ void att_load_qz(const AttnP& P, int lane, int tb, int qpos0, int hq, AttQZ& o) {
    const int li = lane & 15, fq = lane >> 4;
    const bf16_t* Q = SWA ? P.QB : P.QA; const bf16_t* Z = SWA ? P.ZB : P.ZA;
    const bf16_t* qrow = Q + (size_t)(tb + qpos0 + li) * 512 + hq * 64 + 8 * fq;
    o.q0 = *(const bf16x8*)qrow; o.q1 = *(const bf16x8*)(qrow + 32);
    const bf16_t* zrow = Z + (size_t)(tb + qpos0 + li) * 512 + hq * 64 + 8 * fq;
#pragma unroll
    for (int hh = 0; hh < 2; ++hh) o.z[hh] = *(const u32x4*)(zrow + 32 * hh);
}
template <bool SWA, bool FAST>
__device__ __forceinline__ void att_tile(const AttnP& P, LAS unsigned char* lds, int lane, int tb, int qpos0, int hq, int kloc0, int r, int ct, int kr0, int kc0, const AttQZ& qz, float shift) {
    constexpr int NSEG = SWA ? 9 : 8, KMAX = SWA ? 383 : 575;
    const int li = lane & 15, fq = lane >> 4;
    const bf16x8 bq0 = qz.q0, bq1 = qz.q1;
    f32x4 sc[NSEG][2];
    constexpr int GS = SWA ? 3 : 2;
    const int krow0 = (SWA ? kloc0 : kc0) + li, ksw = (krow0 >> 1) & 7;
    const LAS unsigned char* kb0 = lds + krow0 * 128 + ((fq ^ ksw) << 4);
    const LAS unsigned char* kb1 = lds + krow0 * 128 + (((fq + 4) ^ ksw) << 4);
#pragma unroll
    for (int s0 = 0; s0 < NSEG; s0 += GS) {
        bf16x8 kf[GS][2][2];
#pragma unroll
        for (int g = 0; g < GS; ++g)
#pragma unroll
            for (int kt = 0; kt < 2; ++kt) { const int s = s0 + g;
                const int segoff = SWA ? (32 * s + 16 * kt) * 128 : (((kr0 + s) % 9) * 64 + 16 * kt) * 128;
                kf[g][kt][0] = *(const LAS bf16x8*)(kb0 + segoff); kf[g][kt][1] = *(const LAS bf16x8*)(kb1 + segoff); }
        __builtin_amdgcn_sched_barrier(0);
#pragma unroll
        for (int g = 0; g < GS; ++g)
#pragma unroll
            for (int kt = 0; kt < 2; ++kt) {
                f32x4 z = FAST ? (f32x4){-shift, -shift, -shift, -shift} : (f32x4){0.f, 0.f, 0.f, 0.f};
                z = __builtin_amdgcn_mfma_f32_16x16x32_bf16(kf[g][kt][0], bq0, z, 0, 0, 0);
                z = __builtin_amdgcn_mfma_f32_16x16x32_bf16(kf[g][kt][1], bq1, z, 0, 0, 0);
                sc[s0 + g][kt] = z; }
        __builtin_amdgcn_sched_barrier(0);
    }
    float mx = -1e30f;
    if (SWA) {
        const int qp = qpos0 + li, cq = 4 * fq - li;
#pragma unroll
        for (int s = 0; s < NSEG; ++s) {
            const int kb0 = qpos0 - 128 + 32 * s;
            if (s >= 1 && s <= 7 && kb0 >= 0 && kb0 + 31 < SEQ) {
#pragma unroll
                for (int kt = 0; kt < 2; ++kt)
#pragma unroll
                    for (int j = 0; j < 4; ++j) { if (!FAST) mx = fmaxf(mx, sc[s][kt][j]); }
            } else if (s == 0 && kb0 >= 0) {
                asm volatile("");
#pragma unroll
                for (int kt = 0; kt < 2; ++kt)
#pragma unroll
                    for (int j = 0; j < 4; ++j) { const bool ok = (cq + j + 16 * kt) >= 0;
                        const float v = ok ? sc[s][kt][j] : -1e30f; sc[s][kt][j] = v; if (!FAST) mx = fmaxf(mx, v); }
            } else if (s == 8 && kb0 + 31 < SEQ) {
                asm volatile("");
#pragma unroll
                for (int j = 0; j < 4; ++j) { const bool ok = (cq + j) <= 0;
                    const float v = ok ? sc[s][0][j] : -1e30f; sc[s][0][j] = v; sc[s][1][j] = -1e30f; if (!FAST) mx = fmaxf(mx, v); }
            } else {
                asm volatile("");
#pragma unroll
                for (int kt = 0; kt < 2; ++kt)
#pragma unroll
                    for (int j = 0; j < 4; ++j) { const int kp = kb0 + 16 * kt + 4 * fq + j; const int d = kp - qp;
                        const bool ok = (kp >= 0) && (kp < SEQ) && (d <= 128) && (d >= -128);
                        const float v = ok ? sc[s][kt][j] : -1e30f; sc[s][kt][j] = v; if (!FAST) mx = fmaxf(mx, v); }
            }
        }
    } else if (!FAST) {
        const int c = 16 * ct + li, cs = min(max(c - 8, 0), 48);
        const LAS float* rp = (const LAS float*)(lds + ATT_RPB) + (kr0 - r + 7) * 64 + (kc0 + 4 * fq - c + 31);
#pragma unroll
        for (int s = 0; s < NSEG; ++s) {
            float bias[2][4];
#pragma unroll
            for (int kt = 0; kt < 2; ++kt)
#pragma unroll
                for (int j = 0; j < 4; ++j) bias[kt][j] = rp[s * 64 + 16 * kt + j];
#pragma unroll
            for (int kt = 0; kt < 2; ++kt)
#pragma unroll
                for (int j = 0; j < 4; ++j) { const int kc = kc0 + 16 * kt + 4 * fq + j; const bool ok = (kc >= cs) && (kc < cs + 16);
                    float t = sc[s][kt][j] + bias[kt][j]; asm volatile("" : "+v"(t));
                    const float v = ok ? t : -1e30f; sc[s][kt][j] = v; if (!FAST) mx = fmaxf(mx, v); }
        }
    }
    if (!FAST) { mx = fmaxf(mx, __shfl_xor(mx, 16)); mx = fmaxf(mx, __shfl_xor(mx, 32)); }
    float sk = 0.f;
    if (SWA) { sk = P.sink[hq] * LOG2E; if (!FAST) mx = fmaxf(mx, sk); }
    float l = 0.f; f32x2_t l2 = {0.f, 0.f};
    bf16x8 pb[NSEG];
    if constexpr (!SWA && FAST) {
        const int c = 16 * ct + li, cs = min(max(c - 8, 0), 48), w = cs - kc0;
        const LAS float* rp = (const LAS float*)(lds + ATT_RPB) + (kr0 - r + 7) * 64 + (kc0 + 4 * fq - c + 31);
        bool hi[4]; const LAS float* rpj[4];
#pragma unroll
        for (int j = 0; j < 4; ++j) { hi[j] = (4 * fq + j) < w; rpj[j] = rp + (hi[j] ? 16 : 0) + j; }
        const unsigned m01 = (hi[0] ? 0u : 0xffffu) | (hi[1] ? 0u : 0xffff0000u), m23 = (hi[2] ? 0u : 0xffffu) | (hi[3] ? 0u : 0xffff0000u);
#pragma unroll
        for (int s = 0; s < NSEG; ++s) {
            float p[4];
#pragma unroll
            for (int j = 0; j < 4; ++j) { const float v = hi[j] ? sc[s][1][j] : sc[s][0][j]; p[j] = __builtin_amdgcn_exp2f(v + rpj[j][s * 64]); }
            l2 += (f32x2_t){p[0], p[1]}; l2 += (f32x2_t){p[2], p[3]};
            const unsigned pk01 = cvt_pk_bf16(p[0], p[1]), pk23 = cvt_pk_bf16(p[2], p[3]);
            u32x4 wv; wv.x = pk01 & m01; wv.y = pk23 & m23; wv.z = pk01 & ~m01; wv.w = pk23 & ~m23;
            pb[s] = __builtin_bit_cast(bf16x8, wv);
        }
    } else
#pragma unroll
    for (int s = 0; s < NSEG; ++s) {
        float p[8];
#pragma unroll
        for (int kt = 0; kt < 2; ++kt)
#pragma unroll
            for (int j = 0; j < 4; ++j) p[4 * kt + j] = __builtin_amdgcn_exp2f(FAST ? sc[s][kt][j] : sc[s][kt][j] - mx);
#pragma unroll
        for (int e = 0; e < 8; e += 2) l2 += (f32x2_t){p[e], p[e + 1]};
        u32x4 w; w.x = cvt_pk_bf16(p[0], p[1]); w.y = cvt_pk_bf16(p[2], p[3]); w.z = cvt_pk_bf16(p[4], p[5]); w.w = cvt_pk_bf16(p[6], p[7]);
        pb[s] = __builtin_bit_cast(bf16x8, w);
    }
    l += l2[0] + l2[1];
    l += __shfl_xor(l, 16); l += __shfl_xor(l, 32);
    if (SWA) l += __builtin_amdgcn_exp2f(FAST ? sk - shift : sk - mx);
    const float rl = 1.0f / l;
    f32x4 oacc[4];
#pragma unroll
    for (int dt = 0; dt < 4; ++dt) oacc[dt] = (f32x4){0.f, 0.f, 0.f, 0.f};
    constexpr int GV = SWA ? 3 : 2;
    const int g0l = (SWA ? kloc0 : kc0) + 4 * fq;
    const LAS unsigned char* vb0 = lds + ATT_VOFF + (g0l >> 3) * 1024 + li * 16 + (g0l & 7) * 2;
#pragma unroll
    for (int s0 = 0; s0 < NSEG; s0 += GV) {
        u32x2 vf[GV][4][2];
#pragma unroll
        for (int g = 0; g < GV; ++g) { const int s = s0 + g;
            const int segv = SWA ? s * 4096 : ((kr0 + s) % 9) * 8192;
#pragma unroll
            for (int dt = 0; dt < 4; ++dt) {
                vf[g][dt][0] = *(const LAS u32x2*)(vb0 + segv + dt * 256); asm volatile("" ::: "memory");
                vf[g][dt][1] = *(const LAS u32x2*)(vb0 + segv + dt * 256 + 2048); asm volatile("" ::: "memory"); } }
        __builtin_amdgcn_sched_barrier(0);
#pragma unroll
        for (int g = 0; g < GV; ++g)
#pragma unroll
            for (int dt = 0; dt < 4; ++dt) {
                u32x4 w; w.x = vf[g][dt][0].x; w.y = vf[g][dt][0].y; w.z = vf[g][dt][1].x; w.w = vf[g][dt][1].y;
                oacc[dt] = __builtin_amdgcn_mfma_f32_16x16x32_bf16(__builtin_bit_cast(bf16x8, w), pb[s0 + g], oacc[dt], 0, 0, 0); }
        __builtin_amdgcn_sched_barrier(0);
    }
    const size_t tq = (size_t)(tb + qpos0 + li);
#pragma unroll
    for (int hh = 0; hh < 2; ++hh) {
        const u32x4 z = qz.z[hh]; const f32x4 a = oacc[2 * hh], b = oacc[2 * hh + 1];
        u32x4 o; o.x = cvt_pk_bf16(a[0] * rl * bf_lo(z.x), a[1] * rl * bf_hi(z.x)); o.y = cvt_pk_bf16(a[2] * rl * bf_lo(z.y), a[3] * rl * bf_hi(z.y));
        o.z = cvt_pk_bf16(b[0] * rl * bf_lo(z.z), b[1] * rl * bf_hi(z.z)); o.w = cvt_pk_bf16(b[2] * rl * bf_lo(z.w), b[3] * rl * bf_hi(z.w));
        *(u32x4*)(P.Y + tq * 1024 + (SWA ? 512 : 0) + hq * 64 + 32 * hh + 8 * fq) = o;
    }
}

template <bool SWA>
__device__ __forceinline__ void att_phase(const AttnP& P, LAS unsigned char* lds, int tid, int wave, int lane, bool fast, float shift, AttStage<SWA>& st, AttQZ& qzn, bool pre) {
    constexpr int NITEMS = SWA ? 768 : 3072;
    int item = blockIdx.x;
#define ATT_QPOS(x) (SWA ? 128 * (x) + 16 * wave : (2 * (x) + (wave >> 2)) * 64 + 16 * (wave & 3))
    if (!pre && item < NITEMS) { int b, h, x; att_decode<SWA>(item, b, h, x); att_load<SWA>(P, item, tid, st); att_load_qz<SWA>(P, lane, b * SEQ, ATT_QPOS(x), SWA ? 4 * h : h, qzn); }
    for (; item < NITEMS; item += gridDim.x) {
        int b, h, x; att_decode<SWA>(item, b, h, x);
        att_store<SWA>(lds, tid, st);
        if (!SWA) { if (tid < 465) ((LAS float*)(lds + ATT_RPB))[tid] = P.rpb[h * 465 + tid] * LOG2E; }
        __syncthreads();
        const int nitem = item + (int)gridDim.x; const bool has_next = nitem < NITEMS;
        int nb = 0, nh = 0, nx = 0; if (has_next) { att_decode<SWA>(nitem, nb, nh, nx); att_load<SWA>(P, nitem, tid, st); }
        const int tb = b * SEQ;
        if (SWA) {
#pragma unroll 1
            for (int j = 0; j < 4; ++j) { int kl = 16 * wave; asm volatile("" : "+v"(kl));
                const AttQZ qz = qzn;
                if (j < 3) att_load_qz<true>(P, lane, tb, ATT_QPOS(x), 4 * h + j + 1, qzn);
                else if (has_next) att_load_qz<true>(P, lane, nb * SEQ, ATT_QPOS(nx), 4 * nh, qzn);
                if (fast) att_tile<true, true>(P, lds, lane, tb, 128 * x + 16 * wave, 4 * h + j, kl, 0, 0, 0, 0, qz, shift);
                else att_tile<true, false>(P, lds, lane, tb, 128 * x + 16 * wave, 4 * h + j, kl, 0, 0, 0, 0, qz, 0.f); }
        } else {
            const AttQZ qz = qzn;
            if (has_next) att_load_qz<false>(P, lane, nb * SEQ, ATT_QPOS(nx), nh, qzn);
            const int basee = min(max(2 * x - 4, 0), 56), r = 2 * x + (wave >> 2), ct = wave & 3, kr0 = min(max(r - 4, 0), 56);
            const int kc0 = ct == 0 ? 0 : (ct == 1 ? 8 : (ct == 2 ? 24 : 32));
            att_tile<false, false>(P, lds, lane, tb, r * 64 + 16 * ct, h, (kr0 - basee) * 64 + kc0, r, ct, kr0, kc0, qz, 0.f);
        }
        __syncthreads();
    }
#undef ATT_QPOS
}


struct NaStep { int b, h, rp, first, nrows; bool full; };
__device__ __forceinline__ NaStep na_step(int t, int spw, int c) {
    NaStep o; const int g = c * spw + t, bh = g >> 5; o.rp = g & 31; o.h = bh & 7; o.b = bh >> 3;
    const int base = min(max(2 * o.rp - 4, 0), 56);
    o.full = (t == 0) || (o.rp == 0);
    if (o.full) { o.first = base; o.nrows = 9; }
    else { const int pb = min(max(2 * o.rp - 6, 0), 56); o.first = pb + 9; o.nrows = base - pb; }
    return o;
}
__device__ __forceinline__ void na_load(const AttnP& P, const NaStep& st, int tid, AttStage<false>& r) {
    const int tb = st.b * SEQ, kcol = st.h * 64;
#pragma unroll
    for (int i = 0; i < 9; ++i) if (i < st.nrows) {
        const int row = min(st.first + i, 63);
        r.k[i] = *(const u32x4*)(P.KA + (size_t)(tb + row * 64 + (tid >> 3)) * 512 + kcol + 8 * (tid & 7));
        r.v[i] = *(const u32x4*)(P.VAT + ((size_t)((tb + row * 64) >> 3) + (tid >> 6)) * 4096 + (size_t)(kcol + (tid & 63)) * 8);
    }
}
__device__ __forceinline__ void na_store(LAS unsigned char* lds, const NaStep& st, int tid, const AttStage<false>& r) {
#pragma unroll
    for (int i = 0; i < 9; ++i) if (i < st.nrows) {
        const int slot = (st.first + i) % 9, k = slot * 64 + (tid >> 3), c = tid & 7;
        *(LAS u32x4*)(lds + k * 128 + ((c ^ ((k >> 1) & 7)) << 4)) = r.k[i];
        *(LAS u32x4*)(lds + ATT_VOFF + (slot * 8 + (tid >> 6)) * 1024 + att_vpos(tid & 63) * 16) = r.v[i];
    }
}
__device__ __forceinline__ void na_phase(const AttnP& P, LAS unsigned char* lds, int tid, int wave, int lane, bool fast, float shift, AttStage<true>& swa_st, AttQZ& swa_qz) {
    const int G = gridDim.x, c = blockIdx.x;
    const int spw = (3072 + G - 1) / G;
    const int nsteps = min(spw, max(3072 - c * spw, 0));
    AttStage<false> rg; AttQZ qzn;
    if (nsteps > 0) { const NaStep s0 = na_step(0, spw, c); na_load(P, s0, tid, rg); att_load_qz<false>(P, lane, s0.b * SEQ, (2 * s0.rp + (wave >> 2)) * 64 + 16 * (wave & 3), s0.h, qzn); }
#define NA_STEP(T, ...) do { \
        const NaStep st = na_step((T), spw, c); \
        na_store(lds, st, tid, rg); \
        if (st.full) {        \
            _Pragma("unroll") for (int i = 0; i < 2; ++i) { const int e = tid + 512 * i, row = e >> 6, dc = (e & 63) - 16; \
                if (e < 960) ((LAS float*)(lds + ATT_RPB))[e] = (dc >= 0 && dc <= 30) ? P.rpb[st.h * 465 + row * 31 + dc] * LOG2E : 0.f; } } \
        __syncthreads(); \
        const AttQZ qz = qzn; \
        __VA_ARGS__; \
        const int r = 2 * st.rp + (wave >> 2), ct = wave & 3, kr0 = min(max(r - 4, 0), 56); \
        const int kc0 = ct == 0 ? 0 : (ct == 1 ? 8 : (ct == 2 ? 24 : 32)); \
        if (fast) att_tile<false, true>(P, lds, lane, st.b * SEQ, r * 64 + 16 * ct, st.h, 0, r, ct, kr0, kc0, qz, shift); \
        else att_tile<false, false>(P, lds, lane, st.b * SEQ, r * 64 + 16 * ct, st.h, 0, r, ct, kr0, kc0, qz, 0.f); \
        __syncthreads(); } while (0)
    for (int t = 0; t + 1 < nsteps; ++t)
        NA_STEP(t, { const NaStep sn = na_step(t + 1, spw, c); na_load(P, sn, tid, rg); att_load_qz<false>(P, lane, sn.b * SEQ, (2 * sn.rp + (wave >> 2)) * 64 + 16 * (wave & 3), sn.h, qzn); });
    if (nsteps > 0)
        NA_STEP(nsteps - 1, { if (c < 768) { int sb, sh, sx; att_decode<true>(c, sb, sh, sx); att_load<true>(P, c, tid, swa_st); att_load_qz<true>(P, lane, sb * SEQ, 128 * sx + 16 * wave, 4 * sh, swa_qz); } });
#undef NA_STEP
}

#define XB_TMO      128
#define XB_XCNT(j)  (256  + 64 * (j))
#define XB_XSUB(j)  (1280 + 64 * (j))
#define XB_XGEN(j)  (2304 + 64 * (j))
#define XB_TOP      3328
#define XB_TOPGEN   3392
#define XCD_BAR_WORDS 3456
#define XB_SPIN_CAP (1u << 18)
__device__ __forceinline__ unsigned xb_ld(unsigned* p)              { return __hip_atomic_load(p, __ATOMIC_RELAXED, __HIP_MEMORY_SCOPE_AGENT); }
__device__ __forceinline__ unsigned xb_add(unsigned* p, unsigned v) { return __hip_atomic_fetch_add(p, v, __ATOMIC_RELAXED, __HIP_MEMORY_SCOPE_AGENT); }
__device__ __forceinline__ unsigned xb_xcc_id() { return (unsigned)__builtin_amdgcn_s_getreg((3 << 11) | 20) & 0xFu; }
#define XB_SPIN(cond, bar) do { unsigned _sp = 0; while (cond) { __builtin_amdgcn_s_sleep(1); \
    if ((++_sp & 255u) == 0u) { if (xb_ld(&(bar)[XB_TMO])) break; if (_sp > XB_SPIN_CAP) { atomicAdd(&(bar)[XB_TMO], 1u); break; } } } } while (0)
struct XcdBarrier { unsigned* bar; unsigned x; volatile LAS unsigned* st; };
__device__ __forceinline__ XcdBarrier xcd_barrier_post(unsigned* bar, volatile LAS unsigned* st) {
    XcdBarrier b; b.bar = bar; b.x = xb_xcc_id(); b.st = st;
    if (threadIdx.x == 0) (void)xb_add(&bar[XB_XCNT(b.x)], 1u);
    return b;
}
__device__ __forceinline__ void xcd_barrier_complete(unsigned* bar, unsigned x, unsigned& nloc, unsigned& nx) {
    const unsigned G = gridDim.x * gridDim.y * gridDim.z;
    unsigned sum, cnt, mine, sp = 0u;
    for (;;) {
        sum = 0u; cnt = 0u; mine = 0u;
#pragma unroll
        for (unsigned j = 0; j < 16; ++j) { const unsigned c = xb_ld(&bar[XB_XCNT(j)]); sum += c; cnt += (c > 0u) ? 1u : 0u; mine = (j == x) ? c : mine; }
        if (sum == G) break;
        __builtin_amdgcn_s_sleep(1);
        if ((++sp & 255u) == 0u) { if (xb_ld(&bar[XB_TMO])) break; if (sp > XB_SPIN_CAP) { atomicAdd(&bar[XB_TMO], 1u); break; } }
    }
    nloc = mine > 0u ? mine : 1u; nx = cnt > 0u ? cnt : 1u;
}
__device__ __forceinline__ void xcd_barrier(const XcdBarrier& b) {
    asm volatile("s_waitcnt vmcnt(0)" ::: "memory");
    __syncthreads();
    if (threadIdx.x == 0) {
        unsigned* bar = b.bar;
        __builtin_amdgcn_s_waitcnt(0);
        unsigned nloc = b.st[0], nx = b.st[1];
        if (nloc == 0u) { xcd_barrier_complete(bar, b.x, nloc, nx); b.st[0] = nloc; b.st[1] = nx; }
        const unsigned old = xb_add(&bar[XB_XSUB(b.x)], 1u);
        const unsigned gen = old / nloc;
        if (old + 1u == (gen + 1u) * nloc) {
            __builtin_amdgcn_fence(__ATOMIC_RELEASE, "agent");
            asm volatile("s_waitcnt vmcnt(0)" ::: "memory");
            const unsigned og = xb_add(&bar[XB_TOP], 1u);
            const unsigned tg = og / nx;
            if (og + 1u == (tg + 1u) * nx) xb_add(&bar[XB_TOPGEN], 1u);
            else XB_SPIN(xb_ld(&bar[XB_TOPGEN]) == tg, bar);
            __builtin_amdgcn_fence(__ATOMIC_ACQUIRE, "agent");
            xb_add(&bar[XB_XGEN(b.x)], 1u);
            asm volatile("s_waitcnt vmcnt(0)" ::: "memory");
        } else {
            XB_SPIN(xb_ld(&bar[XB_XGEN(b.x)]) == gen, bar);
            __builtin_amdgcn_fence(__ATOMIC_ACQUIRE, "agent");
            asm volatile("s_waitcnt vmcnt(0)" ::: "memory");
        }
    }
    __syncthreads();
}

__global__ void __launch_bounds__(512, 2) fwd_kernel(Args a) {
    extern __shared__ __attribute__((aligned(16))) unsigned char lds_raw[];
    LAS unsigned char* lds = (LAS unsigned char*)lds_raw;
    const int tid = threadIdx.x, lane = tid & 63, wave = __builtin_amdgcn_readfirstlane(tid >> 6);
    const int lo = a.ph_lo, hi = a.ph_hi;
    unsigned char* ws = a.ws;
#define IN(k) (lo <= (k) && (k) < hi)
    volatile LAS unsigned* bst = (volatile LAS unsigned*)(lds + LDS_BYTES - 64);
    if (tid == 0) { bst[0] = 0u; bst[1] = 0u; }
    __syncthreads();
    (void)xcd_barrier_post((unsigned*)(ws + WS_CTL), bst);
    if (lo == 12345) cg::this_grid().sync();
#define SEAM(k) do { if (IN(k) && IN((k) + 1)) { XcdBarrier gb_; gb_.bar = (unsigned*)(ws + WS_CTL); gb_.x = xb_xcc_id(); gb_.st = (volatile LAS unsigned*)(lds + LDS_BYTES - 64); xcd_barrier(gb_); } } while (0)
    if (IN(0)) { p0_prologue(a, lds, wave, lane); }
    SEAM(0);
    if (IN(1)) {
        SchedA S; S.init(T, NIN, gridDim.x, blockIdx.x); S.XB = (const char*)(ws + WS_XB); S.W = (const char*)(ws + WS_WIN);
        EpiA E; E.ws = ws; E.GA = (bf16_t*)a.out;
        E.qn_a = a.in[4]; E.kn_a = a.in[5]; E.qn_b = a.in[7]; E.kn_b = a.in[8];
        pg8::gemm_phase<EpiA, SchedA>(lds, S, E);
    }
    SEAM(1);
    if (IN(2)) {
        AttnP P; P.QA = (const bf16_t*)(ws + WS_QA); P.KA = (const bf16_t*)(ws + WS_KA); P.VAT = (const bf16_t*)(ws + WS_VAT); P.ZA = (const bf16_t*)(ws + WS_ZA);
        P.QB = (const bf16_t*)(ws + WS_QB); P.KB = (const bf16_t*)(ws + WS_KB); P.VBT = (const bf16_t*)(ws + WS_VBT); P.ZB = (const bf16_t*)(ws + WS_ZB);
        P.Y = (bf16_t*)(ws + WS_Y); P.sink = a.in[9]; P.rpb = a.in[6];
        float shiftA, shiftB; bool fast;
        { float mqa = fabsf(a.in[4][lane]), mka = fabsf(a.in[5][lane]), mqb = fabsf(a.in[7][lane]), mkb = fabsf(a.in[8][lane]), msk = fabsf(a.in[9][lane & 7]), mr = 0.f;
          for (int i = tid; i < 8 * 465; i += 512) mr = fmaxf(mr, fabsf(a.in[6][i]));
#pragma unroll
          for (int o = 1; o < 64; o <<= 1) { mqa = fmaxf(mqa, __shfl_xor(mqa, o)); mka = fmaxf(mka, __shfl_xor(mka, o)); mqb = fmaxf(mqb, __shfl_xor(mqb, o)); mkb = fmaxf(mkb, __shfl_xor(mkb, o));
              msk = fmaxf(msk, __shfl_xor(msk, o)); mr = fmaxf(mr, __shfl_xor(mr, o)); }
          LAS float* red = (LAS float*)(lds + ATT_RPB);
          if (lane == 0) red[wave] = mr;
          __syncthreads();
          mr = red[0];
#pragma unroll
          for (int w = 1; w < 8; ++w) mr = fmaxf(mr, red[w]);
          __syncthreads();
          shiftA = 1.02f * (64.f * mqa * mka * QSCALE + mr * LOG2E) + 0.5f; shiftB = 1.02f * (64.f * mqb * mkb * QSCALE) + 0.5f;
          fast = (shiftA < 60.f) && (shiftB < 60.f) && (msk * LOG2E < 60.f); }
        AttStage<true> swa_st; AttQZ swa_qz;
        const bool pre = ((3072 + (int)gridDim.x - 1) / (int)gridDim.x) * (int)blockIdx.x < 3072;
        na_phase(P, lds, tid, wave, lane, fast, shiftA, swa_st, swa_qz);
        att_phase<true>(P, lds, tid, wave, lane, fast, shiftB, swa_st, swa_qz, pre);
    }
    SEAM(2);
    if (IN(3)) {
        SchedP S; S.init(T, 1024, gridDim.x, blockIdx.x); S.A = (const char*)(ws + WS_Y); S.W = (const char*)(ws + WS_WAB);
        EpiC1 E; E.GA = (const bf16_t*)a.out; E.GB = (const bf16_t*)a.out + (size_t)T * 1024; E.MG = (bf16_t*)(ws + WS_MG);
        pg8::gemm_phase<EpiC1, SchedP>(lds, S, E);
    }
    SEAM(3);
    if (IN(4)) {
        SchedP S; S.init(T, 1024, gridDim.x, blockIdx.x); S.A = (const char*)(ws + WS_MG); S.W = (const char*)(ws + WS_WO);
        EpiC2 E; E.xp = a.in[0]; E.xs = a.in[1]; E.out = a.out;
        pg8::gemm_phase<EpiC2, SchedP>(lds, S, E, true);
    }
#undef IN
#undef SEAM
}

extern "C" void kernel_launch(void* const* d_in, const int* in_sizes, int n_in, void* d_out, int out_size, void* d_ws, size_t ws_size, hipStream_t stream) {
    static int grid = 0;
    if (grid == 0) {
        if (n_in != 13 || out_size != T * D || ws_size < WS_END) { fprintf(stderr, "kernel_launch: unexpected shapes (n_in %d out %d ws %zu)\n", n_in, out_size, ws_size); grid = -1; return; }
        int dev = 0, cus = 0;
        if (hipGetDevice(&dev) != hipSuccess || hipDeviceGetAttribute(&cus, hipDeviceAttributeMultiprocessorCount, dev) != hipSuccess) { grid = -1; return; }
        if (hipFuncSetAttribute((const void*)fwd_kernel, hipFuncAttributeMaxDynamicSharedMemorySize, LDS_BYTES) != hipSuccess) { fprintf(stderr, "kernel_launch: hipFuncSetAttribute failed\n"); grid = -1; return; }
        int per_cu = 0;
        if (hipOccupancyMaxActiveBlocksPerMultiprocessor(&per_cu, (const void*)fwd_kernel, 512, LDS_BYTES) != hipSuccess || per_cu < 1) fprintf(stderr, "kernel_launch: occupancy query says %d\n", per_cu);
        (void)hipGetLastError();
        grid = cus;
    }
    if (grid < 0) return;
    hipMemsetAsync((char*)d_ws + WS_CTL, 0, CTL_BYTES, stream);
    Args a{};
    for (int i = 0; i < 13; ++i) a.in[i] = (const float*)d_in[i];
    a.out = (float*)d_out; a.ws = (unsigned char*)d_ws;
    if (N_LAUNCHES == 1) {
        a.ph_lo = 0; a.ph_hi = 5;
        void* args[] = {&a};
        hipError_t e = hipLaunchCooperativeKernel((const void*)fwd_kernel, dim3(grid), dim3(512), args, LDS_BYTES, stream);
        if (e != hipSuccess) fprintf(stderr, "cooperative launch failed: %s (grid %d)\n", hipGetErrorString(e), grid);
    } else {
        for (int p = 0; p < 5; ++p) {
            a.ph_lo = p; a.ph_hi = p + 1; hipLaunchKernelGGL(fwd_kernel, dim3(grid), dim3(512), LDS_BYTES, stream, a); }
    }
}
```

```cpp
#include <hip/hip_runtime.h>
#include <hip/hip_cooperative_groups.h>
#include <cstdio>
namespace cg = cooperative_groups;

#ifndef N_LAUNCHES
#define N_LAUNCHES 1
#endif

#define LAS __attribute__((address_space(3)))
typedef unsigned short bf16_t;
typedef short bf16x8 __attribute__((ext_vector_type(8)));
typedef short bf16x4 __attribute__((ext_vector_type(4)));
typedef float f32x4 __attribute__((ext_vector_type(4)));
typedef unsigned u32x4 __attribute__((ext_vector_type(4)));
typedef unsigned u32x2 __attribute__((ext_vector_type(2)));

constexpr int T = 49152, TP = 32768, D = 1024, NIN = 5376, SEQ = 4096;
constexpr float LOG2E = 1.4426950408889634f;
constexpr float QSCALE = 0.125f * LOG2E;
constexpr float NORM_EPS = 1e-6f;
constexpr size_t MiB = 1u << 20;
constexpr size_t WS_WIN = 0, WS_WAB = 11 * MiB, WS_WO = 13 * MiB, WS_ROPE = 15 * MiB, WS_XB = 17 * MiB, WS_QA = 113 * MiB, WS_KA = 161 * MiB, WS_QB = 209 * MiB,
                 WS_ZA = 257 * MiB, WS_ZB = 305 * MiB, WS_VAT = 353 * MiB, WS_KB = 401 * MiB, WS_VBT = 413 * MiB, WS_END = 425 * MiB;
constexpr size_t WS_CTL = 11 * MiB - 65536, CTL_BYTES = 16384;
constexpr size_t WS_Y = WS_XB;
constexpr size_t WS_MG = WS_QA;
constexpr int LDS_BYTES = 155648;

typedef __bf16 bf16x2_t __attribute__((ext_vector_type(2)));
typedef float f32x2_t __attribute__((ext_vector_type(2)));
__device__ __forceinline__ unsigned cvt_pk_bf16(float lo, float hi) { const f32x2_t v = {lo, hi}; const bf16x2_t r = __builtin_convertvector(v, bf16x2_t); return __builtin_bit_cast(unsigned, r); }
__device__ __forceinline__ float bf_lo(unsigned w) { return __uint_as_float(w << 16); }
__device__ __forceinline__ float bf_hi(unsigned w) { return __uint_as_float(w & 0xffff0000u); }
__device__ __forceinline__ float fast_sigmoid(float v) { return __builtin_amdgcn_rcpf(1.0f + __builtin_amdgcn_exp2f(-v * LOG2E)); }

namespace pg8 {
constexpr int BM = 256, BK = 64, HALF = 128, HTB = HALF * BK * 2, STAGE_BYTES = 8 * HTB, NXCD = 8, WGM = 8, K = 1024;
__device__ __forceinline__ int lds_byte(int r, int c) { const int st = (r >> 4) * 2 + (c >> 5), rr = r & 15, cc = c & 31, ob = rr * 64 + cc * 2; return st * 1024 + (ob ^ (((ob >> 9) & 1) << 5)); }
__device__ __forceinline__ void stage_rc(int b, int& R, int& C) { const int st = b / 1024, sb = b % 1024, swz = sb ^ (((sb >> 9) & 1) << 5); R = (st >> 1) * 16 + swz / 64; C = (st & 1) * 32 + (swz % 64) / 2; }
__device__ __forceinline__ int perm32(int rho) { const int n = rho >> 4, i = rho & 15; return 8 * (i >> 2) + 4 * n + (i & 3); }
struct Unit { int pm, pn; };
struct StaticOrder {
    int nM, nN, nwg, G, c;
    __device__ void init(int M, int N, int G_, int c_) { nM = M / BM; nN = N / BM; nwg = nM * nN; G = G_; c = c_; }
    __device__ bool next(int i, Unit& u) const {
        const long L = (long)i * G + c; if (L >= nwg) return false;
        int wgid = (int)L; { const int q = nwg / NXCD, r = nwg % NXCD, xcd = wgid % NXCD, off = wgid / NXCD; wgid = (xcd < r ? xcd * (q + 1) : r * (q + 1) + (xcd - r) * q) + off; }
        const int nig = WGM * nN, gid = wgid / nig, fm = gid * WGM, gsz = (nM - fm) < WGM ? (nM - fm) : WGM;
        u.pm = fm + ((wgid % nig) % gsz); u.pn = (wgid % nig) / gsz; return true;
    }
};
template <class Epi, class Sched>
__device__ __forceinline__ void gemm_phase(LAS unsigned char* lds, const Sched& S, const Epi& E, bool natural = false) {
    const int tid = threadIdx.x, wid = __builtin_amdgcn_readfirstlane(tid >> 6), lane = tid & 63, wr = wid >> 2, wc = wid & 3, fr = lane & 15, fq = lane >> 4;
    constexpr int nt = K / BK;
    unsigned voffA[2], voffB0[2], voffB1[2];
#pragma unroll
    for (int i = 0; i < 2; ++i) { int R, C; stage_rc(tid * 16 + i * 8192, R, C);
        const int Rb = 64 * (R >> 5) + (natural ? (R & 31) : perm32(R & 31));
        voffA[i] = (unsigned)(R * K + C) * 2u; voffB0[i] = (unsigned)(Rb * K + C) * 2u; voffB1[i] = (unsigned)((Rb + 32) * K + C) * 2u; }
    constexpr size_t kstep = (size_t)(BK * 2);
    constexpr size_t hstep = (size_t)HALF * K * 2;
    const unsigned ldsw = (unsigned)wid * 1024u;
    const int aoff = lds_byte(wr * 64 + fr, fq * 8), boff = lds_byte(wc * 32 + fr, fq * 8);
#define PG8_SA(b, h) (((b) * 2 + (h)) * HTB)
#define PG8_SB(b, h) ((4 + (b) * 2 + (h)) * HTB)
#define PG8_STAGE(bufoff, gbase, voff) do { _Pragma("unroll") for (int _i = 0; _i < 2; ++_i) \
        __builtin_amdgcn_global_load_lds((const unsigned*)((const char*)(gbase) + (voff)[_i]), (LAS unsigned*)(lds + (bufoff) + ldsw + _i * 8192), 16, 0, 0); } while (0)
#define PG8_LDA(dst, b, h) do { _Pragma("unroll") for (int m = 0; m < 4; ++m) _Pragma("unroll") for (int k = 0; k < 2; ++k) dst[m][k] = *(const LAS bf16x8*)(lds + PG8_SA(b, h) + aoff + m * 2048 + k * 1024); } while (0)
#define PG8_LDB(dst, b, h) do { _Pragma("unroll") for (int n = 0; n < 2; ++n) _Pragma("unroll") for (int k = 0; k < 2; ++k) dst[n][k] = *(const LAS bf16x8*)(lds + PG8_SB(b, h) + boff + n * 2048 + k * 1024); } while (0)
#define PG8_MMA(ai, bj, At, Bt) do { __builtin_amdgcn_s_setprio(1); _Pragma("unroll") for (int m = 0; m < 4; ++m) _Pragma("unroll") for (int n = 0; n < 2; ++n) _Pragma("unroll") for (int k = 0; k < 2; ++k) \
        acc[ai][bj][m][n] = __builtin_amdgcn_mfma_f32_16x16x32_bf16(Bt[n][k], At[m][k], acc[ai][bj][m][n], 0, 0, 0); __builtin_amdgcn_s_setprio(0); } while (0)
#define PG8_WAIT_V(n) asm volatile("s_waitcnt vmcnt(" #n ")" ::: "memory")
#define PG8_WAIT_L(n) asm volatile("s_waitcnt lgkmcnt(" #n ")" ::: "memory")
#define PG8_BAR __builtin_amdgcn_s_barrier()
#define PG8_SCHED __builtin_amdgcn_sched_barrier(0)
    Unit cur, nxt; int ui = 0;
    if (!S.next(0, cur)) return;
    f32x4 acc[2][2][4][2];
#pragma unroll
    for (int a = 0; a < 2; ++a)
#pragma unroll
        for (int b = 0; b < 2; ++b)
#pragma unroll
            for (int m = 0; m < 4; ++m)
#pragma unroll
                for (int n = 0; n < 2; ++n) acc[a][b][m][n] = (f32x4){0.f, 0.f, 0.f, 0.f};
    bf16x8 At[4][2], B0[2][2], B1[2][2];
    const char* cA; const char* cB; S.ptrs(cur, cA, cB);
    PG8_STAGE(PG8_SB(0, 0), cB, voffB0); PG8_STAGE(PG8_SB(0, 1), cB, voffB1); PG8_STAGE(PG8_SA(0, 0), cA, voffA); PG8_STAGE(PG8_SA(0, 1), cA + hstep, voffA);
    if (wr == 1) PG8_BAR;
    PG8_WAIT_V(2); PG8_BAR;
    PG8_STAGE(PG8_SB(1, 0), cB + kstep, voffB0); PG8_STAGE(PG8_SA(1, 0), cA + kstep, voffA); PG8_STAGE(PG8_SB(1, 1), cB + kstep, voffB1);
    PG8_WAIT_V(6); PG8_BAR;
    for (;;) {
        const bool has_next = S.next(ui + 1, nxt);
        const char* nA = cA; const char* nB = cB; if (has_next) S.ptrs(nxt, nA, nB);
        for (int t = 0; t < nt; t += 2) {
            const bool last = (t == nt - 2);
            const char* a1 = cA + (size_t)(t + 1) * kstep;
            const char* a2 = last ? nA : cA + (size_t)(t + 2) * kstep; const char* b2 = last ? nB : cB + (size_t)(t + 2) * kstep;
            const char* a3 = a2 + kstep; const char* b3 = b2 + kstep;
            if constexpr (Epi::MIDHOOK) { if (t == nt / 2) E.mid(acc, cur, wr, wc, fr, fq); }
            PG8_LDB(B0, 0, 0); PG8_LDB(B1, 0, 1); PG8_SCHED; PG8_LDA(At, 0, 0); PG8_STAGE(PG8_SA(1, 1), a1 + hstep, voffA);
            PG8_WAIT_V(8); PG8_WAIT_L(0); PG8_BAR; PG8_MMA(0, 0, At, B0); PG8_MMA(0, 1, At, B1); PG8_BAR; PG8_SCHED;
            PG8_LDA(At, 0, 1); PG8_STAGE(PG8_SB(0, 0), b2, voffB0); PG8_STAGE(PG8_SB(0, 1), b2, voffB1); PG8_STAGE(PG8_SA(0, 0), a2, voffA);
            PG8_WAIT_V(8); PG8_WAIT_L(0); PG8_BAR; PG8_MMA(1, 0, At, B0); PG8_MMA(1, 1, At, B1); PG8_BAR; PG8_SCHED;
            PG8_LDB(B0, 1, 0); PG8_LDB(B1, 1, 1); PG8_SCHED; PG8_LDA(At, 1, 0); PG8_STAGE(PG8_SA(0, 1), a2 + hstep, voffA);
            PG8_WAIT_V(8); PG8_WAIT_L(0); PG8_BAR; PG8_MMA(0, 0, At, B0); PG8_MMA(0, 1, At, B1); PG8_BAR; PG8_SCHED;
            PG8_LDA(At, 1, 1); PG8_STAGE(PG8_SB(1, 0), b3, voffB0); PG8_STAGE(PG8_SB(1, 1), b3, voffB1); PG8_STAGE(PG8_SA(1, 0), a3, voffA);
            PG8_WAIT_V(8); PG8_WAIT_L(0); PG8_BAR; PG8_MMA(1, 0, At, B0); PG8_MMA(1, 1, At, B1); PG8_BAR; PG8_SCHED;
        }
        if (wr == 0) PG8_BAR;
        E(acc, cur, wr, wc, fr, fq);
        if (!has_next) break;
#pragma unroll
        for (int a = 0; a < 2; ++a)
#pragma unroll
            for (int b = 0; b < 2; ++b)
#pragma unroll
                for (int m = 0; m < 4; ++m)
#pragma unroll
                    for (int n = 0; n < 2; ++n) acc[a][b][m][n] = (f32x4){0.f, 0.f, 0.f, 0.f};
        cur = nxt; cA = nA; cB = nB; ++ui;
        if (wr == 1) PG8_BAR;
    }
    PG8_WAIT_V(0);
    PG8_BAR;
#undef PG8_SA
#undef PG8_SB
#undef PG8_STAGE
#undef PG8_LDA
#undef PG8_LDB
#undef PG8_MMA
#undef PG8_WAIT_V
#undef PG8_WAIT_L
#undef PG8_BAR
#undef PG8_SCHED
}
}
using pg8::Unit;
typedef f32x4 AccT[2][2][4][2];

__device__ const float ROPE_IREV[32] = {1.591549367e-01f, 1.193493679e-01f, 8.949939907e-02f, 6.711508334e-02f, 5.032921210e-02f, 3.774158657e-02f, 2.830219641e-02f, 2.122365311e-02f,
    1.591549441e-02f, 1.193493698e-02f, 8.949940093e-03f, 6.711508147e-03f, 5.032920744e-03f, 3.774158657e-03f, 2.830219688e-03f, 2.122365171e-03f,
    1.591549371e-03f, 1.193493721e-03f, 8.949940093e-04f, 6.711508031e-04f, 5.032921326e-04f, 3.774158540e-04f, 2.830219746e-04f, 2.122365258e-04f,
    1.591549517e-04f, 1.193493663e-04f, 8.949940093e-05f, 6.711508468e-05f, 5.032921035e-05f, 3.774158540e-05f, 2.830219637e-05f, 2.122365368e-05f};
struct SchedA : pg8::StaticOrder {
    const char* XB; const char* W;
    __device__ __forceinline__ void ptrs(const Unit& u, const char*& cA, const char*& cB) const {
        const char* x = XB + (size_t)u.pm * (256 * 1024 * 2); const char* w = W + (size_t)u.pn * (256 * 1024 * 2);
        if (u.pn >= 19) { cA = w; cB = x; } else { cA = x; cB = w; }
    }
};
struct SchedP : pg8::StaticOrder {
    const char* A; const char* W;
    __device__ __forceinline__ void ptrs(const Unit& u, const char*& cA, const char*& cB) const { cA = A + (size_t)u.pm * (256 * 1024 * 2); cB = W + (size_t)u.pn * (256 * 1024 * 2); }
};

struct EpiA {
    static constexpr bool MIDHOOK = false;
    unsigned char* ws; bf16_t* GA;
    const float *qn_a, *kn_a, *qn_b, *kn_b;
    __device__ __forceinline__ void mid(AccT&, const Unit&, int, int, int, int) const {}
    __device__ __forceinline__ void qk(const AccT& acc, int row0, int wr, int fr, int fq, bf16_t* dst, int ld, int colh, const float* w, float scale, bool rope) const {
        f32x4 wv[2][2];
        int fq8 = 8 * fq; asm volatile("" : "+v"(fq8));
#pragma unroll
        for (int bj = 0; bj < 2; ++bj)
#pragma unroll
            for (int n = 0; n < 2; ++n) wv[bj][n] = *(const f32x4*)(w + 32 * bj + fq8 + 4 * n) * scale;
        f32x4 irev[2];
#pragma unroll
        for (int n = 0; n < 2; ++n) irev[n] = rope ? *(const f32x4*)(ROPE_IREV + fq8 + 4 * n) : (f32x4){0.f, 0.f, 0.f, 0.f};
#pragma unroll
        for (int ai = 0; ai < 2; ++ai)
#pragma unroll
            for (int m = 0; m < 4; ++m) {
                const int r = row0 + 128 * ai + 64 * wr + 16 * m + fr;
                f32x4 v[2][2]; float ss = 0.f;
#pragma unroll
                for (int bj = 0; bj < 2; ++bj)
#pragma unroll
                    for (int n = 0; n < 2; ++n) { v[bj][n] = acc[ai][bj][m][n]; const f32x4 x = v[bj][n]; ss += (x[0] * x[0] + x[1] * x[1]) + (x[2] * x[2] + x[3] * x[3]); }
                ss += __shfl_xor(ss, 16); ss += __shfl_xor(ss, 32);
                const float inv = __builtin_amdgcn_rsqf(ss * (1.0f / 64.0f) + NORM_EPS);
#pragma unroll
                for (int bj = 0; bj < 2; ++bj)
#pragma unroll
                    for (int n = 0; n < 2; ++n) v[bj][n] = v[bj][n] * inv * wv[bj][n];
                if (rope) {
                    const float fp = (float)(r & (SEQ - 1));
#pragma unroll
                    for (int n = 0; n < 2; ++n) {
                        f32x4 c, s;
#pragma unroll
                        for (int j = 0; j < 4; ++j) { const float fr_ = __builtin_amdgcn_fractf(fp * irev[n][j]); c[j] = __builtin_amdgcn_cosf(fr_); s[j] = __builtin_amdgcn_sinf(fr_); }
                        const f32x4 x1 = v[0][n], x2 = v[1][n];
                        v[0][n] = x1 * c - x2 * s; v[1][n] = x2 * c + x1 * s;
                    }
                }
                bf16_t* rowp = dst + (size_t)r * ld + colh + 8 * fq;
#pragma unroll
                for (int bj = 0; bj < 2; ++bj) { u32x4 o; o.x = cvt_pk_bf16(v[bj][0][0], v[bj][0][1]); o.y = cvt_pk_bf16(v[bj][0][2], v[bj][0][3]); o.z = cvt_pk_bf16(v[bj][1][0], v[bj][1][1]); o.w = cvt_pk_bf16(v[bj][1][2], v[bj][1][3]);
                    *(u32x4*)(rowp + 32 * bj) = o; }
            }
    }
    __device__ __forceinline__ void act(const AccT& acc, int row0, int wr, int wc, int fr, int fq, bf16_t* dst, int ld, int col0) const {
#pragma unroll
        for (int ai = 0; ai < 2; ++ai)
#pragma unroll
            for (int m = 0; m < 4; ++m) {
                const int r = row0 + 128 * ai + 64 * wr + 16 * m + fr;
                bf16_t* rowp = dst + (size_t)r * ld + col0 + 64 * wc + 8 * fq;
#pragma unroll
                for (int bj = 0; bj < 2; ++bj) { unsigned w[4];
#pragma unroll
                    for (int n = 0; n < 2; ++n)
#pragma unroll
                        for (int h = 0; h < 2; ++h) { const f32x2_t x = {acc[ai][bj][m][n][2 * h], acc[ai][bj][m][n][2 * h + 1]};
                            const f32x2_t t = x * (-LOG2E); f32x2_t e; e[0] = __builtin_amdgcn_exp2f(t[0]); e[1] = __builtin_amdgcn_exp2f(t[1]);
                            const f32x2_t d = e + 1.0f; f32x2_t sg; sg[0] = __builtin_amdgcn_rcpf(d[0]); sg[1] = __builtin_amdgcn_rcpf(d[1]);
                            const f32x2_t o = x * sg; w[2 * n + h] = cvt_pk_bf16(o[0], o[1]); }
                    u32x4 wv; wv.x = w[0]; wv.y = w[1]; wv.z = w[2]; wv.w = w[3];
                    *(u32x4*)(rowp + 32 * bj) = wv; }
            }
    }
    __device__ __forceinline__ void operator()(AccT& acc, const Unit& u, int wr, int wc, int fr, int fq) const {
        const int pn = u.pn, row0 = u.pm * 256;
        bf16_t* const QA = (bf16_t*)(ws + WS_QA); bf16_t* const KA = (bf16_t*)(ws + WS_KA); bf16_t* const QB = (bf16_t*)(ws + WS_QB); bf16_t* const KB = (bf16_t*)(ws + WS_KB);
        bf16_t* const VBT = (bf16_t*)(ws + WS_VBT); bf16_t* const ZA = (bf16_t*)(ws + WS_ZA); bf16_t* const ZB = (bf16_t*)(ws + WS_ZB); bf16_t* const VAT = (bf16_t*)(ws + WS_VAT);
        bf16_t* const GB = GA + (size_t)T * 1024;
        if (pn < 2) qk(acc, row0, wr, fr, fq, QA, 512, 256 * pn + 64 * wc, qn_a, QSCALE, false);
        else if (pn < 4) qk(acc, row0, wr, fr, fq, KA, 512, 256 * (pn - 2) + 64 * wc, kn_a, 1.0f, false);
        else if (pn < 6) qk(acc, row0, wr, fr, fq, QB, 512, 256 * (pn - 4) + 64 * wc, qn_b, QSCALE, true);
        else if (pn == 6) {
            if (wc < 2) qk(acc, row0, wr, fr, fq, KB, 128, 64 * wc, kn_b, 1.0f, true);
            else {
#pragma unroll
                for (int ai = 0; ai < 2; ++ai)
#pragma unroll
                    for (int m = 0; m < 4; ++m) {
                        const int r = row0 + 128 * ai + 64 * wr + 16 * m + fr;
                        bf16_t* base = VBT + ((size_t)(r >> 3) * 128 + 64 * (wc - 2) + 8 * fq) * 8 + (r & 7);
#pragma unroll
                        for (int bj = 0; bj < 2; ++bj)
#pragma unroll
                            for (int n = 0; n < 2; ++n) { const f32x4 x = acc[ai][bj][m][n];
                                const unsigned p0 = cvt_pk_bf16(x[0], x[1]), p1 = cvt_pk_bf16(x[2], x[3]);
                                bf16_t* q = base + (32 * bj + 4 * n) * 8;
                                q[0] = (bf16_t)(p0 & 0xffffu); q[8] = (bf16_t)(p0 >> 16); q[16] = (bf16_t)(p1 & 0xffffu); q[24] = (bf16_t)(p1 >> 16); }
                    }
            }
        }
        else if (pn < 9) act(acc, row0, wr, wc, fr, fq, ZA, 512, 256 * (pn - 7));
        else if (pn < 11) act(acc, row0, wr, wc, fr, fq, ZB, 512, 256 * (pn - 9));
        else if (pn < 19) {
#pragma unroll
            for (int ai = 0; ai < 2; ++ai)
#pragma unroll
                for (int m = 0; m < 4; ++m) {
                    const int r = row0 + 128 * ai + 64 * wr + 16 * m + fr;
                    unsigned Rw[4], Sw[4];
#pragma unroll
                    for (int n = 0; n < 2; ++n)
#pragma unroll
                        for (int h = 0; h < 2; ++h) { const f32x2_t a2 = {acc[ai][0][m][n][2 * h], acc[ai][0][m][n][2 * h + 1]}, b2 = {acc[ai][1][m][n][2 * h], acc[ai][1][m][n][2 * h + 1]};
                            const f32x2_t ta = a2 * (-LOG2E), tb = b2 * (-LOG2E); f32x2_t ea, eb;
                            ea[0] = __builtin_amdgcn_exp2f(ta[0]); ea[1] = __builtin_amdgcn_exp2f(ta[1]); eb[0] = __builtin_amdgcn_exp2f(tb[0]); eb[1] = __builtin_amdgcn_exp2f(tb[1]);
                            const f32x2_t ua = ea + 1.0f, ub = eb + 1.0f, pr = ua * ub; f32x2_t t; t[0] = __builtin_amdgcn_rcpf(pr[0]); t[1] = __builtin_amdgcn_rcpf(pr[1]);
                            const f32x2_t S2 = t * ua, R2 = t * ub * ub;
                            Sw[2 * n + h] = cvt_pk_bf16(S2[0], S2[1]); Rw[2 * n + h] = cvt_pk_bf16(R2[0], R2[1]); }
                    const size_t off = (size_t)r * 1024 + 128 * (pn - 11) + 32 * wc + 8 * fq;
                    u32x4 w; w.x = Rw[0]; w.y = Rw[1]; w.z = Rw[2]; w.w = Rw[3];
                    *(u32x4*)(GA + off) = w;
                    w.x = Sw[0]; w.y = Sw[1]; w.z = Sw[2]; w.w = Sw[3];
                    *(u32x4*)(GB + off) = w;
                }
        }
        else {
            const int c0 = 256 * (pn - 19);
#pragma unroll
            for (int ai = 0; ai < 2; ++ai)
#pragma unroll
                for (int m = 0; m < 4; ++m) {
                    const int c = c0 + 128 * ai + 64 * wr + 16 * m + fr;
#pragma unroll
                    for (int bj = 0; bj < 2; ++bj) {
                        const int t0 = row0 + 64 * wc + 32 * bj + 8 * fq;
                        const f32x4 x0 = acc[ai][bj][m][0], x1 = acc[ai][bj][m][1];
                        u32x4 o; o.x = cvt_pk_bf16(x0[0], x0[1]); o.y = cvt_pk_bf16(x0[2], x0[3]); o.z = cvt_pk_bf16(x1[0], x1[1]); o.w = cvt_pk_bf16(x1[2], x1[3]);
                        *(u32x4*)(VAT + ((size_t)(t0 >> 3) * 512 + c) * 8) = o; }
                }
        }
    }
};

struct EpiC1 {
    static constexpr bool MIDHOOK = true;
    const bf16_t *GA, *GB; bf16_t* MG;
    __device__ __forceinline__ void mid(AccT& acc, const Unit& u, int wr, int wc, int fr, int fq) const {
        unsigned base = (unsigned)((u.pm * 256 + 64 * wr + fr) * 1024 + u.pn * 256 + 64 * wc + 8 * fq) * 2u;
        asm volatile("" : "+v"(base));
#pragma unroll
        for (int ai = 0; ai < 2; ++ai)
#pragma unroll
            for (int m = 0; m < 4; ++m) {
#pragma unroll
                for (int bj = 0; bj < 2; ++bj) {
                    const unsigned off = base + (unsigned)((128 * ai + 16 * m) * 1024 + 32 * bj) * 2u;
                    const u32x4 a = *(const u32x4*)((const char*)GA + off);
                    f32x4 r0, r1;
                    r0[0] = bf_lo(a.x); r0[1] = bf_hi(a.x); r0[2] = bf_lo(a.y); r0[3] = bf_hi(a.y);
                    r1[0] = bf_lo(a.z); r1[1] = bf_hi(a.z); r1[2] = bf_lo(a.w); r1[3] = bf_hi(a.w);
                    acc[ai][bj][m][0] *= r0; acc[ai][bj][m][1] *= r1;
                }

            }
    }
    __device__ __forceinline__ void operator()(AccT& acc, const Unit& u, int wr, int wc, int fr, int fq) const {
        unsigned base = (unsigned)((u.pm * 256 + 64 * wr + fr) * 1024 + u.pn * 256 + 64 * wc + 8 * fq) * 2u;
        asm volatile("" : "+v"(base));
        u32x4 sv[2][4][2];
#pragma unroll
        for (int ai = 0; ai < 2; ++ai)
#pragma unroll
            for (int m = 0; m < 4; ++m)
#pragma unroll
                for (int bj = 0; bj < 2; ++bj) sv[ai][m][bj] = *(const u32x4*)((const char*)GB + base + (unsigned)((128 * ai + 16 * m) * 1024 + 32 * bj) * 2u);
#pragma unroll
        for (int ai = 0; ai < 2; ++ai)
#pragma unroll
            for (int m = 0; m < 4; ++m) {
#pragma unroll
                for (int bj = 0; bj < 2; ++bj) {
                    const unsigned off = base + (unsigned)((128 * ai + 16 * m) * 1024 + 32 * bj) * 2u;
                    const u32x4 b = sv[ai][m][bj];
                    const f32x4 x0 = acc[ai][bj][m][0], x1 = acc[ai][bj][m][1];
                    u32x4 o; o.x = cvt_pk_bf16(x0[0] * bf_lo(b.x), x0[1] * bf_hi(b.x)); o.y = cvt_pk_bf16(x0[2] * bf_lo(b.y), x0[3] * bf_hi(b.y));
                    o.z = cvt_pk_bf16(x1[0] * bf_lo(b.z), x1[1] * bf_hi(b.z)); o.w = cvt_pk_bf16(x1[2] * bf_lo(b.w), x1[3] * bf_hi(b.w));
                    *(u32x4*)((char*)MG + off) = o;
                }
            }
    }
};
struct EpiC2 {
    static constexpr bool MIDHOOK = false;
    const float *xp, *xs; float* out;
    __device__ __forceinline__ void mid(AccT&, const Unit&, int, int, int, int) const {}
    __device__ __forceinline__ void operator()(AccT& acc, const Unit& u, int wr, int wc, int fr, int fq) const {
        const int row0 = u.pm * 256;
        const char* xb = (const char*)(row0 < TP ? xp + (size_t)row0 * 1024 : xs + (size_t)(row0 - TP) * 1024);
        char* ob = (char*)(out + (size_t)row0 * 1024);
        unsigned base = (unsigned)((64 * wr + fr) * 1024 + u.pn * 256 + 64 * wc + 4 * fq) * 4u;
        asm volatile("" : "+v"(base));
#pragma unroll
        for (int ai = 0; ai < 2; ++ai) {
            f32x4 xv[4][2][2];
#pragma unroll
            for (int m = 0; m < 4; ++m)
#pragma unroll
                for (int bj = 0; bj < 2; ++bj)
#pragma unroll
                    for (int n = 0; n < 2; ++n) xv[m][bj][n] = *(const f32x4*)(xb + base + (unsigned)((128 * ai + 16 * m) * 1024 + 32 * bj + 16 * n) * 4u);
#pragma unroll
            for (int m = 0; m < 4; ++m)
#pragma unroll
                for (int bj = 0; bj < 2; ++bj)
#pragma unroll
                    for (int n = 0; n < 2; ++n) *(f32x4*)(ob + base + (unsigned)((128 * ai + 16 * m) * 1024 + 32 * bj + 16 * n) * 4u) = xv[m][bj][n] + acc[ai][bj][m][n];
            asm volatile("" ::: "memory");
        }
    }
};

__device__ __forceinline__ int map_col(int n) {
    if (n < 1024) return n;
    if (n < 1536) return 2048 + n - 1024;
    if (n < 1664) return 2560 + n - 1536;
    if (n < 1792) return 2688 + n - 1664;
    if (n < 2304) return 1536 + n - 1792;
    if (n < 2816) return 2816 + n - 2304;
    if (n < 4864) { const int w = n - 2816, tg = w >> 8, ww = w & 255, wcw = ww >> 6, bj = (ww >> 5) & 1, e = ww & 31;
        return (bj ? 4352 : 3328) + 128 * tg + 32 * wcw + e; }
    return 1024 + n - 4864;
}
__device__ __forceinline__ void p0_transpose_item(const float* W, int N, int ksrc0, int nsrc0, const float* ksc, bf16_t* WT, int nrow0, int kdst0, LAS float* scr, int lane) {
#pragma unroll 8
    for (int i = 0; i < 32; ++i) { const int kk = 2 * i + (lane >> 5); float v = W[(size_t)(ksrc0 + kk) * N + nsrc0 + (lane & 31)]; if (ksc) v *= ksc[ksrc0 + kk]; scr[kk * 33 + (lane & 31)] = v; }
    asm volatile("s_waitcnt lgkmcnt(0)" ::: "memory");
    const int c = lane & 7;
#pragma unroll
    for (int j = 0; j < 4; ++j) { const int n = (lane >> 3) + 8 * j; const LAS float* s = scr + (8 * c) * 33 + n;
        u32x4 o; o.x = cvt_pk_bf16(s[0 * 33], s[1 * 33]); o.y = cvt_pk_bf16(s[2 * 33], s[3 * 33]); o.z = cvt_pk_bf16(s[4 * 33], s[5 * 33]); o.w = cvt_pk_bf16(s[6 * 33], s[7 * 33]);
        *(u32x4*)(WT + (size_t)(nrow0 + n) * 1024 + kdst0 + 8 * c) = o; }
    asm volatile("s_waitcnt lgkmcnt(0)" ::: "memory");
}

struct Args { const float* in[13]; float* out; unsigned char* ws; int ph_lo, ph_hi; };

__device__ __forceinline__ void p0_load4(const Args& a, int m0, int NGW, int lane, f32x4 (&v)[4][4]) {
#pragma unroll
    for (int u = 0; u < 4; ++u) { const int m = min(m0 + u * NGW, T - 1);
        const float* xrow = m < TP ? a.in[0] + (size_t)m * 1024 : a.in[1] + (size_t)(m - TP) * 1024;
        const f32x4* xr = (const f32x4*)xrow + lane;
#pragma unroll
        for (int j = 0; j < 4; ++j) v[u][j] = xr[64 * j]; }
}
__device__ __forceinline__ void p0_proc4(bf16_t* XB, int m0, int NGW, int lane, const f32x4 (&v)[4][4]) {
    float s[4];
#pragma unroll
    for (int u = 0; u < 4; ++u) { float t = 0.f;
#pragma unroll
        for (int j = 0; j < 4; ++j) t += (v[u][j][0] * v[u][j][0] + v[u][j][1] * v[u][j][1]) + (v[u][j][2] * v[u][j][2] + v[u][j][3] * v[u][j][3]);
        s[u] = t; }
#pragma unroll
    for (int o = 1; o < 64; o <<= 1) {
#pragma unroll
        for (int u = 0; u < 4; ++u) s[u] += __shfl_xor(s[u], o); }
#pragma unroll
    for (int u = 0; u < 4; ++u) { const int m = m0 + u * NGW; if (m >= T) break;
        const float rstd = 1.0f / sqrtf(s[u] * (1.0f / 1024.0f) + NORM_EPS);
        u32x2* o8 = (u32x2*)(XB + (size_t)m * 1024) + lane;
#pragma unroll
        for (int j = 0; j < 4; ++j) { u32x2 w; w.x = cvt_pk_bf16(v[u][j][0] * rstd, v[u][j][1] * rstd); w.y = cvt_pk_bf16(v[u][j][2] * rstd, v[u][j][3] * rstd); o8[64 * j] = w; } }
}

__device__ __forceinline__ void p0_prologue(const Args& a, LAS unsigned char* lds, int wave, int lane) {
    if (wave < 4) {
        LAS float* scr = (LAS float*)(lds + wave * 16384);
        const int gw = blockIdx.x * 4 + wave, NGW = gridDim.x * 4;
        const float* w_in = a.in[3]; const float* w_oa = a.in[10]; const float* w_ob = a.in[11]; const float* w_o = a.in[12]; const float* ng = a.in[2];
        bf16_t* WIN = (bf16_t*)(a.ws + WS_WIN); bf16_t* WAB = (bf16_t*)(a.ws + WS_WAB); bf16_t* WO = (bf16_t*)(a.ws + WS_WO);
        constexpr int I_IN = 16 * 168, I_OA = 8 * 32, I_OB = 8 * 32, I_O = 16 * 32, NITEMS = I_IN + I_OA + I_OB + I_O;
        for (int it = gw; it < NITEMS; it += NGW) {
            int r = it;
            if (r < I_IN) { const int kb = r / 168, nb = r % 168; p0_transpose_item(w_in, NIN, 64 * kb, map_col(32 * nb), ng, WIN, 32 * nb, 64 * kb, scr, lane); continue; } r -= I_IN;
            if (r < I_OA) { const int kb = r / 32, nb = r % 32; p0_transpose_item(w_oa, 1024, 64 * kb, 32 * nb, nullptr, WAB, 32 * nb, 64 * kb, scr, lane); continue; } r -= I_OA;
            if (r < I_OB) { const int kb = r / 32, nb = r % 32; p0_transpose_item(w_ob, 1024, 64 * kb, 32 * nb, nullptr, WAB, 32 * nb, 512 + 64 * kb, scr, lane); continue; } r -= I_OB;
            { const int kb = r / 32, nb = r % 32; p0_transpose_item(w_o, 1024, 64 * kb, 32 * nb, nullptr, WO, 32 * nb, 64 * kb, scr, lane); }
        }
    } else {
        bf16_t* XB = (bf16_t*)(a.ws + WS_XB);
        const int gw = blockIdx.x * 4 + (wave - 4), NGW = gridDim.x * 4;
        f32x4 va[4][4], vb[4][4];
        int m0 = gw;
        if (m0 < T) p0_load4(a, m0, NGW, lane, va);
        while (m0 < T) {
            const int m1 = m0 + 4 * NGW; const bool has1 = m1 < T;
            if (has1) p0_load4(a, m1, NGW, lane, vb);
            p0_proc4(XB, m0, NGW, lane, va);
            if (!has1) break;
            const int m2 = m1 + 4 * NGW; const bool has2 = m2 < T;
            if (has2) p0_load4(a, m2, NGW, lane, va);
            p0_proc4(XB, m1, NGW, lane, vb);
            if (!has2) break;
            m0 = m2;
        }
    }
}

struct AttnP { const bf16_t *QA, *KA, *VAT, *ZA, *QB, *KB, *VBT, *ZB; bf16_t* Y; const float* sink; const float* rpb; };
constexpr int ATT_VOFF = 73728, ATT_RPB = 147456;
__device__ __forceinline__ int att_vpos(int d) { return (d & 32) | ((d & 4) << 2) | ((d & 24) >> 1) | (d & 3); }

template <bool SWA> struct AttStage { u32x4 k[SWA ? 6 : 9]; u32x4 v[SWA ? 6 : 9]; };

template <bool SWA>
__device__ __forceinline__ void att_decode(int item, int& b, int& h, int& x) {
    if (SWA) { x = item & 31; h = (item >> 5) & 1; b = item >> 6; }
    else { x = item & 31; h = (item >> 5) & 7; b = item >> 8; }
}
template <bool SWA>
__device__ __forceinline__ void att_load(const AttnP& P, int item, int tid, AttStage<SWA>& st) {
    constexpr int NCH = SWA ? 6 : 9, KLD = SWA ? 128 : 512;
    int b, h, x; att_decode<SWA>(item, b, h, x);
    const int tb = b * SEQ, kcol = h * 64;
    const bf16_t* Kp = SWA ? P.KB : P.KA; const bf16_t* VT = SWA ? P.VBT : P.VAT;
    const int base = SWA ? 128 * x - 128 : min(max(2 * x - 4, 0), 56);
#pragma unroll
    for (int i = 0; i < NCH; ++i) {
        const int idx = tid + 512 * i;
        { const int k = idx >> 3, c = idx & 7; int tok;
          if (SWA) tok = min(max(base + k, 0), SEQ - 1); else tok = min(base + (k >> 6), 63) * 64 + (k & 63);
          st.k[i] = *(const u32x4*)(Kp + (size_t)(tb + tok) * KLD + kcol + 8 * c); }
        { const int kb = idx >> 6, d = idx & 63; int tok;
          if (SWA) tok = min(max(base + 8 * kb, 0), SEQ - 8); else tok = min(base + (kb >> 3), 63) * 64 + 8 * (kb & 7);
          st.v[i] = *(const u32x4*)(VT + ((size_t)((tb + tok) >> 3) * KLD + kcol + d) * 8); }
    }
}
template <bool SWA>
__device__ __forceinline__ void att_store(LAS unsigned char* lds, int tid, const AttStage<SWA>& st) {
    constexpr int NCH = SWA ? 6 : 9;
#pragma unroll
    for (int i = 0; i < NCH; ++i) {
        const int idx = tid + 512 * i, k = idx >> 3, c = idx & 7;
        *(LAS u32x4*)(lds + k * 128 + ((c ^ ((k >> 1) & 7)) << 4)) = st.k[i];
        *(LAS u32x4*)(lds + ATT_VOFF + ((idx & ~63) + att_vpos(idx & 63)) * 16) = st.v[i];
    }
}

struct AttQZ { bf16x8 q0, q1; u32x4 z[2]; };
template <bool SWA>
__device__ __forceinline__ void att_load_qz(const AttnP& P, int lane, int tb, int qpos0, int hq, AttQZ& o) {
    const int li = lane & 15, fq = lane >> 4;
    const bf16_t* Q = SWA ? P.QB : P.QA; const bf16_t* Z = SWA ? P.ZB : P.ZA;
    const bf16_t* qrow = Q + (size_t)(tb + qpos0 + li) * 512 + hq * 64 + 8 * fq;
    o.q0 = *(const bf16x8*)qrow; o.q1 = *(const bf16x8*)(qrow + 32);
    const bf16_t* zrow = Z + (size_t)(tb + qpos0 + li) * 512 + hq * 64 + 8 * fq;
#pragma unroll
    for (int hh = 0; hh < 2; ++hh) o.z[hh] = *(const u32x4*)(zrow + 32 * hh);
}
template <bool SWA, bool FAST>
__device__ __forceinline__ void att_tile(const AttnP& P, LAS unsigned char* lds, int lane, int tb, int qpos0, int hq, int kloc0, int r, int ct, int kr0, int kc0, const AttQZ& qz, float shift) {
    constexpr int NSEG = SWA ? 9 : 8, KMAX = SWA ? 383 : 575;
    const int li = lane & 15, fq = lane >> 4;
    const bf16x8 bq0 = qz.q0, bq1 = qz.q1;
    f32x4 sc[NSEG][2];
    constexpr int GS = SWA ? 3 : 2;
    const int krow0 = (SWA ? kloc0 : kc0) + li, ksw = (krow0 >> 1) & 7;
    const LAS unsigned char* kb0 = lds + krow0 * 128 + ((fq ^ ksw) << 4);
    const LAS unsigned char* kb1 = lds + krow0 * 128 + (((fq + 4) ^ ksw) << 4);
#pragma unroll
    for (int s0 = 0; s0 < NSEG; s0 += GS) {
        bf16x8 kf[GS][2][2];
#pragma unroll
        for (int g = 0; g < GS; ++g)
#pragma unroll
            for (int kt = 0; kt < 2; ++kt) { const int s = s0 + g;
                const int segoff = SWA ? (32 * s + 16 * kt) * 128 : (((kr0 + s) % 9) * 64 + 16 * kt) * 128;
                kf[g][kt][0] = *(const LAS bf16x8*)(kb0 + segoff); kf[g][kt][1] = *(const LAS bf16x8*)(kb1 + segoff); }
        __builtin_amdgcn_sched_barrier(0);
#pragma unroll
        for (int g = 0; g < GS; ++g)
#pragma unroll
            for (int kt = 0; kt < 2; ++kt) {
                f32x4 z = FAST ? (f32x4){-shift, -shift, -shift, -shift} : (f32x4){0.f, 0.f, 0.f, 0.f};
                z = __builtin_amdgcn_mfma_f32_16x16x32_bf16(kf[g][kt][0], bq0, z, 0, 0, 0);
                z = __builtin_amdgcn_mfma_f32_16x16x32_bf16(kf[g][kt][1], bq1, z, 0, 0, 0);
                sc[s0 + g][kt] = z; }
        __builtin_amdgcn_sched_barrier(0);
    }
    float mx = -1e30f;
    if (SWA) {
        const int qp = qpos0 + li;
#pragma unroll
        for (int s = 0; s < NSEG; ++s) {
            const int kb0 = qpos0 - 128 + 32 * s;
            if (s >= 1 && s <= 7 && kb0 >= 0 && kb0 + 31 < SEQ) {
#pragma unroll
                for (int kt = 0; kt < 2; ++kt)
#pragma unroll
                    for (int j = 0; j < 4; ++j) { if (!FAST) mx = fmaxf(mx, sc[s][kt][j]); }
            } else {
                asm volatile("");
#pragma unroll
                for (int kt = 0; kt < 2; ++kt)
#pragma unroll
                    for (int j = 0; j < 4; ++j) { const int kp = kb0 + 16 * kt + 4 * fq + j; const int d = kp - qp;
                        const bool ok = (kp >= 0) && (kp < SEQ) && (d <= 128) && (d >= -128);
                        const float v = ok ? sc[s][kt][j] : -1e30f; sc[s][kt][j] = v; if (!FAST) mx = fmaxf(mx, v); }
            }
        }
    } else if (!FAST) {
        const int c = 16 * ct + li, cs = min(max(c - 8, 0), 48);
        const LAS float* rp = (const LAS float*)(lds + ATT_RPB) + (kr0 - r + 7) * 64 + (kc0 + 4 * fq - c + 31);
#pragma unroll
        for (int s = 0; s < NSEG; ++s) {
            float bias[2][4];
#pragma unroll
            for (int kt = 0; kt < 2; ++kt)
#pragma unroll
                for (int j = 0; j < 4; ++j) bias[kt][j] = rp[s * 64 + 16 * kt + j];
#pragma unroll
            for (int kt = 0; kt < 2; ++kt)
#pragma unroll
                for (int j = 0; j < 4; ++j) { const int kc = kc0 + 16 * kt + 4 * fq + j; const bool ok = (kc >= cs) && (kc < cs + 16);
                    float t = sc[s][kt][j] + bias[kt][j]; asm volatile("" : "+v"(t));
                    const float v = ok ? t : -1e30f; sc[s][kt][j] = v; if (!FAST) mx = fmaxf(mx, v); }
        }
    }
    if (!FAST) { mx = fmaxf(mx, __shfl_xor(mx, 16)); mx = fmaxf(mx, __shfl_xor(mx, 32)); }
    float sk = 0.f;
    if (SWA) { sk = P.sink[hq] * LOG2E; if (!FAST) mx = fmaxf(mx, sk); }
    float l = 0.f; f32x2_t l2 = {0.f, 0.f};
    bf16x8 pb[NSEG];
    if constexpr (!SWA && FAST) {
        const int c = 16 * ct + li, cs = min(max(c - 8, 0), 48), w = cs - kc0;
        const LAS float* rp = (const LAS float*)(lds + ATT_RPB) + (kr0 - r + 7) * 64 + (kc0 + 4 * fq - c + 31);
        bool hi[4]; const LAS float* rpj[4];
#pragma unroll
        for (int j = 0; j < 4; ++j) { hi[j] = (4 * fq + j) < w; rpj[j] = rp + (hi[j] ? 16 : 0) + j; }
        const unsigned m01 = (hi[0] ? 0u : 0xffffu) | (hi[1] ? 0u : 0xffff0000u), m23 = (hi[2] ? 0u : 0xffffu) | (hi[3] ? 0u : 0xffff0000u);
#pragma unroll
        for (int s = 0; s < NSEG; ++s) {
            float p[4];
#pragma unroll
            for (int j = 0; j < 4; ++j) { const float v = hi[j] ? sc[s][1][j] : sc[s][0][j]; p[j] = __builtin_amdgcn_exp2f(v + rpj[j][s * 64]); }
            l2 += (f32x2_t){p[0], p[1]}; l2 += (f32x2_t){p[2], p[3]};
            const unsigned pk01 = cvt_pk_bf16(p[0], p[1]), pk23 = cvt_pk_bf16(p[2], p[3]);
            u32x4 wv; wv.x = pk01 & m01; wv.y = pk23 & m23; wv.z = pk01 & ~m01; wv.w = pk23 & ~m23;
            pb[s] = __builtin_bit_cast(bf16x8, wv);
        }
    } else
#pragma unroll
    for (int s = 0; s < NSEG; ++s) {
        float p[8];
#pragma unroll
        for (int kt = 0; kt < 2; ++kt)
#pragma unroll
            for (int j = 0; j < 4; ++j) p[4 * kt + j] = __builtin_amdgcn_exp2f(FAST ? sc[s][kt][j] : sc[s][kt][j] - mx);
#pragma unroll
        for (int e = 0; e < 8; e += 2) l2 += (f32x2_t){p[e], p[e + 1]};
        u32x4 w; w.x = cvt_pk_bf16(p[0], p[1]); w.y = cvt_pk_bf16(p[2], p[3]); w.z = cvt_pk_bf16(p[4], p[5]); w.w = cvt_pk_bf16(p[6], p[7]);
        pb[s] = __builtin_bit_cast(bf16x8, w);
    }
    l += l2[0] + l2[1];
    l += __shfl_xor(l, 16); l += __shfl_xor(l, 32);
    if (SWA) l += __builtin_amdgcn_exp2f(FAST ? sk - shift : sk - mx);
    const float rl = 1.0f / l;
    f32x4 oacc[4];
#pragma unroll
    for (int dt = 0; dt < 4; ++dt) oacc[dt] = (f32x4){0.f, 0.f, 0.f, 0.f};
    constexpr int GV = SWA ? 3 : 4;
    const int g0l = (SWA ? kloc0 : kc0) + 4 * fq;
    const LAS unsigned char* vb0 = lds + ATT_VOFF + (g0l >> 3) * 1024 + li * 16 + (g0l & 7) * 2;
#pragma unroll
    for (int s0 = 0; s0 < NSEG; s0 += GV) {
        u32x2 vf[GV][4][2];
#pragma unroll
        for (int g = 0; g < GV; ++g) { const int s = s0 + g;
            const int segv = SWA ? s * 4096 : ((kr0 + s) % 9) * 8192;
#pragma unroll
            for (int dt = 0; dt < 4; ++dt) {
                vf[g][dt][0] = *(const LAS u32x2*)(vb0 + segv + dt * 256); asm volatile("" ::: "memory");
                vf[g][dt][1] = *(const LAS u32x2*)(vb0 + segv + dt * 256 + 2048); asm volatile("" ::: "memory"); } }
        __builtin_amdgcn_sched_barrier(0);
#pragma unroll
        for (int g = 0; g < GV; ++g)
#pragma unroll
            for (int dt = 0; dt < 4; ++dt) {
                u32x4 w; w.x = vf[g][dt][0].x; w.y = vf[g][dt][0].y; w.z = vf[g][dt][1].x; w.w = vf[g][dt][1].y;
                oacc[dt] = __builtin_amdgcn_mfma_f32_16x16x32_bf16(__builtin_bit_cast(bf16x8, w), pb[s0 + g], oacc[dt], 0, 0, 0); }
        __builtin_amdgcn_sched_barrier(0);
    }
    const size_t tq = (size_t)(tb + qpos0 + li);
#pragma unroll
    for (int hh = 0; hh < 2; ++hh) {
        const u32x4 z = qz.z[hh]; const f32x4 a = oacc[2 * hh], b = oacc[2 * hh + 1];
        u32x4 o; o.x = cvt_pk_bf16(a[0] * rl * bf_lo(z.x), a[1] * rl * bf_hi(z.x)); o.y = cvt_pk_bf16(a[2] * rl * bf_lo(z.y), a[3] * rl * bf_hi(z.y));
        o.z = cvt_pk_bf16(b[0] * rl * bf_lo(z.z), b[1] * rl * bf_hi(z.z)); o.w = cvt_pk_bf16(b[2] * rl * bf_lo(z.w), b[3] * rl * bf_hi(z.w));
        *(u32x4*)(P.Y + tq * 1024 + (SWA ? 512 : 0) + hq * 64 + 32 * hh + 8 * fq) = o;
    }
}

template <bool SWA>
__device__ __forceinline__ void att_phase(const AttnP& P, LAS unsigned char* lds, int tid, int wave, int lane, bool fast, float shift, AttStage<SWA>& st, AttQZ& qzn, bool pre) {
    constexpr int NITEMS = SWA ? 768 : 3072;
    int item = blockIdx.x;
#define ATT_QPOS(x) (SWA ? 128 * (x) + 16 * wave : (2 * (x) + (wave >> 2)) * 64 + 16 * (wave & 3))
    if (!pre && item < NITEMS) { int b, h, x; att_decode<SWA>(item, b, h, x); att_load<SWA>(P, item, tid, st); att_load_qz<SWA>(P, lane, b * SEQ, ATT_QPOS(x), SWA ? 4 * h : h, qzn); }
    for (; item < NITEMS; item += gridDim.x) {
        int b, h, x; att_decode<SWA>(item, b, h, x);
        att_store<SWA>(lds, tid, st);
        if (!SWA) { if (tid < 465) ((LAS float*)(lds + ATT_RPB))[tid] = P.rpb[h * 465 + tid] * LOG2E; }
        __syncthreads();
        const int nitem = item + (int)gridDim.x; const bool has_next = nitem < NITEMS;
        int nb = 0, nh = 0, nx = 0; if (has_next) { att_decode<SWA>(nitem, nb, nh, nx); att_load<SWA>(P, nitem, tid, st); }
        const int tb = b * SEQ;
        if (SWA) {
#pragma unroll 1
            for (int j = 0; j < 4; ++j) { int kl = 16 * wave; asm volatile("" : "+v"(kl));
                const AttQZ qz = qzn;
                if (j < 3) att_load_qz<true>(P, lane, tb, ATT_QPOS(x), 4 * h + j + 1, qzn);
                else if (has_next) att_load_qz<true>(P, lane, nb * SEQ, ATT_QPOS(nx), 4 * nh, qzn);
                if (fast) att_tile<true, true>(P, lds, lane, tb, 128 * x + 16 * wave, 4 * h + j, kl, 0, 0, 0, 0, qz, shift);
                else att_tile<true, false>(P, lds, lane, tb, 128 * x + 16 * wave, 4 * h + j, kl, 0, 0, 0, 0, qz, 0.f); }
        } else {
            const AttQZ qz = qzn;
            if (has_next) att_load_qz<false>(P, lane, nb * SEQ, ATT_QPOS(nx), nh, qzn);
            const int basee = min(max(2 * x - 4, 0), 56), r = 2 * x + (wave >> 2), ct = wave & 3, kr0 = min(max(r - 4, 0), 56);
            const int kc0 = ct == 0 ? 0 : (ct == 1 ? 8 : (ct == 2 ? 24 : 32));
            att_tile<false, false>(P, lds, lane, tb, r * 64 + 16 * ct, h, (kr0 - basee) * 64 + kc0, r, ct, kr0, kc0, qz, 0.f);
        }
        __syncthreads();
    }
#undef ATT_QPOS
}


struct NaStep { int b, h, rp, first, nrows; bool full; };
__device__ __forceinline__ NaStep na_step(int t, int spw, int c) {
    NaStep o; const int g = c * spw + t, bh = g >> 5; o.rp = g & 31; o.h = bh & 7; o.b = bh >> 3;
    const int base = min(max(2 * o.rp - 4, 0), 56);
    o.full = (t == 0) || (o.rp == 0);
    if (o.full) { o.first = base; o.nrows = 9; }
    else { const int pb = min(max(2 * o.rp - 6, 0), 56); o.first = pb + 9; o.nrows = base - pb; }
    return o;
}
__device__ __forceinline__ void na_load(const AttnP& P, const NaStep& st, int tid, AttStage<false>& r) {
    const int tb = st.b * SEQ, kcol = st.h * 64;
#pragma unroll
    for (int i = 0; i < 9; ++i) if (i < st.nrows) {
        const int row = min(st.first + i, 63);
        r.k[i] = *(const u32x4*)(P.KA + (size_t)(tb + row * 64 + (tid >> 3)) * 512 + kcol + 8 * (tid & 7));
        r.v[i] = *(const u32x4*)(P.VAT + ((size_t)((tb + row * 64) >> 3) + (tid >> 6)) * 4096 + (size_t)(kcol + (tid & 63)) * 8);
    }
}
__device__ __forceinline__ void na_store(LAS unsigned char* lds, const NaStep& st, int tid, const AttStage<false>& r) {
#pragma unroll
    for (int i = 0; i < 9; ++i) if (i < st.nrows) {
        const int slot = (st.first + i) % 9, k = slot * 64 + (tid >> 3), c = tid & 7;
        *(LAS u32x4*)(lds + k * 128 + ((c ^ ((k >> 1) & 7)) << 4)) = r.k[i];
        *(LAS u32x4*)(lds + ATT_VOFF + (slot * 8 + (tid >> 6)) * 1024 + att_vpos(tid & 63) * 16) = r.v[i];
    }
}
__device__ __forceinline__ void na_phase(const AttnP& P, LAS unsigned char* lds, int tid, int wave, int lane, bool fast, float shift, AttStage<true>& swa_st, AttQZ& swa_qz) {
    const int G = gridDim.x, c = blockIdx.x;
    const int spw = (3072 + G - 1) / G;
    const int nsteps = min(spw, max(3072 - c * spw, 0));
    AttStage<false> rg; AttQZ qzn;
    if (nsteps > 0) { const NaStep s0 = na_step(0, spw, c); na_load(P, s0, tid, rg); att_load_qz<false>(P, lane, s0.b * SEQ, (2 * s0.rp + (wave >> 2)) * 64 + 16 * (wave & 3), s0.h, qzn); }
#define NA_STEP(T, ...) do { \
        const NaStep st = na_step((T), spw, c); \
        na_store(lds, st, tid, rg); \
        if (st.full) {        \
            _Pragma("unroll") for (int i = 0; i < 2; ++i) { const int e = tid + 512 * i, row = e >> 6, dc = (e & 63) - 16; \
                if (e < 960) ((LAS float*)(lds + ATT_RPB))[e] = (dc >= 0 && dc <= 30) ? P.rpb[st.h * 465 + row * 31 + dc] * LOG2E : 0.f; } } \
        __syncthreads(); \
        const AttQZ qz = qzn; \
        __VA_ARGS__; \
        const int r = 2 * st.rp + (wave >> 2), ct = wave & 3, kr0 = min(max(r - 4, 0), 56); \
        const int kc0 = ct == 0 ? 0 : (ct == 1 ? 8 : (ct == 2 ? 24 : 32)); \
        if (fast) att_tile<false, true>(P, lds, lane, st.b * SEQ, r * 64 + 16 * ct, st.h, 0, r, ct, kr0, kc0, qz, shift); \
        else att_tile<false, false>(P, lds, lane, st.b * SEQ, r * 64 + 16 * ct, st.h, 0, r, ct, kr0, kc0, qz, 0.f); \
        __syncthreads(); } while (0)
    for (int t = 0; t + 1 < nsteps; ++t)
        NA_STEP(t, { const NaStep sn = na_step(t + 1, spw, c); na_load(P, sn, tid, rg); att_load_qz<false>(P, lane, sn.b * SEQ, (2 * sn.rp + (wave >> 2)) * 64 + 16 * (wave & 3), sn.h, qzn); });
    if (nsteps > 0)
        NA_STEP(nsteps - 1, { if (c < 768) { int sb, sh, sx; att_decode<true>(c, sb, sh, sx); att_load<true>(P, c, tid, swa_st); att_load_qz<true>(P, lane, sb * SEQ, 128 * sx + 16 * wave, 4 * sh, swa_qz); } });
#undef NA_STEP
}

#define XB_TMO      128
#define XB_XCNT(j)  (256  + 64 * (j))
#define XB_XSUB(j)  (1280 + 64 * (j))
#define XB_XGEN(j)  (2304 + 64 * (j))
#define XB_TOP      3328
#define XB_TOPGEN   3392
#define XCD_BAR_WORDS 3456
#define XB_SPIN_CAP (1u << 18)
__device__ __forceinline__ unsigned xb_ld(unsigned* p)              { return __hip_atomic_load(p, __ATOMIC_RELAXED, __HIP_MEMORY_SCOPE_AGENT); }
__device__ __forceinline__ unsigned xb_add(unsigned* p, unsigned v) { return __hip_atomic_fetch_add(p, v, __ATOMIC_RELAXED, __HIP_MEMORY_SCOPE_AGENT); }
__device__ __forceinline__ unsigned xb_xcc_id() { return (unsigned)__builtin_amdgcn_s_getreg((3 << 11) | 20) & 0xFu; }
#define XB_SPIN(cond, bar) do { unsigned _sp = 0; while (cond) { __builtin_amdgcn_s_sleep(1); \
    if ((++_sp & 255u) == 0u) { if (xb_ld(&(bar)[XB_TMO])) break; if (_sp > XB_SPIN_CAP) { atomicAdd(&(bar)[XB_TMO], 1u); break; } } } } while (0)
struct XcdBarrier { unsigned* bar; unsigned x; volatile LAS unsigned* st; };
__device__ __forceinline__ XcdBarrier xcd_barrier_post(unsigned* bar, volatile LAS unsigned* st) {
    XcdBarrier b; b.bar = bar; b.x = xb_xcc_id(); b.st = st;
    if (threadIdx.x == 0) (void)xb_add(&bar[XB_XCNT(b.x)], 1u);
    return b;
}
__device__ __forceinline__ void xcd_barrier_complete(unsigned* bar, unsigned x, unsigned& nloc, unsigned& nx) {
    const unsigned G = gridDim.x * gridDim.y * gridDim.z;
    unsigned sum, cnt, mine, sp = 0u;
    for (;;) {
        sum = 0u; cnt = 0u; mine = 0u;
#pragma unroll
        for (unsigned j = 0; j < 16; ++j) { const unsigned c = xb_ld(&bar[XB_XCNT(j)]); sum += c; cnt += (c > 0u) ? 1u : 0u; mine = (j == x) ? c : mine; }
        if (sum == G) break;
        __builtin_amdgcn_s_sleep(1);
        if ((++sp & 255u) == 0u) { if (xb_ld(&bar[XB_TMO])) break; if (sp > XB_SPIN_CAP) { atomicAdd(&bar[XB_TMO], 1u); break; } }
    }
    nloc = mine > 0u ? mine : 1u; nx = cnt > 0u ? cnt : 1u;
}
__device__ __forceinline__ void xcd_barrier(const XcdBarrier& b) {
    asm volatile("s_waitcnt vmcnt(0)" ::: "memory");
    __syncthreads();
    if (threadIdx.x == 0) {
        unsigned* bar = b.bar;
        __builtin_amdgcn_s_waitcnt(0);
        unsigned nloc = b.st[0], nx = b.st[1];
        if (nloc == 0u) { xcd_barrier_complete(bar, b.x, nloc, nx); b.st[0] = nloc; b.st[1] = nx; }
        const unsigned old = xb_add(&bar[XB_XSUB(b.x)], 1u);
        const unsigned gen = old / nloc;
        if (old + 1u == (gen + 1u) * nloc) {
            __builtin_amdgcn_fence(__ATOMIC_RELEASE, "agent");
            asm volatile("s_waitcnt vmcnt(0)" ::: "memory");
            const unsigned og = xb_add(&bar[XB_TOP], 1u);
            const unsigned tg = og / nx;
            if (og + 1u == (tg + 1u) * nx) xb_add(&bar[XB_TOPGEN], 1u);
            else XB_SPIN(xb_ld(&bar[XB_TOPGEN]) == tg, bar);
            __builtin_amdgcn_fence(__ATOMIC_ACQUIRE, "agent");
            xb_add(&bar[XB_XGEN(b.x)], 1u);
            asm volatile("s_waitcnt vmcnt(0)" ::: "memory");
        } else {
            XB_SPIN(xb_ld(&bar[XB_XGEN(b.x)]) == gen, bar);
            __builtin_amdgcn_fence(__ATOMIC_ACQUIRE, "agent");
            asm volatile("s_waitcnt vmcnt(0)" ::: "memory");
        }
    }
    __syncthreads();
}

__global__ void __launch_bounds__(512, 2) fwd_kernel(Args a) {
    extern __shared__ __attribute__((aligned(16))) unsigned char lds_raw[];
    LAS unsigned char* lds = (LAS unsigned char*)lds_raw;
    const int tid = threadIdx.x, lane = tid & 63, wave = __builtin_amdgcn_readfirstlane(tid >> 6);
    const int lo = a.ph_lo, hi = a.ph_hi;
    unsigned char* ws = a.ws;
#define IN(k) (lo <= (k) && (k) < hi)
    volatile LAS unsigned* bst = (volatile LAS unsigned*)(lds + LDS_BYTES - 64);
    if (tid == 0) { bst[0] = 0u; bst[1] = 0u; }
    __syncthreads();
    (void)xcd_barrier_post((unsigned*)(ws + WS_CTL), bst);
    if (lo == 12345) cg::this_grid().sync();
#define SEAM(k) do { if (IN(k) && IN((k) + 1)) { XcdBarrier gb_; gb_.bar = (unsigned*)(ws + WS_CTL); gb_.x = xb_xcc_id(); gb_.st = (volatile LAS unsigned*)(lds + LDS_BYTES - 64); xcd_barrier(gb_); } } while (0)
    if (IN(0)) { p0_prologue(a, lds, wave, lane); }
    SEAM(0);
    if (IN(1)) {
        SchedA S; S.init(T, NIN, gridDim.x, blockIdx.x); S.XB = (const char*)(ws + WS_XB); S.W = (const char*)(ws + WS_WIN);
        EpiA E; E.ws = ws; E.GA = (bf16_t*)a.out;
        E.qn_a = a.in[4]; E.kn_a = a.in[5]; E.qn_b = a.in[7]; E.kn_b = a.in[8];
        pg8::gemm_phase<EpiA, SchedA>(lds, S, E);
    }
    SEAM(1);
    if (IN(2)) {
        AttnP P; P.QA = (const bf16_t*)(ws + WS_QA); P.KA = (const bf16_t*)(ws + WS_KA); P.VAT = (const bf16_t*)(ws + WS_VAT); P.ZA = (const bf16_t*)(ws + WS_ZA);
        P.QB = (const bf16_t*)(ws + WS_QB); P.KB = (const bf16_t*)(ws + WS_KB); P.VBT = (const bf16_t*)(ws + WS_VBT); P.ZB = (const bf16_t*)(ws + WS_ZB);
        P.Y = (bf16_t*)(ws + WS_Y); P.sink = a.in[9]; P.rpb = a.in[6];
        float shiftA, shiftB; bool fast;
        { float mqa = fabsf(a.in[4][lane]), mka = fabsf(a.in[5][lane]), mqb = fabsf(a.in[7][lane]), mkb = fabsf(a.in[8][lane]), msk = fabsf(a.in[9][lane & 7]), mr = 0.f;
          for (int i = tid; i < 8 * 465; i += 512) mr = fmaxf(mr, fabsf(a.in[6][i]));
#pragma unroll
          for (int o = 1; o < 64; o <<= 1) { mqa = fmaxf(mqa, __shfl_xor(mqa, o)); mka = fmaxf(mka, __shfl_xor(mka, o)); mqb = fmaxf(mqb, __shfl_xor(mqb, o)); mkb = fmaxf(mkb, __shfl_xor(mkb, o));
              msk = fmaxf(msk, __shfl_xor(msk, o)); mr = fmaxf(mr, __shfl_xor(mr, o)); }
          LAS float* red = (LAS float*)(lds + ATT_RPB);
          if (lane == 0) red[wave] = mr;
          __syncthreads();
          mr = red[0];
#pragma unroll
          for (int w = 1; w < 8; ++w) mr = fmaxf(mr, red[w]);
          __syncthreads();
          shiftA = 1.02f * (64.f * mqa * mka * QSCALE + mr * LOG2E) + 0.5f; shiftB = 1.02f * (64.f * mqb * mkb * QSCALE) + 0.5f;
          fast = (shiftA < 60.f) && (shiftB < 60.f) && (msk * LOG2E < 60.f); }
        AttStage<true> swa_st; AttQZ swa_qz;
        const bool pre = ((3072 + (int)gridDim.x - 1) / (int)gridDim.x) * (int)blockIdx.x < 3072;
        na_phase(P, lds, tid, wave, lane, fast, shiftA, swa_st, swa_qz);
        att_phase<true>(P, lds, tid, wave, lane, fast, shiftB, swa_st, swa_qz, pre);
    }
    SEAM(2);
    if (IN(3)) {
        SchedP S; S.init(T, 1024, gridDim.x, blockIdx.x); S.A = (const char*)(ws + WS_Y); S.W = (const char*)(ws + WS_WAB);
        EpiC1 E; E.GA = (const bf16_t*)a.out; E.GB = (const bf16_t*)a.out + (size_t)T * 1024; E.MG = (bf16_t*)(ws + WS_MG);
        pg8::gemm_phase<EpiC1, SchedP>(lds, S, E);
    }
    SEAM(3);
    if (IN(4)) {
        SchedP S; S.init(T, 1024, gridDim.x, blockIdx.x); S.A = (const char*)(ws + WS_MG); S.W = (const char*)(ws + WS_WO);
        EpiC2 E; E.xp = a.in[0]; E.xs = a.in[1]; E.out = a.out;
        pg8::gemm_phase<EpiC2, SchedP>(lds, S, E, true);
    }
#undef IN
#undef SEAM
}

extern "C" void kernel_launch(void* const* d_in, const int* in_sizes, int n_in, void* d_out, int out_size, void* d_ws, size_t ws_size, hipStream_t stream) {
    static int grid = 0;
    if (grid == 0) {
        if (n_in != 13 || out_size != T * D || ws_size < WS_END) { fprintf(stderr, "kernel_launch: unexpected shapes (n_in %d out %d ws %zu)\n", n_in, out_size, ws_size); grid = -1; return; }
        int dev = 0, cus = 0;
        if (hipGetDevice(&dev) != hipSuccess || hipDeviceGetAttribute(&cus, hipDeviceAttributeMultiprocessorCount, dev) != hipSuccess) { grid = -1; return; }
        if (hipFuncSetAttribute((const void*)fwd_kernel, hipFuncAttributeMaxDynamicSharedMemorySize, LDS_BYTES) != hipSuccess) { fprintf(stderr, "kernel_launch: hipFuncSetAttribute failed\n"); grid = -1; return; }
        int per_cu = 0;
        if (hipOccupancyMaxActiveBlocksPerMultiprocessor(&per_cu, (const void*)fwd_kernel, 512, LDS_BYTES) != hipSuccess || per_cu < 1) fprintf(stderr, "kernel_launch: occupancy query says %d\n", per_cu);
        (void)hipGetLastError();
        grid = cus;
    }
    if (grid < 0) return;
    hipMemsetAsync((char*)d_ws + WS_CTL, 0, CTL_BYTES, stream);
    Args a{};
    for (int i = 0; i < 13; ++i) a.in[i] = (const float*)d_in[i];
    a.out = (float*)d_out; a.ws = (unsigned char*)d_ws;
    if (N_LAUNCHES == 1) {
        a.ph_lo = 0; a.ph_hi = 5;
        void* args[] = {&a};
        hipError_t e = hipLaunchCooperativeKernel((const void*)fwd_kernel, dim3(grid), dim3(512), args, LDS_BYTES, stream);
        if (e != hipSuccess) fprintf(stderr, "cooperative launch failed: %s (grid %d)\n", hipGetErrorString(e), grid);
    } else {
        for (int p = 0; p < 5; ++p) {
            a.ph_lo = p; a.ph_hi = p + 1; hipLaunchKernelGGL(fwd_kernel, dim3(grid), dim3(512), LDS_BYTES, stream, a); }
    }
}
```

```cpp
#include <hip/hip_runtime.h>
#include <hip/hip_cooperative_groups.h>
#include <cstdio>
namespace cg = cooperative_groups;

#ifndef N_LAUNCHES
#define N_LAUNCHES 1
#endif

#define LAS __attribute__((address_space(3)))
typedef unsigned short bf16_t;
typedef short bf16x8 __attribute__((ext_vector_type(8)));
typedef short bf16x4 __attribute__((ext_vector_type(4)));
typedef float f32x4 __attribute__((ext_vector_type(4)));
typedef unsigned u32x4 __attribute__((ext_vector_type(4)));
typedef unsigned u32x2 __attribute__((ext_vector_type(2)));

constexpr int T = 49152, TP = 32768, D = 1024, NIN = 5376, SEQ = 4096;
constexpr float LOG2E = 1.4426950408889634f;
constexpr float QSCALE = 0.125f * LOG2E;
constexpr float NORM_EPS = 1e-6f;
constexpr size_t MiB = 1u << 20;
constexpr size_t WS_WIN = 0, WS_WAB = 11 * MiB, WS_WO = 13 * MiB, WS_ROPE = 15 * MiB, WS_XB = 17 * MiB, WS_QA = 113 * MiB, WS_KA = 161 * MiB, WS_QB = 209 * MiB,
                 WS_ZA = 257 * MiB, WS_ZB = 305 * MiB, WS_VAT = 353 * MiB, WS_KB = 401 * MiB, WS_VBT = 413 * MiB, WS_END = 425 * MiB;
constexpr size_t WS_CTL = 11 * MiB - 65536, CTL_BYTES = 16384;
constexpr size_t WS_Y = WS_XB;
constexpr size_t WS_MG = WS_QA;
constexpr int LDS_BYTES = 155648;

typedef __bf16 bf16x2_t __attribute__((ext_vector_type(2)));
typedef float f32x2_t __attribute__((ext_vector_type(2)));
__device__ __forceinline__ unsigned cvt_pk_bf16(float lo, float hi) { const f32x2_t v = {lo, hi}; const bf16x2_t r = __builtin_convertvector(v, bf16x2_t); return __builtin_bit_cast(unsigned, r); }
__device__ __forceinline__ float bf_lo(unsigned w) { return __uint_as_float(w << 16); }
__device__ __forceinline__ float bf_hi(unsigned w) { return __uint_as_float(w & 0xffff0000u); }
__device__ __forceinline__ float fast_sigmoid(float v) { return __builtin_amdgcn_rcpf(1.0f + __builtin_amdgcn_exp2f(-v * LOG2E)); }

namespace pg8 {
constexpr int BM = 256, BK = 64, HALF = 128, HTB = HALF * BK * 2, STAGE_BYTES = 8 * HTB, NXCD = 8, WGM = 4, K = 1024;
__device__ __forceinline__ int lds_byte(int r, int c) { const int st = (r >> 4) * 2 + (c >> 5), rr = r & 15, cc = c & 31, ob = rr * 64 + cc * 2; return st * 1024 + (ob ^ (((ob >> 9) & 1) << 5)); }
__device__ __forceinline__ void stage_rc(int b, int& R, int& C) { const int st = b / 1024, sb = b % 1024, swz = sb ^ (((sb >> 9) & 1) << 5); R = (st >> 1) * 16 + swz / 64; C = (st & 1) * 32 + (swz % 64) / 2; }
__device__ __forceinline__ int perm32(int rho) { const int n = rho >> 4, i = rho & 15; return 8 * (i >> 2) + 4 * n + (i & 3); }
struct Unit { int pm, pn; };
struct StaticOrder {
    int nM, nN, nwg, G, c;
    __device__ void init(int M, int N, int G_, int c_) { nM = M / BM; nN = N / BM; nwg = nM * nN; G = G_; c = c_; }
    __device__ bool next(int i, Unit& u) const {
        const long L = (long)i * G + c; if (L >= nwg) return false;
        int wgid = (int)L; { const int q = nwg / NXCD, r = nwg % NXCD, xcd = wgid % NXCD, off = wgid / NXCD; wgid = (xcd < r ? xcd * (q + 1) : r * (q + 1) + (xcd - r) * q) + off; }
        const int nig = WGM * nN, gid = wgid / nig, fm = gid * WGM, gsz = (nM - fm) < WGM ? (nM - fm) : WGM;
        u.pm = fm + ((wgid % nig) % gsz); u.pn = (wgid % nig) / gsz; return true;
    }
};
template <class Epi, class Sched>
__device__ __forceinline__ void gemm_phase(LAS unsigned char* lds, const Sched& S, const Epi& E, bool natural = false) {
    const int tid = threadIdx.x, wid = __builtin_amdgcn_readfirstlane(tid >> 6), lane = tid & 63, wr = wid >> 2, wc = wid & 3, fr = lane & 15, fq = lane >> 4;
    constexpr int nt = K / BK;
    unsigned voffA[2], voffB0[2], voffB1[2];
#pragma unroll
    for (int i = 0; i < 2; ++i) { int R, C; stage_rc(tid * 16 + i * 8192, R, C);
        const int Rb = 64 * (R >> 5) + (natural ? (R & 31) : perm32(R & 31));
        voffA[i] = (unsigned)(R * K + C) * 2u; voffB0[i] = (unsigned)(Rb * K + C) * 2u; voffB1[i] = (unsigned)((Rb + 32) * K + C) * 2u; }
    constexpr size_t kstep = (size_t)(BK * 2);
    constexpr size_t hstep = (size_t)HALF * K * 2;
    const unsigned ldsw = (unsigned)wid * 1024u;
    const int aoff = lds_byte(wr * 64 + fr, fq * 8), boff = lds_byte(wc * 32 + fr, fq * 8);
#define PG8_SA(b, h) (((b) * 2 + (h)) * HTB)
#define PG8_SB(b, h) ((4 + (b) * 2 + (h)) * HTB)
#define PG8_STAGE(bufoff, gbase, voff) do { _Pragma("unroll") for (int _i = 0; _i < 2; ++_i) \
        __builtin_amdgcn_global_load_lds((const unsigned*)((const char*)(gbase) + (voff)[_i]), (LAS unsigned*)(lds + (bufoff) + ldsw + _i * 8192), 16, 0, 0); } while (0)
#define PG8_LDA(dst, b, h) do { _Pragma("unroll") for (int m = 0; m < 4; ++m) _Pragma("unroll") for (int k = 0; k < 2; ++k) dst[m][k] = *(const LAS bf16x8*)(lds + PG8_SA(b, h) + aoff + m * 2048 + k * 1024); } while (0)
#define PG8_LDB(dst, b, h) do { _Pragma("unroll") for (int n = 0; n < 2; ++n) _Pragma("unroll") for (int k = 0; k < 2; ++k) dst[n][k] = *(const LAS bf16x8*)(lds + PG8_SB(b, h) + boff + n * 2048 + k * 1024); } while (0)
#define PG8_MMA(ai, bj, At, Bt) do { __builtin_amdgcn_s_setprio(1); _Pragma("unroll") for (int m = 0; m < 4; ++m) _Pragma("unroll") for (int n = 0; n < 2; ++n) _Pragma("unroll") for (int k = 0; k < 2; ++k) \
        acc[ai][bj][m][n] = __builtin_amdgcn_mfma_f32_16x16x32_bf16(Bt[n][k], At[m][k], acc[ai][bj][m][n], 0, 0, 0); __builtin_amdgcn_s_setprio(0); } while (0)
#define PG8_WAIT_V(n) asm volatile("s_waitcnt vmcnt(" #n ")" ::: "memory")
#define PG8_WAIT_L(n) asm volatile("s_waitcnt lgkmcnt(" #n ")" ::: "memory")
#define PG8_BAR __builtin_amdgcn_s_barrier()
#define PG8_SCHED __builtin_amdgcn_sched_barrier(0)
    Unit cur, nxt; int ui = 0;
    if (!S.next(0, cur)) return;
    f32x4 acc[2][2][4][2];
#pragma unroll
    for (int a = 0; a < 2; ++a)
#pragma unroll
        for (int b = 0; b < 2; ++b)
#pragma unroll
            for (int m = 0; m < 4; ++m)
#pragma unroll
                for (int n = 0; n < 2; ++n) acc[a][b][m][n] = (f32x4){0.f, 0.f, 0.f, 0.f};
    bf16x8 At[4][2], B0[2][2], B1[2][2];
    const char* cA; const char* cB; S.ptrs(cur, cA, cB);
    PG8_STAGE(PG8_SB(0, 0), cB, voffB0); PG8_STAGE(PG8_SB(0, 1), cB, voffB1); PG8_STAGE(PG8_SA(0, 0), cA, voffA); PG8_STAGE(PG8_SA(0, 1), cA + hstep, voffA);
    if (wr == 1) PG8_BAR;
    PG8_WAIT_V(2); PG8_BAR;
    PG8_STAGE(PG8_SB(1, 0), cB + kstep, voffB0); PG8_STAGE(PG8_SA(1, 0), cA + kstep, voffA); PG8_STAGE(PG8_SB(1, 1), cB + kstep, voffB1);
    PG8_WAIT_V(6); PG8_BAR;
    for (;;) {
        const bool has_next = S.next(ui + 1, nxt);
        const char* nA = cA; const char* nB = cB; if (has_next) S.ptrs(nxt, nA, nB);
        for (int t = 0; t < nt; t += 2) {
            const bool last = (t == nt - 2);
            const char* a1 = cA + (size_t)(t + 1) * kstep;
            const char* a2 = last ? nA : cA + (size_t)(t + 2) * kstep; const char* b2 = last ? nB : cB + (size_t)(t + 2) * kstep;
            const char* a3 = a2 + kstep; const char* b3 = b2 + kstep;
            if constexpr (Epi::MIDHOOK) { if (t == nt / 2) E.mid(acc, cur, wr, wc, fr, fq); }
            PG8_LDB(B0, 0, 0); PG8_LDB(B1, 0, 1); PG8_SCHED; PG8_LDA(At, 0, 0); PG8_STAGE(PG8_SA(1, 1), a1 + hstep, voffA);
            PG8_WAIT_V(8); PG8_WAIT_L(0); PG8_BAR; PG8_MMA(0, 0, At, B0); PG8_MMA(0, 1, At, B1); PG8_BAR; PG8_SCHED;
            PG8_LDA(At, 0, 1); PG8_STAGE(PG8_SB(0, 0), b2, voffB0); PG8_STAGE(PG8_SB(0, 1), b2, voffB1); PG8_STAGE(PG8_SA(0, 0), a2, voffA);
            PG8_WAIT_V(8); PG8_WAIT_L(0); PG8_BAR; PG8_MMA(1, 0, At, B0); PG8_MMA(1, 1, At, B1); PG8_BAR; PG8_SCHED;
            PG8_LDB(B0, 1, 0); PG8_LDB(B1, 1, 1); PG8_SCHED; PG8_LDA(At, 1, 0); PG8_STAGE(PG8_SA(0, 1), a2 + hstep, voffA);
            PG8_WAIT_V(8); PG8_WAIT_L(0); PG8_BAR; PG8_MMA(0, 0, At, B0); PG8_MMA(0, 1, At, B1); PG8_BAR; PG8_SCHED;
            PG8_LDA(At, 1, 1); PG8_STAGE(PG8_SB(1, 0), b3, voffB0); PG8_STAGE(PG8_SB(1, 1), b3, voffB1); PG8_STAGE(PG8_SA(1, 0), a3, voffA);
            PG8_WAIT_V(8); PG8_WAIT_L(0); PG8_BAR; PG8_MMA(1, 0, At, B0); PG8_MMA(1, 1, At, B1); PG8_BAR; PG8_SCHED;
        }
        if (wr == 0) PG8_BAR;
        E(acc, cur, wr, wc, fr, fq);
        if (!has_next) break;
#pragma unroll
        for (int a = 0; a < 2; ++a)
#pragma unroll
            for (int b = 0; b < 2; ++b)
#pragma unroll
                for (int m = 0; m < 4; ++m)
#pragma unroll
                    for (int n = 0; n < 2; ++n) acc[a][b][m][n] = (f32x4){0.f, 0.f, 0.f, 0.f};
        cur = nxt; cA = nA; cB = nB; ++ui;
        if (wr == 1) PG8_BAR;
    }
    PG8_WAIT_V(0);
    PG8_BAR;
#undef PG8_SA
#undef PG8_SB
#undef PG8_STAGE
#undef PG8_LDA
#undef PG8_LDB
#undef PG8_MMA
#undef PG8_WAIT_V
#undef PG8_WAIT_L
#undef PG8_BAR
#undef PG8_SCHED
}
}
using pg8::Unit;
typedef f32x4 AccT[2][2][4][2];

__device__ const float ROPE_IREV[32] = {1.591549367e-01f, 1.193493679e-01f, 8.949939907e-02f, 6.711508334e-02f, 5.032921210e-02f, 3.774158657e-02f, 2.830219641e-02f, 2.122365311e-02f,
    1.591549441e-02f, 1.193493698e-02f, 8.949940093e-03f, 6.711508147e-03f, 5.032920744e-03f, 3.774158657e-03f, 2.830219688e-03f, 2.122365171e-03f,
    1.591549371e-03f, 1.193493721e-03f, 8.949940093e-04f, 6.711508031e-04f, 5.032921326e-04f, 3.774158540e-04f, 2.830219746e-04f, 2.122365258e-04f,
    1.591549517e-04f, 1.193493663e-04f, 8.949940093e-05f, 6.711508468e-05f, 5.032921035e-05f, 3.774158540e-05f, 2.830219637e-05f, 2.122365368e-05f};
struct SchedA : pg8::StaticOrder {
    const char* XB; const char* W;
    __device__ __forceinline__ void ptrs(const Unit& u, const char*& cA, const char*& cB) const {
        const char* x = XB + (size_t)u.pm * (256 * 1024 * 2); const char* w = W + (size_t)u.pn * (256 * 1024 * 2);
        if (u.pn >= 19) { cA = w; cB = x; } else { cA = x; cB = w; }
    }
};
struct SchedP : pg8::StaticOrder {
    const char* A; const char* W;
    __device__ __forceinline__ void ptrs(const Unit& u, const char*& cA, const char*& cB) const { cA = A + (size_t)u.pm * (256 * 1024 * 2); cB = W + (size_t)u.pn * (256 * 1024 * 2); }
};

struct EpiA {
    static constexpr bool MIDHOOK = false;
    unsigned char* ws; bf16_t* GA;
    const float *qn_a, *kn_a, *qn_b, *kn_b;
    __device__ __forceinline__ void mid(AccT&, const Unit&, int, int, int, int) const {}
    __device__ __forceinline__ void qk(const AccT& acc, int row0, int wr, int fr, int fq, bf16_t* dst, int ld, int colh, const float* w, float scale, bool rope) const {
        f32x4 wv[2][2];
        int fq8 = 8 * fq; asm volatile("" : "+v"(fq8));
#pragma unroll
        for (int bj = 0; bj < 2; ++bj)
#pragma unroll
            for (int n = 0; n < 2; ++n) wv[bj][n] = *(const f32x4*)(w + 32 * bj + fq8 + 4 * n) * scale;
        f32x4 irev[2];
#pragma unroll
        for (int n = 0; n < 2; ++n) irev[n] = rope ? *(const f32x4*)(ROPE_IREV + fq8 + 4 * n) : (f32x4){0.f, 0.f, 0.f, 0.f};
#pragma unroll
        for (int ai = 0; ai < 2; ++ai)
#pragma unroll
            for (int m = 0; m < 4; ++m) {
                const int r = row0 + 128 * ai + 64 * wr + 16 * m + fr;
                f32x4 v[2][2]; float ss = 0.f;
#pragma unroll
                for (int bj = 0; bj < 2; ++bj)
#pragma unroll
                    for (int n = 0; n < 2; ++n) { v[bj][n] = acc[ai][bj][m][n]; const f32x4 x = v[bj][n]; ss += (x[0] * x[0] + x[1] * x[1]) + (x[2] * x[2] + x[3] * x[3]); }
                ss += __shfl_xor(ss, 16); ss += __shfl_xor(ss, 32);
                const float inv = __builtin_amdgcn_rsqf(ss * (1.0f / 64.0f) + NORM_EPS);
#pragma unroll
                for (int bj = 0; bj < 2; ++bj)
#pragma unroll
                    for (int n = 0; n < 2; ++n) v[bj][n] = v[bj][n] * inv * wv[bj][n];
                if (rope) {
                    const float fp = (float)(r & (SEQ - 1));
#pragma unroll
                    for (int n = 0; n < 2; ++n) {
                        f32x4 c, s;
#pragma unroll
                        for (int j = 0; j < 4; ++j) { const float fr_ = __builtin_amdgcn_fractf(fp * irev[n][j]); c[j] = __builtin_amdgcn_cosf(fr_); s[j] = __builtin_amdgcn_sinf(fr_); }
                        const f32x4 x1 = v[0][n], x2 = v[1][n];
                        v[0][n] = x1 * c - x2 * s; v[1][n] = x2 * c + x1 * s;
                    }
                }
                bf16_t* rowp = dst + (size_t)r * ld + colh + 8 * fq;
#pragma unroll
                for (int bj = 0; bj < 2; ++bj) { u32x4 o; o.x = cvt_pk_bf16(v[bj][0][0], v[bj][0][1]); o.y = cvt_pk_bf16(v[bj][0][2], v[bj][0][3]); o.z = cvt_pk_bf16(v[bj][1][0], v[bj][1][1]); o.w = cvt_pk_bf16(v[bj][1][2], v[bj][1][3]);
                    *(u32x4*)(rowp + 32 * bj) = o; }
            }
    }
    __device__ __forceinline__ void act(const AccT& acc, int row0, int wr, int wc, int fr, int fq, bf16_t* dst, int ld, int col0) const {
#pragma unroll
        for (int ai = 0; ai < 2; ++ai)
#pragma unroll
            for (int m = 0; m < 4; ++m) {
                const int r = row0 + 128 * ai + 64 * wr + 16 * m + fr;
                bf16_t* rowp = dst + (size_t)r * ld + col0 + 64 * wc + 8 * fq;
#pragma unroll
                for (int bj = 0; bj < 2; ++bj) { unsigned w[4];
#pragma unroll
                    for (int n = 0; n < 2; ++n)
#pragma unroll
                        for (int h = 0; h < 2; ++h) { const f32x2_t x = {acc[ai][bj][m][n][2 * h], acc[ai][bj][m][n][2 * h + 1]};
                            const f32x2_t t = x * (-LOG2E); f32x2_t e; e[0] = __builtin_amdgcn_exp2f(t[0]); e[1] = __builtin_amdgcn_exp2f(t[1]);
                            const f32x2_t d = e + 1.0f; f32x2_t sg; sg[0] = __builtin_amdgcn_rcpf(d[0]); sg[1] = __builtin_amdgcn_rcpf(d[1]);
                            const f32x2_t o = x * sg; w[2 * n + h] = cvt_pk_bf16(o[0], o[1]); }
                    u32x4 wv; wv.x = w[0]; wv.y = w[1]; wv.z = w[2]; wv.w = w[3];
                    *(u32x4*)(rowp + 32 * bj) = wv; }
            }
    }
    __device__ __forceinline__ void operator()(AccT& acc, const Unit& u, int wr, int wc, int fr, int fq) const {
        const int pn = u.pn, row0 = u.pm * 256;
        bf16_t* const QA = (bf16_t*)(ws + WS_QA); bf16_t* const KA = (bf16_t*)(ws + WS_KA); bf16_t* const QB = (bf16_t*)(ws + WS_QB); bf16_t* const KB = (bf16_t*)(ws + WS_KB);
        bf16_t* const VBT = (bf16_t*)(ws + WS_VBT); bf16_t* const ZA = (bf16_t*)(ws + WS_ZA); bf16_t* const ZB = (bf16_t*)(ws + WS_ZB); bf16_t* const VAT = (bf16_t*)(ws + WS_VAT);
        bf16_t* const GB = GA + (size_t)T * 1024;
        if (pn < 2) qk(acc, row0, wr, fr, fq, QA, 512, 256 * pn + 64 * wc, qn_a, QSCALE, false);
        else if (pn < 4) qk(acc, row0, wr, fr, fq, KA, 512, 256 * (pn - 2) + 64 * wc, kn_a, 1.0f, false);
        else if (pn < 6) qk(acc, row0, wr, fr, fq, QB, 512, 256 * (pn - 4) + 64 * wc, qn_b, QSCALE, true);
        else if (pn == 6) {
            if (wc < 2) qk(acc, row0, wr, fr, fq, KB, 128, 64 * wc, kn_b, 1.0f, true);
            else {
#pragma unroll
                for (int ai = 0; ai < 2; ++ai)
#pragma unroll
                    for (int m = 0; m < 4; ++m) {
                        const int r = row0 + 128 * ai + 64 * wr + 16 * m + fr;
                        bf16_t* base = VBT + ((size_t)(r >> 3) * 128 + 64 * (wc - 2) + 8 * fq) * 8 + (r & 7);
#pragma unroll
                        for (int bj = 0; bj < 2; ++bj)
#pragma unroll
                            for (int n = 0; n < 2; ++n) { const f32x4 x = acc[ai][bj][m][n];
                                const unsigned p0 = cvt_pk_bf16(x[0], x[1]), p1 = cvt_pk_bf16(x[2], x[3]);
                                bf16_t* q = base + (32 * bj + 4 * n) * 8;
                                q[0] = (bf16_t)(p0 & 0xffffu); q[8] = (bf16_t)(p0 >> 16); q[16] = (bf16_t)(p1 & 0xffffu); q[24] = (bf16_t)(p1 >> 16); }
                    }
            }
        }
        else if (pn < 9) act(acc, row0, wr, wc, fr, fq, ZA, 512, 256 * (pn - 7));
        else if (pn < 11) act(acc, row0, wr, wc, fr, fq, ZB, 512, 256 * (pn - 9));
        else if (pn < 19) {
#pragma unroll
            for (int ai = 0; ai < 2; ++ai)
#pragma unroll
                for (int m = 0; m < 4; ++m) {
                    const int r = row0 + 128 * ai + 64 * wr + 16 * m + fr;
                    unsigned Rw[4], Sw[4];
#pragma unroll
                    for (int n = 0; n < 2; ++n)
#pragma unroll
                        for (int h = 0; h < 2; ++h) { const f32x2_t a2 = {acc[ai][0][m][n][2 * h], acc[ai][0][m][n][2 * h + 1]}, b2 = {acc[ai][1][m][n][2 * h], acc[ai][1][m][n][2 * h + 1]};
                            const f32x2_t ta = a2 * (-LOG2E), tb = b2 * (-LOG2E); f32x2_t ea, eb;
                            ea[0] = __builtin_amdgcn_exp2f(ta[0]); ea[1] = __builtin_amdgcn_exp2f(ta[1]); eb[0] = __builtin_amdgcn_exp2f(tb[0]); eb[1] = __builtin_amdgcn_exp2f(tb[1]);
                            const f32x2_t ua = ea + 1.0f, ub = eb + 1.0f, pr = ua * ub; f32x2_t t; t[0] = __builtin_amdgcn_rcpf(pr[0]); t[1] = __builtin_amdgcn_rcpf(pr[1]);
                            const f32x2_t S2 = t * ua, R2 = t * ub * ub;
                            Sw[2 * n + h] = cvt_pk_bf16(S2[0], S2[1]); Rw[2 * n + h] = cvt_pk_bf16(R2[0], R2[1]); }
                    const size_t off = (size_t)r * 1024 + 128 * (pn - 11) + 32 * wc + 8 * fq;
                    u32x4 w; w.x = Rw[0]; w.y = Rw[1]; w.z = Rw[2]; w.w = Rw[3];
                    *(u32x4*)(GA + off) = w;
                    w.x = Sw[0]; w.y = Sw[1]; w.z = Sw[2]; w.w = Sw[3];
                    *(u32x4*)(GB + off) = w;
                }
        }
        else {
            const int c0 = 256 * (pn - 19);
#pragma unroll
            for (int ai = 0; ai < 2; ++ai)
#pragma unroll
                for (int m = 0; m < 4; ++m) {
                    const int c = c0 + 128 * ai + 64 * wr + 16 * m + fr;
#pragma unroll
                    for (int bj = 0; bj < 2; ++bj) {
                        const int t0 = row0 + 64 * wc + 32 * bj + 8 * fq;
                        const f32x4 x0 = acc[ai][bj][m][0], x1 = acc[ai][bj][m][1];
                        u32x4 o; o.x = cvt_pk_bf16(x0[0], x0[1]); o.y = cvt_pk_bf16(x0[2], x0[3]); o.z = cvt_pk_bf16(x1[0], x1[1]); o.w = cvt_pk_bf16(x1[2], x1[3]);
                        *(u32x4*)(VAT + ((size_t)(t0 >> 3) * 512 + c) * 8) = o; }
                }
        }
    }
};

struct EpiC1 {
    static constexpr bool MIDHOOK = true;
    const bf16_t *GA, *GB; bf16_t* MG;
    __device__ __forceinline__ void mid(AccT& acc, const Unit& u, int wr, int wc, int fr, int fq) const {
        unsigned base = (unsigned)((u.pm * 256 + 64 * wr + fr) * 1024 + u.pn * 256 + 64 * wc + 8 * fq) * 2u;
        asm volatile("" : "+v"(base));
#pragma unroll
        for (int ai = 0; ai < 2; ++ai)
#pragma unroll
            for (int m = 0; m < 4; ++m) {
#pragma unroll
                for (int bj = 0; bj < 2; ++bj) {
                    const unsigned off = base + (unsigned)((128 * ai + 16 * m) * 1024 + 32 * bj) * 2u;
                    const u32x4 a = *(const u32x4*)((const char*)GA + off);
                    f32x4 r0, r1;
                    r0[0] = bf_lo(a.x); r0[1] = bf_hi(a.x); r0[2] = bf_lo(a.y); r0[3] = bf_hi(a.y);
                    r1[0] = bf_lo(a.z); r1[1] = bf_hi(a.z); r1[2] = bf_lo(a.w); r1[3] = bf_hi(a.w);
                    acc[ai][bj][m][0] *= r0; acc[ai][bj][m][1] *= r1;
                }

            }
    }
    __device__ __forceinline__ void operator()(AccT& acc, const Unit& u, int wr, int wc, int fr, int fq) const {
        unsigned base = (unsigned)((u.pm * 256 + 64 * wr + fr) * 1024 + u.pn * 256 + 64 * wc + 8 * fq) * 2u;
        asm volatile("" : "+v"(base));
        u32x4 sv[2][4][2];
#pragma unroll
        for (int ai = 0; ai < 2; ++ai)
#pragma unroll
            for (int m = 0; m < 4; ++m)
#pragma unroll
                for (int bj = 0; bj < 2; ++bj) sv[ai][m][bj] = *(const u32x4*)((const char*)GB + base + (unsigned)((128 * ai + 16 * m) * 1024 + 32 * bj) * 2u);
#pragma unroll
        for (int ai = 0; ai < 2; ++ai)
#pragma unroll
            for (int m = 0; m < 4; ++m) {
#pragma unroll
                for (int bj = 0; bj < 2; ++bj) {
                    const unsigned off = base + (unsigned)((128 * ai + 16 * m) * 1024 + 32 * bj) * 2u;
                    const u32x4 b = sv[ai][m][bj];
                    const f32x4 x0 = acc[ai][bj][m][0], x1 = acc[ai][bj][m][1];
                    u32x4 o; o.x = cvt_pk_bf16(x0[0] * bf_lo(b.x), x0[1] * bf_hi(b.x)); o.y = cvt_pk_bf16(x0[2] * bf_lo(b.y), x0[3] * bf_hi(b.y));
                    o.z = cvt_pk_bf16(x1[0] * bf_lo(b.z), x1[1] * bf_hi(b.z)); o.w = cvt_pk_bf16(x1[2] * bf_lo(b.w), x1[3] * bf_hi(b.w));
                    *(u32x4*)((char*)MG + off) = o;
                }
            }
    }
};
struct EpiC2 {
    static constexpr bool MIDHOOK = false;
    const float *xp, *xs; float* out;
    __device__ __forceinline__ void mid(AccT&, const Unit&, int, int, int, int) const {}
    __device__ __forceinline__ void operator()(AccT& acc, const Unit& u, int wr, int wc, int fr, int fq) const {
        const int row0 = u.pm * 256;
        const char* xb = (const char*)(row0 < TP ? xp + (size_t)row0 * 1024 : xs + (size_t)(row0 - TP) * 1024);
        char* ob = (char*)(out + (size_t)row0 * 1024);
        unsigned base = (unsigned)((64 * wr + fr) * 1024 + u.pn * 256 + 64 * wc + 4 * fq) * 4u;
        asm volatile("" : "+v"(base));
#pragma unroll
        for (int ai = 0; ai < 2; ++ai) {
            f32x4 xv[4][2][2];
#pragma unroll
            for (int m = 0; m < 4; ++m)
#pragma unroll
                for (int bj = 0; bj < 2; ++bj)
#pragma unroll
                    for (int n = 0; n < 2; ++n) xv[m][bj][n] = *(const f32x4*)(xb + base + (unsigned)((128 * ai + 16 * m) * 1024 + 32 * bj + 16 * n) * 4u);
#pragma unroll
            for (int m = 0; m < 4; ++m)
#pragma unroll
                for (int bj = 0; bj < 2; ++bj)
#pragma unroll
                    for (int n = 0; n < 2; ++n) *(f32x4*)(ob + base + (unsigned)((128 * ai + 16 * m) * 1024 + 32 * bj + 16 * n) * 4u) = xv[m][bj][n] + acc[ai][bj][m][n];
            asm volatile("" ::: "memory");
        }
    }
};

__device__ __forceinline__ int map_col(int n) {
    if (n < 1024) return n;
    if (n < 1536) return 2048 + n - 1024;
    if (n < 1664) return 2560 + n - 1536;
    if (n < 1792) return 2688 + n - 1664;
    if (n < 2304) return 1536 + n - 1792;
    if (n < 2816) return 2816 + n - 2304;
    if (n < 4864) { const int w = n - 2816, tg = w >> 8, ww = w & 255, wcw = ww >> 6, bj = (ww >> 5) & 1, e = ww & 31;
        return (bj ? 4352 : 3328) + 128 * tg + 32 * wcw + e; }
    return 1024 + n - 4864;
}
__device__ __forceinline__ void p0_transpose_item(const float* W, int N, int ksrc0, int nsrc0, const float* ksc, bf16_t* WT, int nrow0, int kdst0, LAS float* scr, int lane) {
#pragma unroll 8
    for (int i = 0; i < 32; ++i) { const int kk = 2 * i + (lane >> 5); float v = W[(size_t)(ksrc0 + kk) * N + nsrc0 + (lane & 31)]; if (ksc) v *= ksc[ksrc0 + kk]; scr[kk * 33 + (lane & 31)] = v; }
    asm volatile("s_waitcnt lgkmcnt(0)" ::: "memory");
    const int c = lane & 7;
#pragma unroll
    for (int j = 0; j < 4; ++j) { const int n = (lane >> 3) + 8 * j; const LAS float* s = scr + (8 * c) * 33 + n;
        u32x4 o; o.x = cvt_pk_bf16(s[0 * 33], s[1 * 33]); o.y = cvt_pk_bf16(s[2 * 33], s[3 * 33]); o.z = cvt_pk_bf16(s[4 * 33], s[5 * 33]); o.w = cvt_pk_bf16(s[6 * 33], s[7 * 33]);
        *(u32x4*)(WT + (size_t)(nrow0 + n) * 1024 + kdst0 + 8 * c) = o; }
    asm volatile("s_waitcnt lgkmcnt(0)" ::: "memory");
}

struct Args { const float* in[13]; float* out; unsigned char* ws; int ph_lo, ph_hi; };

__device__ __forceinline__ void p0_load4(const Args& a, int m0, int NGW, int lane, f32x4 (&v)[4][4]) {
#pragma unroll
    for (int u = 0; u < 4; ++u) { const int m = min(m0 + u * NGW, T - 1);
        const float* xrow = m < TP ? a.in[0] + (size_t)m * 1024 : a.in[1] + (size_t)(m - TP) * 1024;
        const f32x4* xr = (const f32x4*)xrow + lane;
#pragma unroll
        for (int j = 0; j < 4; ++j) v[u][j] = xr[64 * j]; }
}
__device__ __forceinline__ void p0_proc4(bf16_t* XB, int m0, int NGW, int lane, const f32x4 (&v)[4][4]) {
    float s[4];
#pragma unroll
    for (int u = 0; u < 4; ++u) { float t = 0.f;
#pragma unroll
        for (int j = 0; j < 4; ++j) t += (v[u][j][0] * v[u][j][0] + v[u][j][1] * v[u][j][1]) + (v[u][j][2] * v[u][j][2] + v[u][j][3] * v[u][j][3]);
        s[u] = t; }
#pragma unroll
    for (int o = 1; o < 64; o <<= 1) {
#pragma unroll
        for (int u = 0; u < 4; ++u) s[u] += __shfl_xor(s[u], o); }
#pragma unroll
    for (int u = 0; u < 4; ++u) { const int m = m0 + u * NGW; if (m >= T) break;
        const float rstd = 1.0f / sqrtf(s[u] * (1.0f / 1024.0f) + NORM_EPS);
        u32x2* o8 = (u32x2*)(XB + (size_t)m * 1024) + lane;
#pragma unroll
        for (int j = 0; j < 4; ++j) { u32x2 w; w.x = cvt_pk_bf16(v[u][j][0] * rstd, v[u][j][1] * rstd); w.y = cvt_pk_bf16(v[u][j][2] * rstd, v[u][j][3] * rstd); o8[64 * j] = w; } }
}

__device__ __forceinline__ void p0_prologue(const Args& a, LAS unsigned char* lds, int wave, int lane) {
    if (wave < 4) {
        LAS float* scr = (LAS float*)(lds + wave * 16384);
        const int gw = blockIdx.x * 4 + wave, NGW = gridDim.x * 4;
        const float* w_in = a.in[3]; const float* w_oa = a.in[10]; const float* w_ob = a.in[11]; const float* w_o = a.in[12]; const float* ng = a.in[2];
        bf16_t* WIN = (bf16_t*)(a.ws + WS_WIN); bf16_t* WAB = (bf16_t*)(a.ws + WS_WAB); bf16_t* WO = (bf16_t*)(a.ws + WS_WO);
        constexpr int I_IN = 16 * 168, I_OA = 8 * 32, I_OB = 8 * 32, I_O = 16 * 32, NITEMS = I_IN + I_OA + I_OB + I_O;
        for (int it = gw; it < NITEMS; it += NGW) {
            int r = it;
            if (r < I_IN) { const int kb = r / 168, nb = r % 168; p0_transpose_item(w_in, NIN, 64 * kb, map_col(32 * nb), ng, WIN, 32 * nb, 64 * kb, scr, lane); continue; } r -= I_IN;
            if (r < I_OA) { const int kb = r / 32, nb = r % 32; p0_transpose_item(w_oa, 1024, 64 * kb, 32 * nb, nullptr, WAB, 32 * nb, 64 * kb, scr, lane); continue; } r -= I_OA;
            if (r < I_OB) { const int kb = r / 32, nb = r % 32; p0_transpose_item(w_ob, 1024, 64 * kb, 32 * nb, nullptr, WAB, 32 * nb, 512 + 64 * kb, scr, lane); continue; } r -= I_OB;
            { const int kb = r / 32, nb = r % 32; p0_transpose_item(w_o, 1024, 64 * kb, 32 * nb, nullptr, WO, 32 * nb, 64 * kb, scr, lane); }
        }
    } else {
        bf16_t* XB = (bf16_t*)(a.ws + WS_XB);
        const int gw = blockIdx.x * 4 + (wave - 4), NGW = gridDim.x * 4;
        f32x4 va[4][4], vb[4][4];
        int m0 = gw;
        if (m0 < T) p0_load4(a, m0, NGW, lane, va);
        while (m0 < T) {
            const int m1 = m0 + 4 * NGW; const bool has1 = m1 < T;
            if (has1) p0_load4(a, m1, NGW, lane, vb);
            p0_proc4(XB, m0, NGW, lane, va);
            if (!has1) break;
            const int m2 = m1 + 4 * NGW; const bool has2 = m2 < T;
            if (has2) p0_load4(a, m2, NGW, lane, va);
            p0_proc4(XB, m1, NGW, lane, vb);
            if (!has2) break;
            m0 = m2;
        }
    }
}

struct AttnP { const bf16_t *QA, *KA, *VAT, *ZA, *QB, *KB, *VBT, *ZB; bf16_t* Y; const float* sink; const float* rpb; };
constexpr int ATT_VOFF = 73728, ATT_RPB = 147456;
__device__ __forceinline__ int att_vpos(int d) { return (d & 32) | ((d & 4) << 2) | ((d & 24) >> 1) | (d & 3); }

template <bool SWA> struct AttStage { u32x4 k[SWA ? 6 : 9]; u32x4 v[SWA ? 6 : 9]; };

template <bool SWA>
__device__ __forceinline__ void att_decode(int item, int& b, int& h, int& x) {
    if (SWA) { x = item & 31; h = (item >> 5) & 1; b = item >> 6; }
    else { x = item & 31; h = (item >> 5) & 7; b = item >> 8; }
}
template <bool SWA>
__device__ __forceinline__ void att_load(const AttnP& P, int item, int tid, AttStage<SWA>& st) {
    constexpr int NCH = SWA ? 6 : 9, KLD = SWA ? 128 : 512;
    int b, h, x; att_decode<SWA>(item, b, h, x);
    const int tb = b * SEQ, kcol = h * 64;
    const bf16_t* Kp = SWA ? P.KB : P.KA; const bf16_t* VT = SWA ? P.VBT : P.VAT;
    const int base = SWA ? 128 * x - 128 : min(max(2 * x - 4, 0), 56);
#pragma unroll
    for (int i = 0; i < NCH; ++i) {
        const int idx = tid + 512 * i;
        { const int k = idx >> 3, c = idx & 7; int tok;
          if (SWA) tok = min(max(base + k, 0), SEQ - 1); else tok = min(base + (k >> 6), 63) * 64 + (k & 63);
          st.k[i] = *(const u32x4*)(Kp + (size_t)(tb + tok) * KLD + kcol + 8 * c); }
        { const int kb = idx >> 6, d = idx & 63; int tok;
          if (SWA) tok = min(max(base + 8 * kb, 0), SEQ - 8); else tok = min(base + (kb >> 3), 63) * 64 + 8 * (kb & 7);
          st.v[i] = *(const u32x4*)(VT + ((size_t)((tb + tok) >> 3) * KLD + kcol + d) * 8); }
    }
}
template <bool SWA>
__device__ __forceinline__ void att_store(LAS unsigned char* lds, int tid, const AttStage<SWA>& st) {
    constexpr int NCH = SWA ? 6 : 9;
#pragma unroll
    for (int i = 0; i < NCH; ++i) {
        const int idx = tid + 512 * i, k = idx >> 3, c = idx & 7;
        *(LAS u32x4*)(lds + k * 128 + ((c ^ ((k >> 1) & 7)) << 4)) = st.k[i];
        *(LAS u32x4*)(lds + ATT_VOFF + ((idx & ~63) + att_vpos(idx & 63)) * 16) = st.v[i];
    }
}

struct AttQZ { bf16x8 q0, q1; u32x4 z[2]; };
template <bool SWA>
__device__ __forceinline__ void att_load_qz(const AttnP& P, int lane, int tb, int qpos0, int hq, AttQZ& o) {
    const int li = lane & 15, fq = lane >> 4;
    const bf16_t* Q = SWA ? P.QB : P.QA; const bf16_t* Z = SWA ? P.ZB : P.ZA;
    const bf16_t* qrow = Q + (size_t)(tb + qpos0 + li) * 512 + hq * 64 + 8 * fq;
    o.q0 = *(const bf16x8*)qrow; o.q1 = *(const bf16x8*)(qrow + 32);
    const bf16_t* zrow = Z + (size_t)(tb + qpos0 + li) * 512 + hq * 64 + 8 * fq;
#pragma unroll
    for (int hh = 0; hh < 2; ++hh) o.z[hh] = *(const u32x4*)(zrow + 32 * hh);
}
template <bool SWA, bool FAST>
__device__ __forceinline__ void att_tile(const AttnP& P, LAS unsigned char* lds, int lane, int tb, int qpos0, int hq, int kloc0, int r, int ct, int kr0, int kc0, const AttQZ& qz, float shift) {
    constexpr int NSEG = SWA ? 9 : 8, KMAX = SWA ? 383 : 575;
    const int li = lane & 15, fq = lane >> 4;
    const bf16x8 bq0 = qz.q0, bq1 = qz.q1;
    f32x4 sc[NSEG][2];
    constexpr int GS = SWA ? 3 : 2;
    const int krow0 = (SWA ? kloc0 : kc0) + li, ksw = (krow0 >> 1) & 7;
    const LAS unsigned char* kb0 = lds + krow0 * 128 + ((fq ^ ksw) << 4);
    const LAS unsigned char* kb1 = lds + krow0 * 128 + (((fq + 4) ^ ksw) << 4);
#pragma unroll
    for (int s0 = 0; s0 < NSEG; s0 += GS) {
        bf16x8 kf[GS][2][2];
#pragma unroll
        for (int g = 0; g < GS; ++g)
#pragma unroll
            for (int kt = 0; kt < 2; ++kt) { const int s = s0 + g;
                const int segoff = SWA ? (32 * s + 16 * kt) * 128 : (((kr0 + s) % 9) * 64 + 16 * kt) * 128;
                kf[g][kt][0] = *(const LAS bf16x8*)(kb0 + segoff); kf[g][kt][1] = *(const LAS bf16x8*)(kb1 + segoff); }
        __builtin_amdgcn_sched_barrier(0);
#pragma unroll
        for (int g = 0; g < GS; ++g)
#pragma unroll
            for (int kt = 0; kt < 2; ++kt) {
                f32x4 z = FAST ? (f32x4){-shift, -shift, -shift, -shift} : (f32x4){0.f, 0.f, 0.f, 0.f};
                z = __builtin_amdgcn_mfma_f32_16x16x32_bf16(kf[g][kt][0], bq0, z, 0, 0, 0);
                z = __builtin_amdgcn_mfma_f32_16x16x32_bf16(kf[g][kt][1], bq1, z, 0, 0, 0);
                sc[s0 + g][kt] = z; }
        __builtin_amdgcn_sched_barrier(0);
    }
    float mx = -1e30f;
    if (SWA) {
        const int qp = qpos0 + li;
#pragma unroll
        for (int s = 0; s < NSEG; ++s) {
            const int kb0 = qpos0 - 128 + 32 * s;
            if (s >= 1 && s <= 7 && kb0 >= 0 && kb0 + 31 < SEQ) {
#pragma unroll
                for (int kt = 0; kt < 2; ++kt)
#pragma unroll
                    for (int j = 0; j < 4; ++j) { if (!FAST) mx = fmaxf(mx, sc[s][kt][j]); }
            } else {
                asm volatile("");
#pragma unroll
                for (int kt = 0; kt < 2; ++kt)
#pragma unroll
                    for (int j = 0; j < 4; ++j) { const int kp = kb0 + 16 * kt + 4 * fq + j; const int d = kp - qp;
                        const bool ok = (kp >= 0) && (kp < SEQ) && (d <= 128) && (d >= -128);
                        const float v = ok ? sc[s][kt][j] : -1e30f; sc[s][kt][j] = v; if (!FAST) mx = fmaxf(mx, v); }
            }
        }
    } else if (!FAST) {
        const int c = 16 * ct + li, cs = min(max(c - 8, 0), 48);
        const LAS float* rp = (const LAS float*)(lds + ATT_RPB) + (kr0 - r + 7) * 64 + (kc0 + 4 * fq - c + 31);
#pragma unroll
        for (int s = 0; s < NSEG; ++s) {
            float bias[2][4];
#pragma unroll
            for (int kt = 0; kt < 2; ++kt)
#pragma unroll
                for (int j = 0; j < 4; ++j) bias[kt][j] = rp[s * 64 + 16 * kt + j];
#pragma unroll
            for (int kt = 0; kt < 2; ++kt)
#pragma unroll
                for (int j = 0; j < 4; ++j) { const int kc = kc0 + 16 * kt + 4 * fq + j; const bool ok = (kc >= cs) && (kc < cs + 16);
                    float t = sc[s][kt][j] + bias[kt][j]; asm volatile("" : "+v"(t));
                    const float v = ok ? t : -1e30f; sc[s][kt][j] = v; if (!FAST) mx = fmaxf(mx, v); }
        }
    }
    if (!FAST) { mx = fmaxf(mx, __shfl_xor(mx, 16)); mx = fmaxf(mx, __shfl_xor(mx, 32)); }
    float sk = 0.f;
    if (SWA) { sk = P.sink[hq] * LOG2E; if (!FAST) mx = fmaxf(mx, sk); }
    float l = 0.f; f32x2_t l2 = {0.f, 0.f};
    bf16x8 pb[NSEG];
    if constexpr (!SWA && FAST) {
        const int c = 16 * ct + li, cs = min(max(c - 8, 0), 48), w = cs - kc0;
        const LAS float* rp = (const LAS float*)(lds + ATT_RPB) + (kr0 - r + 7) * 64 + (kc0 + 4 * fq - c + 31);
        bool hi[4]; const LAS float* rpj[4];
#pragma unroll
        for (int j = 0; j < 4; ++j) { hi[j] = (4 * fq + j) < w; rpj[j] = rp + (hi[j] ? 16 : 0) + j; }
        const unsigned m01 = (hi[0] ? 0u : 0xffffu) | (hi[1] ? 0u : 0xffff0000u), m23 = (hi[2] ? 0u : 0xffffu) | (hi[3] ? 0u : 0xffff0000u);
#pragma unroll
        for (int s = 0; s < NSEG; ++s) {
            float p[4];
#pragma unroll
            for (int j = 0; j < 4; ++j) { const float v = hi[j] ? sc[s][1][j] : sc[s][0][j]; p[j] = __builtin_amdgcn_exp2f(v + rpj[j][s * 64]); }
            l2 += (f32x2_t){p[0], p[1]}; l2 += (f32x2_t){p[2], p[3]};
            const unsigned pk01 = cvt_pk_bf16(p[0], p[1]), pk23 = cvt_pk_bf16(p[2], p[3]);
            u32x4 wv; wv.x = pk01 & m01; wv.y = pk23 & m23; wv.z = pk01 & ~m01; wv.w = pk23 & ~m23;
            pb[s] = __builtin_bit_cast(bf16x8, wv);
        }
    } else
#pragma unroll
    for (int s = 0; s < NSEG; ++s) {
        float p[8];
#pragma unroll
        for (int kt = 0; kt < 2; ++kt)
#pragma unroll
            for (int j = 0; j < 4; ++j) p[4 * kt + j] = __builtin_amdgcn_exp2f(FAST ? sc[s][kt][j] : sc[s][kt][j] - mx);
#pragma unroll
        for (int e = 0; e < 8; e += 2) l2 += (f32x2_t){p[e], p[e + 1]};
        u32x4 w; w.x = cvt_pk_bf16(p[0], p[1]); w.y = cvt_pk_bf16(p[2], p[3]); w.z = cvt_pk_bf16(p[4], p[5]); w.w = cvt_pk_bf16(p[6], p[7]);
        pb[s] = __builtin_bit_cast(bf16x8, w);
    }
    l += l2[0] + l2[1];
    l += __shfl_xor(l, 16); l += __shfl_xor(l, 32);
    if (SWA) l += __builtin_amdgcn_exp2f(FAST ? sk - shift : sk - mx);
    const float rl = 1.0f / l;
    f32x4 oacc[4];
#pragma unroll
    for (int dt = 0; dt < 4; ++dt) oacc[dt] = (f32x4){0.f, 0.f, 0.f, 0.f};
    constexpr int GV = SWA ? 3 : 2;
    const int g0l = (SWA ? kloc0 : kc0) + 4 * fq;
    const LAS unsigned char* vb0 = lds + ATT_VOFF + (g0l >> 3) * 1024 + li * 16 + (g0l & 7) * 2;
#pragma unroll
    for (int s0 = 0; s0 < NSEG; s0 += GV) {
        u32x2 vf[GV][4][2];
#pragma unroll
        for (int g = 0; g < GV; ++g) { const int s = s0 + g;
            const int segv = SWA ? s * 4096 : ((kr0 + s) % 9) * 8192;
#pragma unroll
            for (int dt = 0; dt < 4; ++dt) {
                vf[g][dt][0] = *(const LAS u32x2*)(vb0 + segv + dt * 256); asm volatile("" ::: "memory");
                vf[g][dt][1] = *(const LAS u32x2*)(vb0 + segv + dt * 256 + 2048); asm volatile("" ::: "memory"); } }
        __builtin_amdgcn_sched_barrier(0);
#pragma unroll
        for (int g = 0; g < GV; ++g)
#pragma unroll
            for (int dt = 0; dt < 4; ++dt) {
                u32x4 w; w.x = vf[g][dt][0].x; w.y = vf[g][dt][0].y; w.z = vf[g][dt][1].x; w.w = vf[g][dt][1].y;
                oacc[dt] = __builtin_amdgcn_mfma_f32_16x16x32_bf16(__builtin_bit_cast(bf16x8, w), pb[s0 + g], oacc[dt], 0, 0, 0); }
        __builtin_amdgcn_sched_barrier(0);
    }
    const size_t tq = (size_t)(tb + qpos0 + li);
#pragma unroll
    for (int hh = 0; hh < 2; ++hh) {
        const u32x4 z = qz.z[hh]; const f32x4 a = oacc[2 * hh], b = oacc[2 * hh + 1];
        u32x4 o; o.x = cvt_pk_bf16(a[0] * rl * bf_lo(z.x), a[1] * rl * bf_hi(z.x)); o.y = cvt_pk_bf16(a[2] * rl * bf_lo(z.y), a[3] * rl * bf_hi(z.y));
        o.z = cvt_pk_bf16(b[0] * rl * bf_lo(z.z), b[1] * rl * bf_hi(z.z)); o.w = cvt_pk_bf16(b[2] * rl * bf_lo(z.w), b[3] * rl * bf_hi(z.w));
        *(u32x4*)(P.Y + tq * 1024 + (SWA ? 512 : 0) + hq * 64 + 32 * hh + 8 * fq) = o;
    }
}

template <bool SWA>
__device__ __forceinline__ void att_phase(const AttnP& P, LAS unsigned char* lds, int tid, int wave, int lane, bool fast, float shift, AttStage<SWA>& st, AttQZ& qzn, bool pre) {
    constexpr int NITEMS = SWA ? 768 : 3072;
    int item = blockIdx.x;
#define ATT_QPOS(x) (SWA ? 128 * (x) + 16 * wave : (2 * (x) + (wave >> 2)) * 64 + 16 * (wave & 3))
    if (!pre && item < NITEMS) { int b, h, x; att_decode<SWA>(item, b, h, x); att_load<SWA>(P, item, tid, st); att_load_qz<SWA>(P, lane, b * SEQ, ATT_QPOS(x), SWA ? 4 * h : h, qzn); }
    for (; item < NITEMS; item += gridDim.x) {
        int b, h, x; att_decode<SWA>(item, b, h, x);
        att_store<SWA>(lds, tid, st);
        if (!SWA) { if (tid < 465) ((LAS float*)(lds + ATT_RPB))[tid] = P.rpb[h * 465 + tid] * LOG2E; }
        __syncthreads();
        const int nitem = item + (int)gridDim.x; const bool has_next = nitem < NITEMS;
        int nb = 0, nh = 0, nx = 0; if (has_next) { att_decode<SWA>(nitem, nb, nh, nx); att_load<SWA>(P, nitem, tid, st); }
        const int tb = b * SEQ;
        if (SWA) {
#pragma unroll 1
            for (int j = 0; j < 4; ++j) { int kl = 16 * wave; asm volatile("" : "+v"(kl));
                const AttQZ qz = qzn;
                if (j < 3) att_load_qz<true>(P, lane, tb, ATT_QPOS(x), 4 * h + j + 1, qzn);
                else if (has_next) att_load_qz<true>(P, lane, nb * SEQ, ATT_QPOS(nx), 4 * nh, qzn);
                if (fast) att_tile<true, true>(P, lds, lane, tb, 128 * x + 16 * wave, 4 * h + j, kl, 0, 0, 0, 0, qz, shift);
                else att_tile<true, false>(P, lds, lane, tb, 128 * x + 16 * wave, 4 * h + j, kl, 0, 0, 0, 0, qz, 0.f); }
        } else {
            const AttQZ qz = qzn;
            if (has_next) att_load_qz<false>(P, lane, nb * SEQ, ATT_QPOS(nx), nh, qzn);
            const int basee = min(max(2 * x - 4, 0), 56), r = 2 * x + (wave >> 2), ct = wave & 3, kr0 = min(max(r - 4, 0), 56);
            const int kc0 = ct == 0 ? 0 : (ct == 1 ? 8 : (ct == 2 ? 24 : 32));
            att_tile<false, false>(P, lds, lane, tb, r * 64 + 16 * ct, h, (kr0 - basee) * 64 + kc0, r, ct, kr0, kc0, qz, 0.f);
        }
        __syncthreads();
    }
#undef ATT_QPOS
}


struct NaStep { int b, h, rp, first, nrows; bool full; };
__device__ __forceinline__ NaStep na_step(int t, int spw, int c) {
    NaStep o; const int g = c * spw + t, bh = g >> 5; o.rp = g & 31; o.h = bh & 7; o.b = bh >> 3;
    const int base = min(max(2 * o.rp - 4, 0), 56);
    o.full = (t == 0) || (o.rp == 0);
    if (o.full) { o.first = base; o.nrows = 9; }
    else { const int pb = min(max(2 * o.rp - 6, 0), 56); o.first = pb + 9; o.nrows = base - pb; }
    return o;
}
__device__ __forceinline__ void na_load(const AttnP& P, const NaStep& st, int tid, AttStage<false>& r) {
    const int tb = st.b * SEQ, kcol = st.h * 64;
#pragma unroll
    for (int i = 0; i < 9; ++i) if (i < st.nrows) {
        const int row = min(st.first + i, 63);
        r.k[i] = *(const u32x4*)(P.KA + (size_t)(tb + row * 64 + (tid >> 3)) * 512 + kcol + 8 * (tid & 7));
        r.v[i] = *(const u32x4*)(P.VAT + ((size_t)((tb + row * 64) >> 3) + (tid >> 6)) * 4096 + (size_t)(kcol + (tid & 63)) * 8);
    }
}
__device__ __forceinline__ void na_store(LAS unsigned char* lds, const NaStep& st, int tid, const AttStage<false>& r) {
#pragma unroll
    for (int i = 0; i < 9; ++i) if (i < st.nrows) {
        const int slot = (st.first + i) % 9, k = slot * 64 + (tid >> 3), c = tid & 7;
        *(LAS u32x4*)(lds + k * 128 + ((c ^ ((k >> 1) & 7)) << 4)) = r.k[i];
        *(LAS u32x4*)(lds + ATT_VOFF + (slot * 8 + (tid >> 6)) * 1024 + att_vpos(tid & 63) * 16) = r.v[i];
    }
}
__device__ __forceinline__ void na_phase(const AttnP& P, LAS unsigned char* lds, int tid, int wave, int lane, bool fast, float shift, AttStage<true>& swa_st, AttQZ& swa_qz) {
    const int G = gridDim.x, c = blockIdx.x;
    const int spw = (3072 + G - 1) / G;
    const int nsteps = min(spw, max(3072 - c * spw, 0));
    AttStage<false> rg; AttQZ qzn;
    if (nsteps > 0) { const NaStep s0 = na_step(0, spw, c); na_load(P, s0, tid, rg); att_load_qz<false>(P, lane, s0.b * SEQ, (2 * s0.rp + (wave >> 2)) * 64 + 16 * (wave & 3), s0.h, qzn); }
#define NA_STEP(T, ...) do { \
        const NaStep st = na_step((T), spw, c); \
        na_store(lds, st, tid, rg); \
        if (st.full) {        \
            _Pragma("unroll") for (int i = 0; i < 2; ++i) { const int e = tid + 512 * i, row = e >> 6, dc = (e & 63) - 16; \
                if (e < 960) ((LAS float*)(lds + ATT_RPB))[e] = (dc >= 0 && dc <= 30) ? P.rpb[st.h * 465 + row * 31 + dc] * LOG2E : 0.f; } } \
        __syncthreads(); \
        const AttQZ qz = qzn; \
        __VA_ARGS__; \
        const int r = 2 * st.rp + (wave >> 2), ct = wave & 3, kr0 = min(max(r - 4, 0), 56); \
        const int kc0 = ct == 0 ? 0 : (ct == 1 ? 8 : (ct == 2 ? 24 : 32)); \
        if (fast) att_tile<false, true>(P, lds, lane, st.b * SEQ, r * 64 + 16 * ct, st.h, 0, r, ct, kr0, kc0, qz, shift); \
        else att_tile<false, false>(P, lds, lane, st.b * SEQ, r * 64 + 16 * ct, st.h, 0, r, ct, kr0, kc0, qz, 0.f); \
        __syncthreads(); } while (0)
    for (int t = 0; t + 1 < nsteps; ++t)
        NA_STEP(t, { const NaStep sn = na_step(t + 1, spw, c); na_load(P, sn, tid, rg); att_load_qz<false>(P, lane, sn.b * SEQ, (2 * sn.rp + (wave >> 2)) * 64 + 16 * (wave & 3), sn.h, qzn); });
    if (nsteps > 0)
        NA_STEP(nsteps - 1, { if (c < 768) { int sb, sh, sx; att_decode<true>(c, sb, sh, sx); att_load<true>(P, c, tid, swa_st); att_load_qz<true>(P, lane, sb * SEQ, 128 * sx + 16 * wave, 4 * sh, swa_qz); } });
#undef NA_STEP
}

#define XB_TMO      128
#define XB_XCNT(j)  (256  + 64 * (j))
#define XB_XSUB(j)  (1280 + 64 * (j))
#define XB_XGEN(j)  (2304 + 64 * (j))
#define XB_TOP      3328
#define XB_TOPGEN   3392
#define XCD_BAR_WORDS 3456
#define XB_SPIN_CAP (1u << 18)
__device__ __forceinline__ unsigned xb_ld(unsigned* p)              { return __hip_atomic_load(p, __ATOMIC_RELAXED, __HIP_MEMORY_SCOPE_AGENT); }
__device__ __forceinline__ unsigned xb_add(unsigned* p, unsigned v) { return __hip_atomic_fetch_add(p, v, __ATOMIC_RELAXED, __HIP_MEMORY_SCOPE_AGENT); }
__device__ __forceinline__ unsigned xb_xcc_id() { return (unsigned)__builtin_amdgcn_s_getreg((3 << 11) | 20) & 0xFu; }
#define XB_SPIN(cond, bar) do { unsigned _sp = 0; while (cond) { __builtin_amdgcn_s_sleep(1); \
    if ((++_sp & 255u) == 0u) { if (xb_ld(&(bar)[XB_TMO])) break; if (_sp > XB_SPIN_CAP) { atomicAdd(&(bar)[XB_TMO], 1u); break; } } } } while (0)
struct XcdBarrier { unsigned* bar; unsigned x; volatile LAS unsigned* st; };
__device__ __forceinline__ XcdBarrier xcd_barrier_post(unsigned* bar, volatile LAS unsigned* st) {
    XcdBarrier b; b.bar = bar; b.x = xb_xcc_id(); b.st = st;
    if (threadIdx.x == 0) (void)xb_add(&bar[XB_XCNT(b.x)], 1u);
    return b;
}
__device__ __forceinline__ void xcd_barrier_complete(unsigned* bar, unsigned x, unsigned& nloc, unsigned& nx) {
    const unsigned G = gridDim.x * gridDim.y * gridDim.z;
    unsigned sum, cnt, mine, sp = 0u;
    for (;;) {
        sum = 0u; cnt = 0u; mine = 0u;
#pragma unroll
        for (unsigned j = 0; j < 16; ++j) { const unsigned c = xb_ld(&bar[XB_XCNT(j)]); sum += c; cnt += (c > 0u) ? 1u : 0u; mine = (j == x) ? c : mine; }
        if (sum == G) break;
        __builtin_amdgcn_s_sleep(1);
        if ((++sp & 255u) == 0u) { if (xb_ld(&bar[XB_TMO])) break; if (sp > XB_SPIN_CAP) { atomicAdd(&bar[XB_TMO], 1u); break; } }
    }
    nloc = mine > 0u ? mine : 1u; nx = cnt > 0u ? cnt : 1u;
}
__device__ __forceinline__ void xcd_barrier(const XcdBarrier& b) {
    asm volatile("s_waitcnt vmcnt(0)" ::: "memory");
    __syncthreads();
    if (threadIdx.x == 0) {
        unsigned* bar = b.bar;
        __builtin_amdgcn_s_waitcnt(0);
        unsigned nloc = b.st[0], nx = b.st[1];
        if (nloc == 0u) { xcd_barrier_complete(bar, b.x, nloc, nx); b.st[0] = nloc; b.st[1] = nx; }
        const unsigned old = xb_add(&bar[XB_XSUB(b.x)], 1u);
        const unsigned gen = old / nloc;
        if (old + 1u == (gen + 1u) * nloc) {
            __builtin_amdgcn_fence(__ATOMIC_RELEASE, "agent");
            asm volatile("s_waitcnt vmcnt(0)" ::: "memory");
            const unsigned og = xb_add(&bar[XB_TOP], 1u);
            const unsigned tg = og / nx;
            if (og + 1u == (tg + 1u) * nx) xb_add(&bar[XB_TOPGEN], 1u);
            else XB_SPIN(xb_ld(&bar[XB_TOPGEN]) == tg, bar);
            __builtin_amdgcn_fence(__ATOMIC_ACQUIRE, "agent");
            xb_add(&bar[XB_XGEN(b.x)], 1u);
            asm volatile("s_waitcnt vmcnt(0)" ::: "memory");
        } else {
            XB_SPIN(xb_ld(&bar[XB_XGEN(b.x)]) == gen, bar);
            __builtin_amdgcn_fence(__ATOMIC_ACQUIRE, "agent");
            asm volatile("s_waitcnt vmcnt(0)" ::: "memory");
        }
    }
    __syncthreads();
}

__global__ void __launch_bounds__(512, 2) fwd_kernel(Args a) {
    extern __shared__ __attribute__((aligned(16))) unsigned char lds_raw[];
    LAS unsigned char* lds = (LAS unsigned char*)lds_raw;
    const int tid = threadIdx.x, lane = tid & 63, wave = __builtin_amdgcn_readfirstlane(tid >> 6);
    const int lo = a.ph_lo, hi = a.ph_hi;
    unsigned char* ws = a.ws;
#define IN(k) (lo <= (k) && (k) < hi)
    volatile LAS unsigned* bst = (volatile LAS unsigned*)(lds + LDS_BYTES - 64);
    if (tid == 0) { bst[0] = 0u; bst[1] = 0u; }
    __syncthreads();
    (void)xcd_barrier_post((unsigned*)(ws + WS_CTL), bst);
    if (lo == 12345) cg::this_grid().sync();
#define SEAM(k) do { if (IN(k) && IN((k) + 1)) { XcdBarrier gb_; gb_.bar = (unsigned*)(ws + WS_CTL); gb_.x = xb_xcc_id(); gb_.st = (volatile LAS unsigned*)(lds + LDS_BYTES - 64); xcd_barrier(gb_); } } while (0)
    if (IN(0)) { p0_prologue(a, lds, wave, lane); }
    SEAM(0);
    if (IN(1)) {
        SchedA S; S.init(T, NIN, gridDim.x, blockIdx.x); S.XB = (const char*)(ws + WS_XB); S.W = (const char*)(ws + WS_WIN);
        EpiA E; E.ws = ws; E.GA = (bf16_t*)a.out;
        E.qn_a = a.in[4]; E.kn_a = a.in[5]; E.qn_b = a.in[7]; E.kn_b = a.in[8];
        pg8::gemm_phase<EpiA, SchedA>(lds, S, E);
    }
    SEAM(1);
    if (IN(2)) {
        AttnP P; P.QA = (const bf16_t*)(ws + WS_QA); P.KA = (const bf16_t*)(ws + WS_KA); P.VAT = (const bf16_t*)(ws + WS_VAT); P.ZA = (const bf16_t*)(ws + WS_ZA);
        P.QB = (const bf16_t*)(ws + WS_QB); P.KB = (const bf16_t*)(ws + WS_KB); P.VBT = (const bf16_t*)(ws + WS_VBT); P.ZB = (const bf16_t*)(ws + WS_ZB);
        P.Y = (bf16_t*)(ws + WS_Y); P.sink = a.in[9]; P.rpb = a.in[6];
        float shiftA, shiftB; bool fast;
        { float mqa = fabsf(a.in[4][lane]), mka = fabsf(a.in[5][lane]), mqb = fabsf(a.in[7][lane]), mkb = fabsf(a.in[8][lane]), msk = fabsf(a.in[9][lane & 7]), mr = 0.f;
          for (int i = tid; i < 8 * 465; i += 512) mr = fmaxf(mr, fabsf(a.in[6][i]));
#pragma unroll
          for (int o = 1; o < 64; o <<= 1) { mqa = fmaxf(mqa, __shfl_xor(mqa, o)); mka = fmaxf(mka, __shfl_xor(mka, o)); mqb = fmaxf(mqb, __shfl_xor(mqb, o)); mkb = fmaxf(mkb, __shfl_xor(mkb, o));
              msk = fmaxf(msk, __shfl_xor(msk, o)); mr = fmaxf(mr, __shfl_xor(mr, o)); }
          LAS float* red = (LAS float*)(lds + ATT_RPB);
          if (lane == 0) red[wave] = mr;
          __syncthreads();
          mr = red[0];
#pragma unroll
          for (int w = 1; w < 8; ++w) mr = fmaxf(mr, red[w]);
          __syncthreads();
          shiftA = 1.02f * (64.f * mqa * mka * QSCALE + mr * LOG2E) + 0.5f; shiftB = 1.02f * (64.f * mqb * mkb * QSCALE) + 0.5f;
          fast = (shiftA < 60.f) && (shiftB < 60.f) && (msk * LOG2E < 60.f); }
        AttStage<true> swa_st; AttQZ swa_qz;
        const bool pre = ((3072 + (int)gridDim.x - 1) / (int)gridDim.x) * (int)blockIdx.x < 3072;
        na_phase(P, lds, tid, wave, lane, fast, shiftA, swa_st, swa_qz);
        att_phase<true>(P, lds, tid, wave, lane, fast, shiftB, swa_st, swa_qz, pre);
    }
    SEAM(2);
    if (IN(3)) {
        SchedP S; S.init(T, 1024, gridDim.x, blockIdx.x); S.A = (const char*)(ws + WS_Y); S.W = (const char*)(ws + WS_WAB);
        EpiC1 E; E.GA = (const bf16_t*)a.out; E.GB = (const bf16_t*)a.out + (size_t)T * 1024; E.MG = (bf16_t*)(ws + WS_MG);
        pg8::gemm_phase<EpiC1, SchedP>(lds, S, E);
    }
    SEAM(3);
    if (IN(4)) {
        SchedP S; S.init(T, 1024, gridDim.x, blockIdx.x); S.A = (const char*)(ws + WS_MG); S.W = (const char*)(ws + WS_WO);
        EpiC2 E; E.xp = a.in[0]; E.xs = a.in[1]; E.out = a.out;
        pg8::gemm_phase<EpiC2, SchedP>(lds, S, E, true);
    }
#undef IN
#undef SEAM
}

extern "C" void kernel_launch(void* const* d_in, const int* in_sizes, int n_in, void* d_out, int out_size, void* d_ws, size_t ws_size, hipStream_t stream) {
    static int grid = 0;
    if (grid == 0) {
        if (n_in != 13 || out_size != T * D || ws_size < WS_END) { fprintf(stderr, "kernel_launch: unexpected shapes (n_in %d out %d ws %zu)\n", n_in, out_size, ws_size); grid = -1; return; }
        int dev = 0, cus = 0;
        if (hipGetDevice(&dev) != hipSuccess || hipDeviceGetAttribute(&cus, hipDeviceAttributeMultiprocessorCount, dev) != hipSuccess) { grid = -1; return; }
        if (hipFuncSetAttribute((const void*)fwd_kernel, hipFuncAttributeMaxDynamicSharedMemorySize, LDS_BYTES) != hipSuccess) { fprintf(stderr, "kernel_launch: hipFuncSetAttribute failed\n"); grid = -1; return; }
        int per_cu = 0;
        if (hipOccupancyMaxActiveBlocksPerMultiprocessor(&per_cu, (const void*)fwd_kernel, 512, LDS_BYTES) != hipSuccess || per_cu < 1) fprintf(stderr, "kernel_launch: occupancy query says %d\n", per_cu);
        (void)hipGetLastError();
        grid = cus;
    }
    if (grid < 0) return;
    hipMemsetAsync((char*)d_ws + WS_CTL, 0, CTL_BYTES, stream);
    Args a{};
    for (int i = 0; i < 13; ++i) a.in[i] = (const float*)d_in[i];
    a.out = (float*)d_out; a.ws = (unsigned char*)d_ws;
    if (N_LAUNCHES == 1) {
        a.ph_lo = 0; a.ph_hi = 5;
        void* args[] = {&a};
        hipError_t e = hipLaunchCooperativeKernel((const void*)fwd_kernel, dim3(grid), dim3(512), args, LDS_BYTES, stream);
        if (e != hipSuccess) fprintf(stderr, "cooperative launch failed: %s (grid %d)\n", hipGetErrorString(e), grid);
    } else {
        for (int p = 0; p < 5; ++p) {
            a.ph_lo = p; a.ph_hi = p + 1; hipLaunchKernelGGL(fwd_kernel, dim3(grid), dim3(512), LDS_BYTES, stream, a); }
    }
}
```

```cpp
#include <hip/hip_runtime.h>
#include <hip/hip_cooperative_groups.h>
#include <cstdio>
namespace cg = cooperative_groups;

#ifndef N_LAUNCHES
#define N_LAUNCHES 1
#endif

#define LAS __attribute__((address_space(3)))
typedef unsigned short bf16_t;
typedef short bf16x8 __attribute__((ext_vector_type(8)));
typedef short bf16x4 __attribute__((ext_vector_type(4)));
typedef float f32x4 __attribute__((ext_vector_type(4)));
typedef unsigned u32x4 __attribute__((ext_vector_type(4)));
typedef unsigned u32x2 __attribute__((ext_vector_type(2)));

constexpr int T = 49152, TP = 32768, D = 1024, NIN = 5376, SEQ = 4096;
constexpr float LOG2E = 1.4426950408889634f;
constexpr float QSCALE = 0.125f * LOG2E;
constexpr float NORM_EPS = 1e-6f;
constexpr size_t MiB = 1u << 20;
constexpr size_t WS_WIN = 0, WS_WAB = 11 * MiB, WS_WO = 13 * MiB, WS_ROPE = 15 * MiB, WS_XB = 17 * MiB, WS_QA = 113 * MiB, WS_KA = 161 * MiB, WS_QB = 209 * MiB,
                 WS_ZA = 257 * MiB, WS_ZB = 305 * MiB, WS_VAT = 353 * MiB, WS_KB = 401 * MiB, WS_VBT = 413 * MiB, WS_END = 425 * MiB;
constexpr size_t WS_CTL = 11 * MiB - 65536, CTL_BYTES = 16384;
constexpr size_t WS_Y = WS_XB;
constexpr size_t WS_MG = WS_QA;
constexpr int LDS_BYTES = 155648;

typedef __bf16 bf16x2_t __attribute__((ext_vector_type(2)));
typedef float f32x2_t __attribute__((ext_vector_type(2)));
__device__ __forceinline__ unsigned cvt_pk_bf16(float lo, float hi) { const f32x2_t v = {lo, hi}; const bf16x2_t r = __builtin_convertvector(v, bf16x2_t); return __builtin_bit_cast(unsigned, r); }
__device__ __forceinline__ float bf_lo(unsigned w) { return __uint_as_float(w << 16); }
__device__ __forceinline__ float bf_hi(unsigned w) { return __uint_as_float(w & 0xffff0000u); }
__device__ __forceinline__ float fast_sigmoid(float v) { return __builtin_amdgcn_rcpf(1.0f + __builtin_amdgcn_exp2f(-v * LOG2E)); }

namespace pg8 {
constexpr int BM = 256, BK = 64, HALF = 128, HTB = HALF * BK * 2, STAGE_BYTES = 8 * HTB, NXCD = 8, WGM = 4, K = 1024;
__device__ __forceinline__ int lds_byte(int r, int c) { const int st = (r >> 4) * 2 + (c >> 5), rr = r & 15, cc = c & 31, ob = rr * 64 + cc * 2; return st * 1024 + (ob ^ (((ob >> 9) & 1) << 5)); }
__device__ __forceinline__ void stage_rc(int b, int& R, int& C) { const int st = b / 1024, sb = b % 1024, swz = sb ^ (((sb >> 9) & 1) << 5); R = (st >> 1) * 16 + swz / 64; C = (st & 1) * 32 + (swz % 64) / 2; }
__device__ __forceinline__ int perm32(int rho) { const int n = rho >> 4, i = rho & 15; return 8 * (i >> 2) + 4 * n + (i & 3); }
struct Unit { int pm, pn; };
struct StaticOrder {
    int nM, nN, nwg, G, c;
    __device__ void init(int M, int N, int G_, int c_) { nM = M / BM; nN = N / BM; nwg = nM * nN; G = G_; c = c_; }
    __device__ bool next(int i, Unit& u) const {
        const long L = (long)i * G + c; if (L >= nwg) return false;
        int wgid = (int)L; { const int q = nwg / NXCD, r = nwg % NXCD, xcd = wgid % NXCD, off = wgid / NXCD; wgid = (xcd < r ? xcd * (q + 1) : r * (q + 1) + (xcd - r) * q) + off; }
        const int nig = WGM * nN, gid = wgid / nig, fm = gid * WGM, gsz = (nM - fm) < WGM ? (nM - fm) : WGM;
        u.pm = fm + ((wgid % nig) % gsz); u.pn = (wgid % nig) / gsz; return true;
    }
};
template <class Epi, class Sched>
__device__ __forceinline__ void gemm_phase(LAS unsigned char* lds, const Sched& S, const Epi& E, bool natural = false) {
    const int tid = threadIdx.x, wid = __builtin_amdgcn_readfirstlane(tid >> 6), lane = tid & 63, wr = wid >> 2, wc = wid & 3, fr = lane & 15, fq = lane >> 4;
    constexpr int nt = K / BK;
    unsigned voffA[2], voffB0[2], voffB1[2];
#pragma unroll
    for (int i = 0; i < 2; ++i) { int R, C; stage_rc(tid * 16 + i * 8192, R, C);
        const int Rb = 64 * (R >> 5) + (natural ? (R & 31) : perm32(R & 31));
        voffA[i] = (unsigned)(R * K + C) * 2u; voffB0[i] = (unsigned)(Rb * K + C) * 2u; voffB1[i] = (unsigned)((Rb + 32) * K + C) * 2u; }
    constexpr size_t kstep = (size_t)(BK * 2);
    constexpr size_t hstep = (size_t)HALF * K * 2;
    const unsigned ldsw = (unsigned)wid * 1024u;
    const int aoff = lds_byte(wr * 64 + fr, fq * 8), boff = lds_byte(wc * 32 + fr, fq * 8);
#define PG8_SA(b, h) (((b) * 2 + (h)) * HTB)
#define PG8_SB(b, h) ((4 + (b) * 2 + (h)) * HTB)
#define PG8_STAGE(bufoff, gbase, voff) do { _Pragma("unroll") for (int _i = 0; _i < 2; ++_i) \
        __builtin_amdgcn_global_load_lds((const unsigned*)((const char*)(gbase) + (voff)[_i]), (LAS unsigned*)(lds + (bufoff) + ldsw + _i * 8192), 16, 0, 0); } while (0)
#define PG8_LDA(dst, b, h) do { _Pragma("unroll") for (int m = 0; m < 4; ++m) _Pragma("unroll") for (int k = 0; k < 2; ++k) dst[m][k] = *(const LAS bf16x8*)(lds + PG8_SA(b, h) + aoff + m * 2048 + k * 1024); } while (0)
#define PG8_LDB(dst, b, h) do { _Pragma("unroll") for (int n = 0; n < 2; ++n) _Pragma("unroll") for (int k = 0; k < 2; ++k) dst[n][k] = *(const LAS bf16x8*)(lds + PG8_SB(b, h) + boff + n * 2048 + k * 1024); } while (0)
#define PG8_MMA(ai, bj, At, Bt) do { __builtin_amdgcn_s_setprio(1); _Pragma("unroll") for (int m = 0; m < 4; ++m) _Pragma("unroll") for (int n = 0; n < 2; ++n) _Pragma("unroll") for (int k = 0; k < 2; ++k) \
        acc[ai][bj][m][n] = __builtin_amdgcn_mfma_f32_16x16x32_bf16(Bt[n][k], At[m][k], acc[ai][bj][m][n], 0, 0, 0); __builtin_amdgcn_s_setprio(0); } while (0)
#define PG8_WAIT_V(n) asm volatile("s_waitcnt vmcnt(" #n ")" ::: "memory")
#define PG8_WAIT_L(n) asm volatile("s_waitcnt lgkmcnt(" #n ")" ::: "memory")
#define PG8_BAR __builtin_amdgcn_s_barrier()
#define PG8_SCHED __builtin_amdgcn_sched_barrier(0)
    Unit cur, nxt; int ui = 0;
    if (!S.next(0, cur)) return;
    f32x4 acc[2][2][4][2];
#pragma unroll
    for (int a = 0; a < 2; ++a)
#pragma unroll
        for (int b = 0; b < 2; ++b)
#pragma unroll
            for (int m = 0; m < 4; ++m)
#pragma unroll
                for (int n = 0; n < 2; ++n) acc[a][b][m][n] = (f32x4){0.f, 0.f, 0.f, 0.f};
    bf16x8 At[4][2], B0[2][2], B1[2][2];
    const char* cA; const char* cB; S.ptrs(cur, cA, cB);
    PG8_STAGE(PG8_SB(0, 0), cB, voffB0); PG8_STAGE(PG8_SB(0, 1), cB, voffB1); PG8_STAGE(PG8_SA(0, 0), cA, voffA); PG8_STAGE(PG8_SA(0, 1), cA + hstep, voffA);
    if (wr == 1) PG8_BAR;
    PG8_WAIT_V(2); PG8_BAR;
    PG8_STAGE(PG8_SB(1, 0), cB + kstep, voffB0); PG8_STAGE(PG8_SA(1, 0), cA + kstep, voffA); PG8_STAGE(PG8_SB(1, 1), cB + kstep, voffB1);
    PG8_WAIT_V(6); PG8_BAR;
    for (;;) {
        const bool has_next = S.next(ui + 1, nxt);
        const char* nA = cA; const char* nB = cB; if (has_next) S.ptrs(nxt, nA, nB);
        for (int t = 0; t < nt; t += 2) {
            const bool last = (t == nt - 2);
            const char* a1 = cA + (size_t)(t + 1) * kstep;
            const char* a2 = last ? nA : cA + (size_t)(t + 2) * kstep; const char* b2 = last ? nB : cB + (size_t)(t + 2) * kstep;
            const char* a3 = a2 + kstep; const char* b3 = b2 + kstep;
            if constexpr (Epi::MIDHOOK) { if (t == nt / 2) E.mid(acc, cur, wr, wc, fr, fq); }
            PG8_LDB(B0, 0, 0); PG8_LDB(B1, 0, 1); PG8_SCHED; PG8_LDA(At, 0, 0); PG8_STAGE(PG8_SA(1, 1), a1 + hstep, voffA);
            PG8_WAIT_V(8); PG8_WAIT_L(0); PG8_BAR; PG8_MMA(0, 0, At, B0); PG8_MMA(0, 1, At, B1); PG8_BAR; PG8_SCHED;
            PG8_LDA(At, 0, 1); PG8_STAGE(PG8_SB(0, 0), b2, voffB0); PG8_STAGE(PG8_SB(0, 1), b2, voffB1); PG8_STAGE(PG8_SA(0, 0), a2, voffA);
            PG8_WAIT_V(8); PG8_WAIT_L(0); PG8_BAR; PG8_MMA(1, 0, At, B0); PG8_MMA(1, 1, At, B1); PG8_BAR; PG8_SCHED;
            PG8_LDB(B0, 1, 0); PG8_LDB(B1, 1, 1); PG8_SCHED; PG8_LDA(At, 1, 0); PG8_STAGE(PG8_SA(0, 1), a2 + hstep, voffA);
            PG8_WAIT_V(8); PG8_WAIT_L(0); PG8_BAR; PG8_MMA(0, 0, At, B0); PG8_MMA(0, 1, At, B1); PG8_BAR; PG8_SCHED;
            PG8_LDA(At, 1, 1); PG8_STAGE(PG8_SB(1, 0), b3, voffB0); PG8_STAGE(PG8_SB(1, 1), b3, voffB1); PG8_STAGE(PG8_SA(1, 0), a3, voffA);
            PG8_WAIT_V(8); PG8_WAIT_L(0); PG8_BAR; PG8_MMA(1, 0, At, B0); PG8_MMA(1, 1, At, B1); PG8_BAR; PG8_SCHED;
        }
        if (wr == 0) PG8_BAR;
        E(acc, cur, wr, wc, fr, fq);
        if (!has_next) break;
#pragma unroll
        for (int a = 0; a < 2; ++a)
#pragma unroll
            for (int b = 0; b < 2; ++b)
#pragma unroll
                for (int m = 0; m < 4; ++m)
#pragma unroll
                    for (int n = 0; n < 2; ++n) acc[a][b][m][n] = (f32x4){0.f, 0.f, 0.f, 0.f};
        cur = nxt; cA = nA; cB = nB; ++ui;
        if (wr == 1) PG8_BAR;
    }
    PG8_WAIT_V(0);
    PG8_BAR;
#undef PG8_SA
#undef PG8_SB
#undef PG8_STAGE
#undef PG8_LDA
#undef PG8_LDB
#undef PG8_MMA
#undef PG8_WAIT_V
#undef PG8_WAIT_L
#undef PG8_BAR
#undef PG8_SCHED
}
}
using pg8::Unit;
typedef f32x4 AccT[2][2][4][2];

__device__ const float ROPE_IREV[32] = {1.591549367e-01f, 1.193493679e-01f, 8.949939907e-02f, 6.711508334e-02f, 5.032921210e-02f, 3.774158657e-02f, 2.830219641e-02f, 2.122365311e-02f,
    1.591549441e-02f, 1.193493698e-02f, 8.949940093e-03f, 6.711508147e-03f, 5.032920744e-03f, 3.774158657e-03f, 2.830219688e-03f, 2.122365171e-03f,
    1.591549371e-03f, 1.193493721e-03f, 8.949940093e-04f, 6.711508031e-04f, 5.032921326e-04f, 3.774158540e-04f, 2.830219746e-04f, 2.122365258e-04f,
    1.591549517e-04f, 1.193493663e-04f, 8.949940093e-05f, 6.711508468e-05f, 5.032921035e-05f, 3.774158540e-05f, 2.830219637e-05f, 2.122365368e-05f};
struct SchedA : pg8::StaticOrder {
    const char* XB; const char* W;
    __device__ __forceinline__ void ptrs(const Unit& u, const char*& cA, const char*& cB) const {
        const char* x = XB + (size_t)u.pm * (256 * 1024 * 2); const char* w = W + (size_t)u.pn * (256 * 1024 * 2);
        if (u.pn >= 19) { cA = w; cB = x; } else { cA = x; cB = w; }
    }
};
struct SchedP : pg8::StaticOrder {
    const char* A; const char* W;
    __device__ __forceinline__ void ptrs(const Unit& u, const char*& cA, const char*& cB) const { cA = A + (size_t)u.pm * (256 * 1024 * 2); cB = W + (size_t)u.pn * (256 * 1024 * 2); }
};

struct EpiA {
    static constexpr bool MIDHOOK = false;
    unsigned char* ws; bf16_t* GA;
    const float *qn_a, *kn_a, *qn_b, *kn_b;
    __device__ __forceinline__ void mid(AccT&, const Unit&, int, int, int, int) const {}
    __device__ __forceinline__ void qk(const AccT& acc, int row0, int wr, int fr, int fq, bf16_t* dst, int ld, int colh, const float* w, float scale, bool rope) const {
        f32x4 wv[2][2];
        int fq8 = 8 * fq; asm volatile("" : "+v"(fq8));
#pragma unroll
        for (int bj = 0; bj < 2; ++bj)
#pragma unroll
            for (int n = 0; n < 2; ++n) wv[bj][n] = *(const f32x4*)(w + 32 * bj + fq8 + 4 * n) * scale;
        f32x4 irev[2];
#pragma unroll
        for (int n = 0; n < 2; ++n) irev[n] = rope ? *(const f32x4*)(ROPE_IREV + fq8 + 4 * n) : (f32x4){0.f, 0.f, 0.f, 0.f};
#pragma unroll
        for (int ai = 0; ai < 2; ++ai)
#pragma unroll
            for (int m = 0; m < 4; ++m) {
                const int r = row0 + 128 * ai + 64 * wr + 16 * m + fr;
                f32x4 v[2][2]; float ss = 0.f;
#pragma unroll
                for (int bj = 0; bj < 2; ++bj)
#pragma unroll
                    for (int n = 0; n < 2; ++n) { v[bj][n] = acc[ai][bj][m][n]; const f32x4 x = v[bj][n]; ss += (x[0] * x[0] + x[1] * x[1]) + (x[2] * x[2] + x[3] * x[3]); }
                ss += __shfl_xor(ss, 16); ss += __shfl_xor(ss, 32);
                const float inv = __builtin_amdgcn_rsqf(ss * (1.0f / 64.0f) + NORM_EPS);
#pragma unroll
                for (int bj = 0; bj < 2; ++bj)
#pragma unroll
                    for (int n = 0; n < 2; ++n) v[bj][n] = v[bj][n] * inv * wv[bj][n];
                if (rope) {
                    const float fp = (float)(r & (SEQ - 1));
#pragma unroll
                    for (int n = 0; n < 2; ++n) {
                        f32x4 c, s;
#pragma unroll
                        for (int j = 0; j < 4; ++j) { const float fr_ = __builtin_amdgcn_fractf(fp * irev[n][j]); c[j] = __builtin_amdgcn_cosf(fr_); s[j] = __builtin_amdgcn_sinf(fr_); }
                        const f32x4 x1 = v[0][n], x2 = v[1][n];
                        v[0][n] = x1 * c - x2 * s; v[1][n] = x2 * c + x1 * s;
                    }
                }
                bf16_t* rowp = dst + (size_t)r * ld + colh + 8 * fq;
#pragma unroll
                for (int bj = 0; bj < 2; ++bj) { u32x4 o; o.x = cvt_pk_bf16(v[bj][0][0], v[bj][0][1]); o.y = cvt_pk_bf16(v[bj][0][2], v[bj][0][3]); o.z = cvt_pk_bf16(v[bj][1][0], v[bj][1][1]); o.w = cvt_pk_bf16(v[bj][1][2], v[bj][1][3]);
                    *(u32x4*)(rowp + 32 * bj) = o; }
            }
    }
    __device__ __forceinline__ void act(const AccT& acc, int row0, int wr, int wc, int fr, int fq, bf16_t* dst, int ld, int col0) const {
#pragma unroll
        for (int ai = 0; ai < 2; ++ai)
#pragma unroll
            for (int m = 0; m < 4; ++m) {
                const int r = row0 + 128 * ai + 64 * wr + 16 * m + fr;
                bf16_t* rowp = dst + (size_t)r * ld + col0 + 64 * wc + 8 * fq;
#pragma unroll
                for (int bj = 0; bj < 2; ++bj) { unsigned w[4];
#pragma unroll
                    for (int n = 0; n < 2; ++n)
#pragma unroll
                        for (int h = 0; h < 2; ++h) { const f32x2_t x = {acc[ai][bj][m][n][2 * h], acc[ai][bj][m][n][2 * h + 1]};
                            const f32x2_t t = x * (-LOG2E); f32x2_t e; e[0] = __builtin_amdgcn_exp2f(t[0]); e[1] = __builtin_amdgcn_exp2f(t[1]);
                            const f32x2_t d = e + 1.0f; f32x2_t sg; sg[0] = __builtin_amdgcn_rcpf(d[0]); sg[1] = __builtin_amdgcn_rcpf(d[1]);
                            const f32x2_t o = x * sg; w[2 * n + h] = cvt_pk_bf16(o[0], o[1]); }
                    u32x4 wv; wv.x = w[0]; wv.y = w[1]; wv.z = w[2]; wv.w = w[3];
                    *(u32x4*)(rowp + 32 * bj) = wv; }
            }
    }
    __device__ __forceinline__ void operator()(AccT& acc, const Unit& u, int wr, int wc, int fr, int fq) const {
        const int pn = u.pn, row0 = u.pm * 256;
        bf16_t* const QA = (bf16_t*)(ws + WS_QA); bf16_t* const KA = (bf16_t*)(ws + WS_KA); bf16_t* const QB = (bf16_t*)(ws + WS_QB); bf16_t* const KB = (bf16_t*)(ws + WS_KB);
        bf16_t* const VBT = (bf16_t*)(ws + WS_VBT); bf16_t* const ZA = (bf16_t*)(ws + WS_ZA); bf16_t* const ZB = (bf16_t*)(ws + WS_ZB); bf16_t* const VAT = (bf16_t*)(ws + WS_VAT);
        bf16_t* const GB = GA + (size_t)T * 1024;
        if (pn < 2) qk(acc, row0, wr, fr, fq, QA, 512, 256 * pn + 64 * wc, qn_a, QSCALE, false);
        else if (pn < 4) qk(acc, row0, wr, fr, fq, KA, 512, 256 * (pn - 2) + 64 * wc, kn_a, 1.0f, false);
        else if (pn < 6) qk(acc, row0, wr, fr, fq, QB, 512, 256 * (pn - 4) + 64 * wc, qn_b, QSCALE, true);
        else if (pn == 6) {
            if (wc < 2) qk(acc, row0, wr, fr, fq, KB, 128, 64 * wc, kn_b, 1.0f, true);
            else {
#pragma unroll
                for (int ai = 0; ai < 2; ++ai)
#pragma unroll
                    for (int m = 0; m < 4; ++m) {
                        const int r = row0 + 128 * ai + 64 * wr + 16 * m + fr;
                        bf16_t* base = VBT + ((size_t)(r >> 3) * 128 + 64 * (wc - 2) + 8 * fq) * 8 + (r & 7);
#pragma unroll
                        for (int bj = 0; bj < 2; ++bj)
#pragma unroll
                            for (int n = 0; n < 2; ++n) { const f32x4 x = acc[ai][bj][m][n];
                                const unsigned p0 = cvt_pk_bf16(x[0], x[1]), p1 = cvt_pk_bf16(x[2], x[3]);
                                bf16_t* q = base + (32 * bj + 4 * n) * 8;
                                q[0] = (bf16_t)(p0 & 0xffffu); q[8] = (bf16_t)(p0 >> 16); q[16] = (bf16_t)(p1 & 0xffffu); q[24] = (bf16_t)(p1 >> 16); }
                    }
            }
        }
        else if (pn < 9) act(acc, row0, wr, wc, fr, fq, ZA, 512, 256 * (pn - 7));
        else if (pn < 11) act(acc, row0, wr, wc, fr, fq, ZB, 512, 256 * (pn - 9));
        else if (pn < 19) {
#pragma unroll
            for (int ai = 0; ai < 2; ++ai)
#pragma unroll
                for (int m = 0; m < 4; ++m) {
                    const int r = row0 + 128 * ai + 64 * wr + 16 * m + fr;
                    unsigned Rw[4], Sw[4];
#pragma unroll
                    for (int n = 0; n < 2; ++n)
#pragma unroll
                        for (int h = 0; h < 2; ++h) { const f32x2_t a2 = {acc[ai][0][m][n][2 * h], acc[ai][0][m][n][2 * h + 1]}, b2 = {acc[ai][1][m][n][2 * h], acc[ai][1][m][n][2 * h + 1]};
                            const f32x2_t ta = a2 * (-LOG2E), tb = b2 * (-LOG2E); f32x2_t ea, eb;
                            ea[0] = __builtin_amdgcn_exp2f(ta[0]); ea[1] = __builtin_amdgcn_exp2f(ta[1]); eb[0] = __builtin_amdgcn_exp2f(tb[0]); eb[1] = __builtin_amdgcn_exp2f(tb[1]);
                            const f32x2_t ua = ea + 1.0f, ub = eb + 1.0f, pr = ua * ub; f32x2_t t; t[0] = __builtin_amdgcn_rcpf(pr[0]); t[1] = __builtin_amdgcn_rcpf(pr[1]);
                            const f32x2_t S2 = t * ua, R2 = t * ub * ub;
                            Sw[2 * n + h] = cvt_pk_bf16(S2[0], S2[1]); Rw[2 * n + h] = cvt_pk_bf16(R2[0], R2[1]); }
                    const size_t off = (size_t)r * 1024 + 128 * (pn - 11) + 32 * wc + 8 * fq;
                    u32x4 w; w.x = Rw[0]; w.y = Rw[1]; w.z = Rw[2]; w.w = Rw[3];
                    *(u32x4*)(GA + off) = w;
                    w.x = Sw[0]; w.y = Sw[1]; w.z = Sw[2]; w.w = Sw[3];
                    *(u32x4*)(GB + off) = w;
                }
        }
        else {
            const int c0 = 256 * (pn - 19);
#pragma unroll
            for (int ai = 0; ai < 2; ++ai)
#pragma unroll
                for (int m = 0; m < 4; ++m) {
                    const int c = c0 + 128 * ai + 64 * wr + 16 * m + fr;
#pragma unroll
                    for (int bj = 0; bj < 2; ++bj) {
                        const int t0 = row0 + 64 * wc + 32 * bj + 8 * fq;
                        const f32x4 x0 = acc[ai][bj][m][0], x1 = acc[ai][bj][m][1];
                        u32x4 o; o.x = cvt_pk_bf16(x0[0], x0[1]); o.y = cvt_pk_bf16(x0[2], x0[3]); o.z = cvt_pk_bf16(x1[0], x1[1]); o.w = cvt_pk_bf16(x1[2], x1[3]);
                        *(u32x4*)(VAT + ((size_t)(t0 >> 3) * 512 + c) * 8) = o; }
                }
        }
    }
};

struct EpiC1 {
    static constexpr bool MIDHOOK = true;
    const bf16_t *GA, *GB; bf16_t* MG;
    __device__ __forceinline__ void mid(AccT& acc, const Unit& u, int wr, int wc, int fr, int fq) const {
        unsigned base = (unsigned)((u.pm * 256 + 64 * wr + fr) * 1024 + u.pn * 256 + 64 * wc + 8 * fq) * 2u;
        asm volatile("" : "+v"(base));
#pragma unroll
        for (int ai = 0; ai < 2; ++ai)
#pragma unroll
            for (int m = 0; m < 4; ++m) {
#pragma unroll
                for (int bj = 0; bj < 2; ++bj) {
                    const unsigned off = base + (unsigned)((128 * ai + 16 * m) * 1024 + 32 * bj) * 2u;
                    const u32x4 a = *(const u32x4*)((const char*)GA + off);
                    f32x4 r0, r1;
                    r0[0] = bf_lo(a.x); r0[1] = bf_hi(a.x); r0[2] = bf_lo(a.y); r0[3] = bf_hi(a.y);
                    r1[0] = bf_lo(a.z); r1[1] = bf_hi(a.z); r1[2] = bf_lo(a.w); r1[3] = bf_hi(a.w);
                    acc[ai][bj][m][0] *= r0; acc[ai][bj][m][1] *= r1;
                }

            }
    }
    __device__ __forceinline__ void operator()(AccT& acc, const Unit& u, int wr, int wc, int fr, int fq) const {
        unsigned base = (unsigned)((u.pm * 256 + 64 * wr + fr) * 1024 + u.pn * 256 + 64 * wc + 8 * fq) * 2u;
        asm volatile("" : "+v"(base));
        u32x4 sv[2][4][2];
#pragma unroll
        for (int ai = 0; ai < 2; ++ai)
#pragma unroll
            for (int m = 0; m < 4; ++m)
#pragma unroll
                for (int bj = 0; bj < 2; ++bj) sv[ai][m][bj] = *(const u32x4*)((const char*)GB + base + (unsigned)((128 * ai + 16 * m) * 1024 + 32 * bj) * 2u);
#pragma unroll
        for (int ai = 0; ai < 2; ++ai)
#pragma unroll
            for (int m = 0; m < 4; ++m) {
#pragma unroll
                for (int bj = 0; bj < 2; ++bj) {
                    const unsigned off = base + (unsigned)((128 * ai + 16 * m) * 1024 + 32 * bj) * 2u;
                    const u32x4 b = sv[ai][m][bj];
                    const f32x4 x0 = acc[ai][bj][m][0], x1 = acc[ai][bj][m][1];
                    u32x4 o; o.x = cvt_pk_bf16(x0[0] * bf_lo(b.x), x0[1] * bf_hi(b.x)); o.y = cvt_pk_bf16(x0[2] * bf_lo(b.y), x0[3] * bf_hi(b.y));
                    o.z = cvt_pk_bf16(x1[0] * bf_lo(b.z), x1[1] * bf_hi(b.z)); o.w = cvt_pk_bf16(x1[2] * bf_lo(b.w), x1[3] * bf_hi(b.w));
                    *(u32x4*)((char*)MG + off) = o;
                }
            }
    }
};
struct EpiC2 {
    static constexpr bool MIDHOOK = false;
    const float *xp, *xs; float* out;
    __device__ __forceinline__ void mid(AccT&, const Unit&, int, int, int, int) const {}
    __device__ __forceinline__ void operator()(AccT& acc, const Unit& u, int wr, int wc, int fr, int fq) const {
        const int row0 = u.pm * 256;
        const char* xb = (const char*)(row0 < TP ? xp + (size_t)row0 * 1024 : xs + (size_t)(row0 - TP) * 1024);
        char* ob = (char*)(out + (size_t)row0 * 1024);
        unsigned base = (unsigned)((64 * wr + fr) * 1024 + u.pn * 256 + 64 * wc + 4 * fq) * 4u;
        asm volatile("" : "+v"(base));
#pragma unroll
        for (int ai = 0; ai < 2; ++ai) {
            f32x4 xv[4][2][2];
#pragma unroll
            for (int m = 0; m < 4; ++m)
#pragma unroll
                for (int bj = 0; bj < 2; ++bj)
#pragma unroll
                    for (int n = 0; n < 2; ++n) xv[m][bj][n] = *(const f32x4*)(xb + base + (unsigned)((128 * ai + 16 * m) * 1024 + 32 * bj + 16 * n) * 4u);
#pragma unroll
            for (int m = 0; m < 4; ++m)
#pragma unroll
                for (int bj = 0; bj < 2; ++bj)
#pragma unroll
                    for (int n = 0; n < 2; ++n) *(f32x4*)(ob + base + (unsigned)((128 * ai + 16 * m) * 1024 + 32 * bj + 16 * n) * 4u) = xv[m][bj][n] + acc[ai][bj][m][n];
            asm volatile("" ::: "memory");
        }
    }
};

__device__ __forceinline__ int map_col(int n) {
    if (n < 1024) return n;
    if (n < 1536) return 2048 + n - 1024;
    if (n < 1664) return 2560 + n - 1536;
    if (n < 1792) return 2688 + n - 1664;
    if (n < 2304) return 1536 + n - 1792;
    if (n < 2816) return 2816 + n - 2304;
    if (n < 4864) { const int w = n - 2816, tg = w >> 8, ww = w & 255, wcw = ww >> 6, bj = (ww >> 5) & 1, e = ww & 31;
        return (bj ? 4352 : 3328) + 128 * tg + 32 * wcw + e; }
    return 1024 + n - 4864;
}
__device__ __forceinline__ void p0_transpose_item(const float* W, int N, int ksrc0, int nsrc0, const float* ksc, bf16_t* WT, int nrow0, int kdst0, LAS float* scr, int lane) {
#pragma unroll 8
    for (int i = 0; i < 32; ++i) { const int kk = 2 * i + (lane >> 5); float v = W[(size_t)(ksrc0 + kk) * N + nsrc0 + (lane & 31)]; if (ksc) v *= ksc[ksrc0 + kk]; scr[kk * 33 + (lane & 31)] = v; }
    asm volatile("s_waitcnt lgkmcnt(0)" ::: "memory");
    const int c = lane & 7;
#pragma unroll
    for (int j = 0; j < 4; ++j) { const int n = (lane >> 3) + 8 * j; const LAS float* s = scr + (8 * c) * 33 + n;
        u32x4 o; o.x = cvt_pk_bf16(s[0 * 33], s[1 * 33]); o.y = cvt_pk_bf16(s[2 * 33], s[3 * 33]); o.z = cvt_pk_bf16(s[4 * 33], s[5 * 33]); o.w = cvt_pk_bf16(s[6 * 33], s[7 * 33]);
        *(u32x4*)(WT + (size_t)(nrow0 + n) * 1024 + kdst0 + 8 * c) = o; }
    asm volatile("s_waitcnt lgkmcnt(0)" ::: "memory");
}

struct Args { const float* in[13]; float* out; unsigned char* ws; int ph_lo, ph_hi; };

__device__ __forceinline__ void p0_load4(const Args& a, int m0, int NGW, int lane, f32x4 (&v)[4][4]) {
#pragma unroll
    for (int u = 0; u < 4; ++u) { const int m = min(m0 + u * NGW, T - 1);
        const float* xrow = m < TP ? a.in[0] + (size_t)m * 1024 : a.in[1] + (size_t)(m - TP) * 1024;
        const f32x4* xr = (const f32x4*)xrow + lane;
#pragma unroll
        for (int j = 0; j < 4; ++j) v[u][j] = xr[64 * j]; }
}
__device__ __forceinline__ void p0_proc4(bf16_t* XB, int m0, int NGW, int lane, const f32x4 (&v)[4][4]) {
    float s[4];
#pragma unroll
    for (int u = 0; u < 4; ++u) { float t = 0.f;
#pragma unroll
        for (int j = 0; j < 4; ++j) t += (v[u][j][0] * v[u][j][0] + v[u][j][1] * v[u][j][1]) + (v[u][j][2] * v[u][j][2] + v[u][j][3] * v[u][j][3]);
        s[u] = t; }
#pragma unroll
    for (int o = 1; o < 64; o <<= 1) {
#pragma unroll
        for (int u = 0; u < 4; ++u) s[u] += __shfl_xor(s[u], o); }
#pragma unroll
    for (int u = 0; u < 4; ++u) { const int m = m0 + u * NGW; if (m >= T) break;
        const float rstd = 1.0f / sqrtf(s[u] * (1.0f / 1024.0f) + NORM_EPS);
        u32x2* o8 = (u32x2*)(XB + (size_t)m * 1024) + lane;
#pragma unroll
        for (int j = 0; j < 4; ++j) { u32x2 w; w.x = cvt_pk_bf16(v[u][j][0] * rstd, v[u][j][1] * rstd); w.y = cvt_pk_bf16(v[u][j][2] * rstd, v[u][j][3] * rstd); o8[64 * j] = w; } }
}

__device__ __forceinline__ void p0_prologue(const Args& a, LAS unsigned char* lds, int wave, int lane) {
    if (wave < 4) {
        LAS float* scr = (LAS float*)(lds + wave * 16384);
        const int gw = blockIdx.x * 4 + wave, NGW = gridDim.x * 4;
        const float* w_in = a.in[3]; const float* w_oa = a.in[10]; const float* w_ob = a.in[11]; const float* w_o = a.in[12]; const float* ng = a.in[2];
        bf16_t* WIN = (bf16_t*)(a.ws + WS_WIN); bf16_t* WAB = (bf16_t*)(a.ws + WS_WAB); bf16_t* WO = (bf16_t*)(a.ws + WS_WO);
        constexpr int I_IN = 16 * 168, I_OA = 8 * 32, I_OB = 8 * 32, I_O = 16 * 32, NITEMS = I_IN + I_OA + I_OB + I_O;
        for (int it = gw; it < NITEMS; it += NGW) {
            int r = it;
            if (r < I_IN) { const int kb = r / 168, nb = r % 168; p0_transpose_item(w_in, NIN, 64 * kb, map_col(32 * nb), ng, WIN, 32 * nb, 64 * kb, scr, lane); continue; } r -= I_IN;
            if (r < I_OA) { const int kb = r / 32, nb = r % 32; p0_transpose_item(w_oa, 1024, 64 * kb, 32 * nb, nullptr, WAB, 32 * nb, 64 * kb, scr, lane); continue; } r -= I_OA;
            if (r < I_OB) { const int kb = r / 32, nb = r % 32; p0_transpose_item(w_ob, 1024, 64 * kb, 32 * nb, nullptr, WAB, 32 * nb, 512 + 64 * kb, scr, lane); continue; } r -= I_OB;
            { const int kb = r / 32, nb = r % 32; p0_transpose_item(w_o, 1024, 64 * kb, 32 * nb, nullptr, WO, 32 * nb, 64 * kb, scr, lane); }
        }
    } else {
        bf16_t* XB = (bf16_t*)(a.ws + WS_XB);
        const int gw = blockIdx.x * 4 + (wave - 4), NGW = gridDim.x * 4;
        f32x4 va[4][4], vb[4][4];
        int m0 = gw;
        if (m0 < T) p0_load4(a, m0, NGW, lane, va);
        while (m0 < T) {
            const int m1 = m0 + 4 * NGW; const bool has1 = m1 < T;
            if (has1) p0_load4(a, m1, NGW, lane, vb);
            p0_proc4(XB, m0, NGW, lane, va);
            if (!has1) break;
            const int m2 = m1 + 4 * NGW; const bool has2 = m2 < T;
            if (has2) p0_load4(a, m2, NGW, lane, va);
            p0_proc4(XB, m1, NGW, lane, vb);
            if (!has2) break;
            m0 = m2;
        }
    }
}

struct AttnP { const bf16_t *QA, *KA, *VAT, *ZA, *QB, *KB, *VBT, *ZB; bf16_t* Y; const float* sink; const float* rpb; };
constexpr int ATT_VOFF = 73728, ATT_RPB = 147456;
__device__ __forceinline__ int att_vpos(int d) { return (d & 32) | ((d & 4) << 2) | ((d & 24) >> 1) | (d & 3); }

template <bool SWA> struct AttStage { u32x4 k[SWA ? 6 : 9]; u32x4 v[SWA ? 6 : 9]; };

template <bool SWA>
__device__ __forceinline__ void att_decode(int item, int& b, int& h, int& x) {
    if (SWA) { x = item & 31; h = (item >> 5) & 1; b = item >> 6; }
    else { x = item & 31; h = (item >> 5) & 7; b = item >> 8; }
}
template <bool SWA>
__device__ __forceinline__ void att_load(const AttnP& P, int item, int tid, AttStage<SWA>& st) {
    constexpr int NCH = SWA ? 6 : 9, KLD = SWA ? 128 : 512;
    int b, h, x; att_decode<SWA>(item, b, h, x);
    const int tb = b * SEQ, kcol = h * 64;
    const bf16_t* Kp = SWA ? P.KB : P.KA; const bf16_t* VT = SWA ? P.VBT : P.VAT;
    const int base = SWA ? 128 * x - 128 : min(max(2 * x - 4, 0), 56);
#pragma unroll
    for (int i = 0; i < NCH; ++i) {
        const int idx = tid + 512 * i;
        { const int k = idx >> 3, c = idx & 7; int tok;
          if (SWA) tok = min(max(base + k, 0), SEQ - 1); else tok = min(base + (k >> 6), 63) * 64 + (k & 63);
          st.k[i] = *(const u32x4*)(Kp + (size_t)(tb + tok) * KLD + kcol + 8 * c); }
        { const int kb = idx >> 6, d = idx & 63; int tok;
          if (SWA) tok = min(max(base + 8 * kb, 0), SEQ - 8); else tok = min(base + (kb >> 3), 63) * 64 + 8 * (kb & 7);
          st.v[i] = *(const u32x4*)(VT + ((size_t)((tb + tok) >> 3) * KLD + kcol + d) * 8); }
    }
}
template <bool SWA>
__device__ __forceinline__ void att_store(LAS unsigned char* lds, int tid, const AttStage<SWA>& st) {
    constexpr int NCH = SWA ? 6 : 9;
#pragma unroll
    for (int i = 0; i < NCH; ++i) {
        const int idx = tid + 512 * i, k = idx >> 3, c = idx & 7;
        *(LAS u32x4*)(lds + k * 128 + ((c ^ ((k >> 1) & 7)) << 4)) = st.k[i];
        *(LAS u32x4*)(lds + ATT_VOFF + ((idx & ~63) + att_vpos(idx & 63)) * 16) = st.v[i];
    }
}

struct AttQZ { bf16x8 q0, q1; u32x4 z[2]; };
template <bool SWA>
__device__ __forceinline__ void att_load_qz(const AttnP& P, int lane, int tb, int qpos0, int hq, AttQZ& o) {
    const int li = lane & 15, fq = lane >> 4;
    const bf16_t* Q = SWA ? P.QB : P.QA; const bf16_t* Z = SWA ? P.ZB : P.ZA;
    const bf16_t* qrow = Q + (size_t)(tb + qpos0 + li) * 512 + hq * 64 + 8 * fq;
    o.q0 = *(const bf16x8*)qrow; o.q1 = *(const bf16x8*)(qrow + 32);
    const bf16_t* zrow = Z + (size_t)(tb + qpos0 + li) * 512 + hq * 64 + 8 * fq;
#pragma unroll
    for (int hh = 0; hh < 2; ++hh) o.z[hh] = *(const u32x4*)(zrow + 32 * hh);
}
template <bool SWA, bool FAST>
__device__ __forceinline__ void att_tile(const AttnP& P, LAS unsigned char* lds, int lane, int tb, int qpos0, int hq, int kloc0, int r, int ct, int kr0, int kc0, const AttQZ& qz, float shift) {
    constexpr int NSEG = SWA ? 9 : 8, KMAX = SWA ? 383 : 575;
    const int li = lane & 15, fq = lane >> 4;
    const bf16x8 bq0 = qz.q0, bq1 = qz.q1;
    f32x4 sc[NSEG][2];
    constexpr int GS = SWA ? 3 : 2;
    const int krow0 = (SWA ? kloc0 : kc0) + li, ksw = (krow0 >> 1) & 7;
    const LAS unsigned char* kb0 = lds + krow0 * 128 + ((fq ^ ksw) << 4);
    const LAS unsigned char* kb1 = lds + krow0 * 128 + (((fq + 4) ^ ksw) << 4);
#pragma unroll
    for (int s0 = 0; s0 < NSEG; s0 += GS) {
        bf16x8 kf[GS][2][2];
#pragma unroll
        for (int g = 0; g < GS; ++g)
#pragma unroll
            for (int kt = 0; kt < 2; ++kt) { const int s = s0 + g;
                const int segoff = SWA ? (32 * s + 16 * kt) * 128 : (((kr0 + s) % 9) * 64 + 16 * kt) * 128;
                kf[g][kt][0] = *(const LAS bf16x8*)(kb0 + segoff); kf[g][kt][1] = *(const LAS bf16x8*)(kb1 + segoff); }
        __builtin_amdgcn_sched_barrier(0);
        __builtin_amdgcn_s_setprio(1);
#pragma unroll
        for (int g = 0; g < GS; ++g)
#pragma unroll
            for (int kt = 0; kt < 2; ++kt) {
                f32x4 z = FAST ? (f32x4){-shift, -shift, -shift, -shift} : (f32x4){0.f, 0.f, 0.f, 0.f};
                z = __builtin_amdgcn_mfma_f32_16x16x32_bf16(kf[g][kt][0], bq0, z, 0, 0, 0);
                z = __builtin_amdgcn_mfma_f32_16x16x32_bf16(kf[g][kt][1], bq1, z, 0, 0, 0);
                sc[s0 + g][kt] = z; }
        __builtin_amdgcn_s_setprio(0);
        __builtin_amdgcn_sched_barrier(0);
    }
    float mx = -1e30f;
    if (SWA) {
        const int qp = qpos0 + li;
#pragma unroll
        for (int s = 0; s < NSEG; ++s) {
            const int kb0 = qpos0 - 128 + 32 * s;
            if (s >= 1 && s <= 7 && kb0 >= 0 && kb0 + 31 < SEQ) {
#pragma unroll
                for (int kt = 0; kt < 2; ++kt)
#pragma unroll
                    for (int j = 0; j < 4; ++j) { if (!FAST) mx = fmaxf(mx, sc[s][kt][j]); }
            } else {
                asm volatile("");
#pragma unroll
                for (int kt = 0; kt < 2; ++kt)
#pragma unroll
                    for (int j = 0; j < 4; ++j) { const int kp = kb0 + 16 * kt + 4 * fq + j; const int d = kp - qp;
                        const bool ok = (kp >= 0) && (kp < SEQ) && (d <= 128) && (d >= -128);
                        const float v = ok ? sc[s][kt][j] : -1e30f; sc[s][kt][j] = v; if (!FAST) mx = fmaxf(mx, v); }
            }
        }
    } else if (!FAST) {
        const int c = 16 * ct + li, cs = min(max(c - 8, 0), 48);
        const LAS float* rp = (const LAS float*)(lds + ATT_RPB) + (kr0 - r + 7) * 64 + (kc0 + 4 * fq - c + 31);
#pragma unroll
        for (int s = 0; s < NSEG; ++s) {
            float bias[2][4];
#pragma unroll
            for (int kt = 0; kt < 2; ++kt)
#pragma unroll
                for (int j = 0; j < 4; ++j) bias[kt][j] = rp[s * 64 + 16 * kt + j];
#pragma unroll
            for (int kt = 0; kt < 2; ++kt)
#pragma unroll
                for (int j = 0; j < 4; ++j) { const int kc = kc0 + 16 * kt + 4 * fq + j; const bool ok = (kc >= cs) && (kc < cs + 16);
                    float t = sc[s][kt][j] + bias[kt][j]; asm volatile("" : "+v"(t));
                    const float v = ok ? t : -1e30f; sc[s][kt][j] = v; if (!FAST) mx = fmaxf(mx, v); }
        }
    }
    if (!FAST) { mx = fmaxf(mx, __shfl_xor(mx, 16)); mx = fmaxf(mx, __shfl_xor(mx, 32)); }
    float sk = 0.f;
    if (SWA) { sk = P.sink[hq] * LOG2E; if (!FAST) mx = fmaxf(mx, sk); }
    float l = 0.f; f32x2_t l2 = {0.f, 0.f};
    bf16x8 pb[NSEG];
    if constexpr (!SWA && FAST) {
        const int c = 16 * ct + li, cs = min(max(c - 8, 0), 48), w = cs - kc0;
        const LAS float* rp = (const LAS float*)(lds + ATT_RPB) + (kr0 - r + 7) * 64 + (kc0 + 4 * fq - c + 31);
        bool hi[4]; const LAS float* rpj[4];
#pragma unroll
        for (int j = 0; j < 4; ++j) { hi[j] = (4 * fq + j) < w; rpj[j] = rp + (hi[j] ? 16 : 0) + j; }
        const unsigned m01 = (hi[0] ? 0u : 0xffffu) | (hi[1] ? 0u : 0xffff0000u), m23 = (hi[2] ? 0u : 0xffffu) | (hi[3] ? 0u : 0xffff0000u);
#pragma unroll
        for (int s = 0; s < NSEG; ++s) {
            float p[4];
#pragma unroll
            for (int j = 0; j < 4; ++j) { const float v = hi[j] ? sc[s][1][j] : sc[s][0][j]; p[j] = __builtin_amdgcn_exp2f(v + rpj[j][s * 64]); }
            l2 += (f32x2_t){p[0], p[1]}; l2 += (f32x2_t){p[2], p[3]};
            const unsigned pk01 = cvt_pk_bf16(p[0], p[1]), pk23 = cvt_pk_bf16(p[2], p[3]);
            u32x4 wv; wv.x = pk01 & m01; wv.y = pk23 & m23; wv.z = pk01 & ~m01; wv.w = pk23 & ~m23;
            pb[s] = __builtin_bit_cast(bf16x8, wv);
        }
    } else
#pragma unroll
    for (int s = 0; s < NSEG; ++s) {
        float p[8];
#pragma unroll
        for (int kt = 0; kt < 2; ++kt)
#pragma unroll
            for (int j = 0; j < 4; ++j) p[4 * kt + j] = __builtin_amdgcn_exp2f(FAST ? sc[s][kt][j] : sc[s][kt][j] - mx);
#pragma unroll
        for (int e = 0; e < 8; e += 2) l2 += (f32x2_t){p[e], p[e + 1]};
        u32x4 w; w.x = cvt_pk_bf16(p[0], p[1]); w.y = cvt_pk_bf16(p[2], p[3]); w.z = cvt_pk_bf16(p[4], p[5]); w.w = cvt_pk_bf16(p[6], p[7]);
        pb[s] = __builtin_bit_cast(bf16x8, w);
    }
    l += l2[0] + l2[1];
    l += __shfl_xor(l, 16); l += __shfl_xor(l, 32);
    if (SWA) l += __builtin_amdgcn_exp2f(FAST ? sk - shift : sk - mx);
    const float rl = 1.0f / l;
    f32x4 oacc[4];
#pragma unroll
    for (int dt = 0; dt < 4; ++dt) oacc[dt] = (f32x4){0.f, 0.f, 0.f, 0.f};
    constexpr int GV = SWA ? 3 : 2;
    const int g0l = (SWA ? kloc0 : kc0) + 4 * fq;
    const LAS unsigned char* vb0 = lds + ATT_VOFF + (g0l >> 3) * 1024 + li * 16 + (g0l & 7) * 2;
#pragma unroll
    for (int s0 = 0; s0 < NSEG; s0 += GV) {
        u32x2 vf[GV][4][2];
#pragma unroll
        for (int g = 0; g < GV; ++g) { const int s = s0 + g;
            const int segv = SWA ? s * 4096 : ((kr0 + s) % 9) * 8192;
#pragma unroll
            for (int dt = 0; dt < 4; ++dt) {
                vf[g][dt][0] = *(const LAS u32x2*)(vb0 + segv + dt * 256); asm volatile("" ::: "memory");
                vf[g][dt][1] = *(const LAS u32x2*)(vb0 + segv + dt * 256 + 2048); asm volatile("" ::: "memory"); } }
        __builtin_amdgcn_sched_barrier(0);
        __builtin_amdgcn_s_setprio(1);
#pragma unroll
        for (int g = 0; g < GV; ++g)
#pragma unroll
            for (int dt = 0; dt < 4; ++dt) {
                u32x4 w; w.x = vf[g][dt][0].x; w.y = vf[g][dt][0].y; w.z = vf[g][dt][1].x; w.w = vf[g][dt][1].y;
                oacc[dt] = __builtin_amdgcn_mfma_f32_16x16x32_bf16(__builtin_bit_cast(bf16x8, w), pb[s0 + g], oacc[dt], 0, 0, 0); }
        __builtin_amdgcn_s_setprio(0);
        __builtin_amdgcn_sched_barrier(0);
    }
    const size_t tq = (size_t)(tb + qpos0 + li);
#pragma unroll
    for (int hh = 0; hh < 2; ++hh) {
        const u32x4 z = qz.z[hh]; const f32x4 a = oacc[2 * hh], b = oacc[2 * hh + 1];
        u32x4 o; o.x = cvt_pk_bf16(a[0] * rl * bf_lo(z.x), a[1] * rl * bf_hi(z.x)); o.y = cvt_pk_bf16(a[2] * rl * bf_lo(z.y), a[3] * rl * bf_hi(z.y));
        o.z = cvt_pk_bf16(b[0] * rl * bf_lo(z.z), b[1] * rl * bf_hi(z.z)); o.w = cvt_pk_bf16(b[2] * rl * bf_lo(z.w), b[3] * rl * bf_hi(z.w));
        *(u32x4*)(P.Y + tq * 1024 + (SWA ? 512 : 0) + hq * 64 + 32 * hh + 8 * fq) = o;
    }
}

template <bool SWA>
__device__ __forceinline__ void att_phase(const AttnP& P, LAS unsigned char* lds, int tid, int wave, int lane, bool fast, float shift, AttStage<SWA>& st, AttQZ& qzn, bool pre) {
    constexpr int NITEMS = SWA ? 768 : 3072;
    int item = blockIdx.x;
#define ATT_QPOS(x) (SWA ? 128 * (x) + 16 * wave : (2 * (x) + (wave >> 2)) * 64 + 16 * (wave & 3))
    if (!pre && item < NITEMS) { int b, h, x; att_decode<SWA>(item, b, h, x); att_load<SWA>(P, item, tid, st); att_load_qz<SWA>(P, lane, b * SEQ, ATT_QPOS(x), SWA ? 4 * h : h, qzn); }
    for (; item < NITEMS; item += gridDim.x) {
        int b, h, x; att_decode<SWA>(item, b, h, x);
        att_store<SWA>(lds, tid, st);
        if (!SWA) { if (tid < 465) ((LAS float*)(lds + ATT_RPB))[tid] = P.rpb[h * 465 + tid] * LOG2E; }
        __syncthreads();
        const int nitem = item + (int)gridDim.x; const bool has_next = nitem < NITEMS;
        int nb = 0, nh = 0, nx = 0; if (has_next) { att_decode<SWA>(nitem, nb, nh, nx); att_load<SWA>(P, nitem, tid, st); }
        const int tb = b * SEQ;
        if (SWA) {
#pragma unroll 1
            for (int j = 0; j < 4; ++j) { int kl = 16 * wave; asm volatile("" : "+v"(kl));
                const AttQZ qz = qzn;
                if (j < 3) att_load_qz<true>(P, lane, tb, ATT_QPOS(x), 4 * h + j + 1, qzn);
                else if (has_next) att_load_qz<true>(P, lane, nb * SEQ, ATT_QPOS(nx), 4 * nh, qzn);
                if (fast) att_tile<true, true>(P, lds, lane, tb, 128 * x + 16 * wave, 4 * h + j, kl, 0, 0, 0, 0, qz, shift);
                else att_tile<true, false>(P, lds, lane, tb, 128 * x + 16 * wave, 4 * h + j, kl, 0, 0, 0, 0, qz, 0.f); }
        } else {
            const AttQZ qz = qzn;
            if (has_next) att_load_qz<false>(P, lane, nb * SEQ, ATT_QPOS(nx), nh, qzn);
            const int basee = min(max(2 * x - 4, 0), 56), r = 2 * x + (wave >> 2), ct = wave & 3, kr0 = min(max(r - 4, 0), 56);
            const int kc0 = ct == 0 ? 0 : (ct == 1 ? 8 : (ct == 2 ? 24 : 32));
            att_tile<false, false>(P, lds, lane, tb, r * 64 + 16 * ct, h, (kr0 - basee) * 64 + kc0, r, ct, kr0, kc0, qz, 0.f);
        }
        __syncthreads();
    }
#undef ATT_QPOS
}


struct NaStep { int b, h, rp, first, nrows; bool full; };
__device__ __forceinline__ NaStep na_step(int t, int spw, int c) {
    NaStep o; const int g = c * spw + t, bh = g >> 5; o.rp = g & 31; o.h = bh & 7; o.b = bh >> 3;
    const int base = min(max(2 * o.rp - 4, 0), 56);
    o.full = (t == 0) || (o.rp == 0);
    if (o.full) { o.first = base; o.nrows = 9; }
    else { const int pb = min(max(2 * o.rp - 6, 0), 56); o.first = pb + 9; o.nrows = base - pb; }
    return o;
}
__device__ __forceinline__ void na_load(const AttnP& P, const NaStep& st, int tid, AttStage<false>& r) {
    const int tb = st.b * SEQ, kcol = st.h * 64;
#pragma unroll
    for (int i = 0; i < 9; ++i) if (i < st.nrows) {
        const int row = min(st.first + i, 63);
        r.k[i] = *(const u32x4*)(P.KA + (size_t)(tb + row * 64 + (tid >> 3)) * 512 + kcol + 8 * (tid & 7));
        r.v[i] = *(const u32x4*)(P.VAT + ((size_t)((tb + row * 64) >> 3) + (tid >> 6)) * 4096 + (size_t)(kcol + (tid & 63)) * 8);
    }
}
__device__ __forceinline__ void na_store(LAS unsigned char* lds, const NaStep& st, int tid, const AttStage<false>& r) {
#pragma unroll
    for (int i = 0; i < 9; ++i) if (i < st.nrows) {
        const int slot = (st.first + i) % 9, k = slot * 64 + (tid >> 3), c = tid & 7;
        *(LAS u32x4*)(lds + k * 128 + ((c ^ ((k >> 1) & 7)) << 4)) = r.k[i];
        *(LAS u32x4*)(lds + ATT_VOFF + (slot * 8 + (tid >> 6)) * 1024 + att_vpos(tid & 63) * 16) = r.v[i];
    }
}
__device__ __forceinline__ void na_phase(const AttnP& P, LAS unsigned char* lds, int tid, int wave, int lane, bool fast, float shift, AttStage<true>& swa_st, AttQZ& swa_qz) {
    const int G = gridDim.x, c = blockIdx.x;
    const int spw = (3072 + G - 1) / G;
    const int nsteps = min(spw, max(3072 - c * spw, 0));
    AttStage<false> rg; AttQZ qzn;
    if (nsteps > 0) { const NaStep s0 = na_step(0, spw, c); na_load(P, s0, tid, rg); att_load_qz<false>(P, lane, s0.b * SEQ, (2 * s0.rp + (wave >> 2)) * 64 + 16 * (wave & 3), s0.h, qzn); }
#define NA_STEP(T, ...) do { \
        const NaStep st = na_step((T), spw, c); \
        na_store(lds, st, tid, rg); \
        if (st.full) {        \
            _Pragma("unroll") for (int i = 0; i < 2; ++i) { const int e = tid + 512 * i, row = e >> 6, dc = (e & 63) - 16; \
                if (e < 960) ((LAS float*)(lds + ATT_RPB))[e] = (dc >= 0 && dc <= 30) ? P.rpb[st.h * 465 + row * 31 + dc] * LOG2E : 0.f; } } \
        __syncthreads(); \
        const AttQZ qz = qzn; \
        __VA_ARGS__; \
        const int r = 2 * st.rp + (wave >> 2), ct = wave & 3, kr0 = min(max(r - 4, 0), 56); \
        const int kc0 = ct == 0 ? 0 : (ct == 1 ? 8 : (ct == 2 ? 24 : 32)); \
        if (fast) att_tile<false, true>(P, lds, lane, st.b * SEQ, r * 64 + 16 * ct, st.h, 0, r, ct, kr0, kc0, qz, shift); \
        else att_tile<false, false>(P, lds, lane, st.b * SEQ, r * 64 + 16 * ct, st.h, 0, r, ct, kr0, kc0, qz, 0.f); \
        __syncthreads(); } while (0)
    for (int t = 0; t + 1 < nsteps; ++t)
        NA_STEP(t, { const NaStep sn = na_step(t + 1, spw, c); na_load(P, sn, tid, rg); att_load_qz<false>(P, lane, sn.b * SEQ, (2 * sn.rp + (wave >> 2)) * 64 + 16 * (wave & 3), sn.h, qzn); });
    if (nsteps > 0)
        NA_STEP(nsteps - 1, { if (c < 768) { int sb, sh, sx; att_decode<true>(c, sb, sh, sx); att_load<true>(P, c, tid, swa_st); att_load_qz<true>(P, lane, sb * SEQ, 128 * sx + 16 * wave, 4 * sh, swa_qz); } });
#undef NA_STEP
}

#define XB_TMO      128
#define XB_XCNT(j)  (256  + 64 * (j))
#define XB_XSUB(j)  (1280 + 64 * (j))
#define XB_XGEN(j)  (2304 + 64 * (j))
#define XB_TOP      3328
#define XB_TOPGEN   3392
#define XCD_BAR_WORDS 3456
#define XB_SPIN_CAP (1u << 18)
__device__ __forceinline__ unsigned xb_ld(unsigned* p)              { return __hip_atomic_load(p, __ATOMIC_RELAXED, __HIP_MEMORY_SCOPE_AGENT); }
__device__ __forceinline__ unsigned xb_add(unsigned* p, unsigned v) { return __hip_atomic_fetch_add(p, v, __ATOMIC_RELAXED, __HIP_MEMORY_SCOPE_AGENT); }
__device__ __forceinline__ unsigned xb_xcc_id() { return (unsigned)__builtin_amdgcn_s_getreg((3 << 11) | 20) & 0xFu; }
#define XB_SPIN(cond, bar) do { unsigned _sp = 0; while (cond) { __builtin_amdgcn_s_sleep(1); \
    if ((++_sp & 255u) == 0u) { if (xb_ld(&(bar)[XB_TMO])) break; if (_sp > XB_SPIN_CAP) { atomicAdd(&(bar)[XB_TMO], 1u); break; } } } } while (0)
struct XcdBarrier { unsigned* bar; unsigned x; volatile LAS unsigned* st; };
__device__ __forceinline__ XcdBarrier xcd_barrier_post(unsigned* bar, volatile LAS unsigned* st) {
    XcdBarrier b; b.bar = bar; b.x = xb_xcc_id(); b.st = st;
    if (threadIdx.x == 0) (void)xb_add(&bar[XB_XCNT(b.x)], 1u);
    return b;
}
__device__ __forceinline__ void xcd_barrier_complete(unsigned* bar, unsigned x, unsigned& nloc, unsigned& nx) {
    const unsigned G = gridDim.x * gridDim.y * gridDim.z;
    unsigned sum, cnt, mine, sp = 0u;
    for (;;) {
        sum = 0u; cnt = 0u; mine = 0u;
#pragma unroll
        for (unsigned j = 0; j < 16; ++j) { const unsigned c = xb_ld(&bar[XB_XCNT(j)]); sum += c; cnt += (c > 0u) ? 1u : 0u; mine = (j == x) ? c : mine; }
        if (sum == G) break;
        __builtin_amdgcn_s_sleep(1);
        if ((++sp & 255u) == 0u) { if (xb_ld(&bar[XB_TMO])) break; if (sp > XB_SPIN_CAP) { atomicAdd(&bar[XB_TMO], 1u); break; } }
    }
    nloc = mine > 0u ? mine : 1u; nx = cnt > 0u ? cnt : 1u;
}
__device__ __forceinline__ void xcd_barrier(const XcdBarrier& b) {
    asm volatile("s_waitcnt vmcnt(0)" ::: "memory");
    __syncthreads();
    if (threadIdx.x == 0) {
        unsigned* bar = b.bar;
        __builtin_amdgcn_s_waitcnt(0);
        unsigned nloc = b.st[0], nx = b.st[1];
        if (nloc == 0u) { xcd_barrier_complete(bar, b.x, nloc, nx); b.st[0] = nloc; b.st[1] = nx; }
        const unsigned old = xb_add(&bar[XB_XSUB(b.x)], 1u);
        const unsigned gen = old / nloc;
        if (old + 1u == (gen + 1u) * nloc) {
            __builtin_amdgcn_fence(__ATOMIC_RELEASE, "agent");
            asm volatile("s_waitcnt vmcnt(0)" ::: "memory");
            const unsigned og = xb_add(&bar[XB_TOP], 1u);
            const unsigned tg = og / nx;
            if (og + 1u == (tg + 1u) * nx) xb_add(&bar[XB_TOPGEN], 1u);
            else XB_SPIN(xb_ld(&bar[XB_TOPGEN]) == tg, bar);
            __builtin_amdgcn_fence(__ATOMIC_ACQUIRE, "agent");
            xb_add(&bar[XB_XGEN(b.x)], 1u);
            asm volatile("s_waitcnt vmcnt(0)" ::: "memory");
        } else {
            XB_SPIN(xb_ld(&bar[XB_XGEN(b.x)]) == gen, bar);
            __builtin_amdgcn_fence(__ATOMIC_ACQUIRE, "agent");
            asm volatile("s_waitcnt vmcnt(0)" ::: "memory");
        }
    }
    __syncthreads();
}

__global__ void __launch_bounds__(512, 2) fwd_kernel(Args a) {
    extern __shared__ __attribute__((aligned(16))) unsigned char lds_raw[];
    LAS unsigned char* lds = (LAS unsigned char*)lds_raw;
    const int tid = threadIdx.x, lane = tid & 63, wave = __builtin_amdgcn_readfirstlane(tid >> 6);
    const int lo = a.ph_lo, hi = a.ph_hi;
    unsigned char* ws = a.ws;
#define IN(k) (lo <= (k) && (k) < hi)
    volatile LAS unsigned* bst = (volatile LAS unsigned*)(lds + LDS_BYTES - 64);
    if (tid == 0) { bst[0] = 0u; bst[1] = 0u; }
    __syncthreads();
    (void)xcd_barrier_post((unsigned*)(ws + WS_CTL), bst);
    if (lo == 12345) cg::this_grid().sync();
#define SEAM(k) do { if (IN(k) && IN((k) + 1)) { XcdBarrier gb_; gb_.bar = (unsigned*)(ws + WS_CTL); gb_.x = xb_xcc_id(); gb_.st = (volatile LAS unsigned*)(lds + LDS_BYTES - 64); xcd_barrier(gb_); } } while (0)
    if (IN(0)) { p0_prologue(a, lds, wave, lane); }
    SEAM(0);
    if (IN(1)) {
        SchedA S; S.init(T, NIN, gridDim.x, blockIdx.x); S.XB = (const char*)(ws + WS_XB); S.W = (const char*)(ws + WS_WIN);
        EpiA E; E.ws = ws; E.GA = (bf16_t*)a.out;
        E.qn_a = a.in[4]; E.kn_a = a.in[5]; E.qn_b = a.in[7]; E.kn_b = a.in[8];
        pg8::gemm_phase<EpiA, SchedA>(lds, S, E);
    }
    SEAM(1);
    if (IN(2)) {
        AttnP P; P.QA = (const bf16_t*)(ws + WS_QA); P.KA = (const bf16_t*)(ws + WS_KA); P.VAT = (const bf16_t*)(ws + WS_VAT); P.ZA = (const bf16_t*)(ws + WS_ZA);
        P.QB = (const bf16_t*)(ws + WS_QB); P.KB = (const bf16_t*)(ws + WS_KB); P.VBT = (const bf16_t*)(ws + WS_VBT); P.ZB = (const bf16_t*)(ws + WS_ZB);
        P.Y = (bf16_t*)(ws + WS_Y); P.sink = a.in[9]; P.rpb = a.in[6];
        float shiftA, shiftB; bool fast;
        { float mqa = fabsf(a.in[4][lane]), mka = fabsf(a.in[5][lane]), mqb = fabsf(a.in[7][lane]), mkb = fabsf(a.in[8][lane]), msk = fabsf(a.in[9][lane & 7]), mr = 0.f;
          for (int i = tid; i < 8 * 465; i += 512) mr = fmaxf(mr, fabsf(a.in[6][i]));
#pragma unroll
          for (int o = 1; o < 64; o <<= 1) { mqa = fmaxf(mqa, __shfl_xor(mqa, o)); mka = fmaxf(mka, __shfl_xor(mka, o)); mqb = fmaxf(mqb, __shfl_xor(mqb, o)); mkb = fmaxf(mkb, __shfl_xor(mkb, o));
              msk = fmaxf(msk, __shfl_xor(msk, o)); mr = fmaxf(mr, __shfl_xor(mr, o)); }
          LAS float* red = (LAS float*)(lds + ATT_RPB);
          if (lane == 0) red[wave] = mr;
          __syncthreads();
          mr = red[0];
#pragma unroll
          for (int w = 1; w < 8; ++w) mr = fmaxf(mr, red[w]);
          __syncthreads();
          shiftA = 1.02f * (64.f * mqa * mka * QSCALE + mr * LOG2E) + 0.5f; shiftB = 1.02f * (64.f * mqb * mkb * QSCALE) + 0.5f;
          fast = (shiftA < 60.f) && (shiftB < 60.f) && (msk * LOG2E < 60.f); }
        AttStage<true> swa_st; AttQZ swa_qz;
        const bool pre = ((3072 + (int)gridDim.x - 1) / (int)gridDim.x) * (int)blockIdx.x < 3072;
        na_phase(P, lds, tid, wave, lane, fast, shiftA, swa_st, swa_qz);
        att_phase<true>(P, lds, tid, wave, lane, fast, shiftB, swa_st, swa_qz, pre);
    }
    SEAM(2);
    if (IN(3)) {
        SchedP S; S.init(T, 1024, gridDim.x, blockIdx.x); S.A = (const char*)(ws + WS_Y); S.W = (const char*)(ws + WS_WAB);
        EpiC1 E; E.GA = (const bf16_t*)a.out; E.GB = (const bf16_t*)a.out + (size_t)T * 1024; E.MG = (bf16_t*)(ws + WS_MG);
        pg8::gemm_phase<EpiC1, SchedP>(lds, S, E);
    }
    SEAM(3);
    if (IN(4)) {
        SchedP S; S.init(T, 1024, gridDim.x, blockIdx.x); S.A = (const char*)(ws + WS_MG); S.W = (const char*)(ws + WS_WO);
        EpiC2 E; E.xp = a.in[0]; E.xs = a.in[1]; E.out = a.out;
        pg8::gemm_phase<EpiC2, SchedP>(lds, S, E, true);
    }
#undef IN
#undef SEAM
}

extern "C" void kernel_launch(void* const* d_in, const int* in_sizes, int n_in, void* d_out, int out_size, void* d_ws, size_t ws_size, hipStream_t stream) {
    static int grid = 0;
    if (grid == 0) {
        if (n_in != 13 || out_size != T * D || ws_size < WS_END) { fprintf(stderr, "kernel_launch: unexpected shapes (n_in %d out %d ws %zu)\n", n_in, out_size, ws_size); grid = -1; return; }
        int dev = 0, cus = 0;
        if (hipGetDevice(&dev) != hipSuccess || hipDeviceGetAttribute(&cus, hipDeviceAttributeMultiprocessorCount, dev) != hipSuccess) { grid = -1; return; }
        if (hipFuncSetAttribute((const void*)fwd_kernel, hipFuncAttributeMaxDynamicSharedMemorySize, LDS_BYTES) != hipSuccess) { fprintf(stderr, "kernel_launch: hipFuncSetAttribute failed\n"); grid = -1; return; }
        int per_cu = 0;
        if (hipOccupancyMaxActiveBlocksPerMultiprocessor(&per_cu, (const void*)fwd_kernel, 512, LDS_BYTES) != hipSuccess || per_cu < 1) fprintf(stderr, "kernel_launch: occupancy query says %d\n", per_cu);
        (void)hipGetLastError();
        grid = cus;
    }
    if (grid < 0) return;
    hipMemsetAsync((char*)d_ws + WS_CTL, 0, CTL_BYTES, stream);
    Args a{};
    for (int i = 0; i < 13; ++i) a.in[i] = (const float*)d_in[i];
    a.out = (float*)d_out; a.ws = (unsigned char*)d_ws;
    if (N_LAUNCHES == 1) {
        a.ph_lo = 0; a.ph_hi = 5;
        void* args[] = {&a};
        hipError_t e = hipLaunchCooperativeKernel((const void*)fwd_kernel, dim3(grid), dim3(512), args, LDS_BYTES, stream);
        if (e != hipSuccess) fprintf(stderr, "cooperative launch failed: %s (grid %d)\n", hipGetErrorString(e), grid);
    } else {
        for (int p = 0; p < 5; ++p) {
            a.ph_lo = p; a.ph_hi = p + 1; hipLaunchKernelGGL(fwd_kernel, dim3(grid), dim3(512), LDS_BYTES, stream, a); }
    }
}
```

```cpp
#include <hip/hip_runtime.h>
#include <hip/hip_cooperative_groups.h>
#include <cstdio>
namespace cg = cooperative_groups;

#ifndef N_LAUNCHES
#define N_LAUNCHES 1
#endif

#define LAS __attribute__((address_space(3)))
typedef unsigned short bf16_t;
typedef short bf16x8 __attribute__((ext_vector_type(8)));
typedef short bf16x4 __attribute__((ext_vector_type(4)));
typedef float f32x4 __attribute__((ext_vector_type(4)));
typedef unsigned u32x4 __attribute__((ext_vector_type(4)));
typedef unsigned u32x2 __attribute__((ext_vector_type(2)));

constexpr int T = 49152, TP = 32768, D = 1024, NIN = 5376, SEQ = 4096;
constexpr float LOG2E = 1.4426950408889634f;
constexpr float QSCALE = 0.125f * LOG2E;
constexpr float NORM_EPS = 1e-6f;
constexpr size_t MiB = 1u << 20;
constexpr size_t WS_WIN = 0, WS_WAB = 11 * MiB, WS_WO = 13 * MiB, WS_ROPE = 15 * MiB, WS_XB = 17 * MiB, WS_QA = 113 * MiB, WS_KA = 161 * MiB, WS_QB = 209 * MiB,
                 WS_ZA = 257 * MiB, WS_ZB = 305 * MiB, WS_VAT = 353 * MiB, WS_KB = 401 * MiB, WS_VBT = 413 * MiB, WS_END = 425 * MiB;
constexpr size_t WS_CTL = 11 * MiB - 65536, CTL_BYTES = 16384;
constexpr size_t WS_Y = WS_XB;
constexpr size_t WS_MG = WS_QA;
constexpr int LDS_BYTES = 155648;

typedef __bf16 bf16x2_t __attribute__((ext_vector_type(2)));
typedef float f32x2_t __attribute__((ext_vector_type(2)));
__device__ __forceinline__ unsigned cvt_pk_bf16(float lo, float hi) { const f32x2_t v = {lo, hi}; const bf16x2_t r = __builtin_convertvector(v, bf16x2_t); return __builtin_bit_cast(unsigned, r); }
__device__ __forceinline__ float bf_lo(unsigned w) { return __uint_as_float(w << 16); }
__device__ __forceinline__ float bf_hi(unsigned w) { return __uint_as_float(w & 0xffff0000u); }
__device__ __forceinline__ float fast_sigmoid(float v) { return __builtin_amdgcn_rcpf(1.0f + __builtin_amdgcn_exp2f(-v * LOG2E)); }

namespace pg8 {
constexpr int BM = 256, BK = 64, HALF = 128, HTB = HALF * BK * 2, STAGE_BYTES = 8 * HTB, NXCD = 8, WGM = 4, K = 1024;
__device__ __forceinline__ int lds_byte(int r, int c) { const int st = (r >> 4) * 2 + (c >> 5), rr = r & 15, cc = c & 31, ob = rr * 64 + cc * 2; return st * 1024 + (ob ^ (((ob >> 9) & 1) << 5)); }
__device__ __forceinline__ void stage_rc(int b, int& R, int& C) { const int st = b / 1024, sb = b % 1024, swz = sb ^ (((sb >> 9) & 1) << 5); R = (st >> 1) * 16 + swz / 64; C = (st & 1) * 32 + (swz % 64) / 2; }
__device__ __forceinline__ int perm32(int rho) { const int n = rho >> 4, i = rho & 15; return 8 * (i >> 2) + 4 * n + (i & 3); }
struct Unit { int pm, pn; };
struct StaticOrder {
    int nM, nN, nwg, G, c;
    __device__ void init(int M, int N, int G_, int c_) { nM = M / BM; nN = N / BM; nwg = nM * nN; G = G_; c = c_; }
    __device__ bool next(int i, Unit& u) const {
        const long L = (long)i * G + c; if (L >= nwg) return false;
        int wgid = (int)L; { const int q = nwg / NXCD, r = nwg % NXCD, xcd = wgid % NXCD, off = wgid / NXCD; wgid = (xcd < r ? xcd * (q + 1) : r * (q + 1) + (xcd - r) * q) + off; }
        const int nig = WGM * nN, gid = wgid / nig, fm = gid * WGM, gsz = (nM - fm) < WGM ? (nM - fm) : WGM;
        u.pm = fm + ((wgid % nig) % gsz); u.pn = (wgid % nig) / gsz; return true;
    }
};
template <class Epi, class Sched>
__device__ __forceinline__ void gemm_phase(LAS unsigned char* lds, const Sched& S, const Epi& E, bool natural = false) {
    const int tid = threadIdx.x, wid = __builtin_amdgcn_readfirstlane(tid >> 6), lane = tid & 63, wr = wid >> 2, wc = wid & 3, fr = lane & 15, fq = lane >> 4;
    constexpr int nt = K / BK;
    unsigned voffA[2], voffB0[2], voffB1[2];
#pragma unroll
    for (int i = 0; i < 2; ++i) { int R, C; stage_rc(tid * 16 + i * 8192, R, C);
        const int Rb = 64 * (R >> 5) + (natural ? (R & 31) : perm32(R & 31));
        voffA[i] = (unsigned)(R * K + C) * 2u; voffB0[i] = (unsigned)(Rb * K + C) * 2u; voffB1[i] = (unsigned)((Rb + 32) * K + C) * 2u; }
    constexpr size_t kstep = (size_t)(BK * 2);
    constexpr size_t hstep = (size_t)HALF * K * 2;
    const unsigned ldsw = (unsigned)wid * 1024u;
    const int aoff = lds_byte(wr * 64 + fr, fq * 8), boff = lds_byte(wc * 32 + fr, fq * 8);
#define PG8_SA(b, h) (((b) * 2 + (h)) * HTB)
#define PG8_SB(b, h) ((4 + (b) * 2 + (h)) * HTB)
#define PG8_STAGE(bufoff, gbase, voff) do { _Pragma("unroll") for (int _i = 0; _i < 2; ++_i) \
        __builtin_amdgcn_global_load_lds((const unsigned*)((const char*)(gbase) + (voff)[_i]), (LAS unsigned*)(lds + (bufoff) + ldsw + _i * 8192), 16, 0, 0); } while (0)
#define PG8_LDA(dst, b, h) do { _Pragma("unroll") for (int m = 0; m < 4; ++m) _Pragma("unroll") for (int k = 0; k < 2; ++k) dst[m][k] = *(const LAS bf16x8*)(lds + PG8_SA(b, h) + aoff + m * 2048 + k * 1024); } while (0)
#define PG8_LDB(dst, b, h) do { _Pragma("unroll") for (int n = 0; n < 2; ++n) _Pragma("unroll") for (int k = 0; k < 2; ++k) dst[n][k] = *(const LAS bf16x8*)(lds + PG8_SB(b, h) + boff + n * 2048 + k * 1024); } while (0)
#define PG8_MMA(ai, bj, At, Bt) do { __builtin_amdgcn_s_setprio(1); _Pragma("unroll") for (int m = 0; m < 4; ++m) _Pragma("unroll") for (int n = 0; n < 2; ++n) _Pragma("unroll") for (int k = 0; k < 2; ++k) \
        acc[ai][bj][m][n] = __builtin_amdgcn_mfma_f32_16x16x32_bf16(Bt[n][k], At[m][k], acc[ai][bj][m][n], 0, 0, 0); __builtin_amdgcn_s_setprio(0); } while (0)
#define PG8_WAIT_V(n) asm volatile("s_waitcnt vmcnt(" #n ")" ::: "memory")
#define PG8_WAIT_L(n) asm volatile("s_waitcnt lgkmcnt(" #n ")" ::: "memory")
#define PG8_BAR __builtin_amdgcn_s_barrier()
#define PG8_SCHED __builtin_amdgcn_sched_barrier(0)
    Unit cur, nxt; int ui = 0;
    if (!S.next(0, cur)) return;
    f32x4 acc[2][2][4][2];
#pragma unroll
    for (int a = 0; a < 2; ++a)
#pragma unroll
        for (int b = 0; b < 2; ++b)
#pragma unroll
            for (int m = 0; m < 4; ++m)
#pragma unroll
                for (int n = 0; n < 2; ++n) acc[a][b][m][n] = (f32x4){0.f, 0.f, 0.f, 0.f};
    bf16x8 At[4][2], B0[2][2], B1[2][2];
    const char* cA; const char* cB; S.ptrs(cur, cA, cB);
    PG8_STAGE(PG8_SB(0, 0), cB, voffB0); PG8_STAGE(PG8_SB(0, 1), cB, voffB1); PG8_STAGE(PG8_SA(0, 0), cA, voffA); PG8_STAGE(PG8_SA(0, 1), cA + hstep, voffA);
    if (wr == 1) PG8_BAR;
    PG8_WAIT_V(2); PG8_BAR;
    PG8_STAGE(PG8_SB(1, 0), cB + kstep, voffB0); PG8_STAGE(PG8_SA(1, 0), cA + kstep, voffA); PG8_STAGE(PG8_SB(1, 1), cB + kstep, voffB1);
    PG8_WAIT_V(6); PG8_BAR;
    for (;;) {
        const bool has_next = S.next(ui + 1, nxt);
        const char* nA = cA; const char* nB = cB; if (has_next) S.ptrs(nxt, nA, nB);
        for (int t = 0; t < nt; t += 2) {
            const bool last = (t == nt - 2);
            const char* a1 = cA + (size_t)(t + 1) * kstep;
            const char* a2 = last ? nA : cA + (size_t)(t + 2) * kstep; const char* b2 = last ? nB : cB + (size_t)(t + 2) * kstep;
            const char* a3 = a2 + kstep; const char* b3 = b2 + kstep;
            if constexpr (Epi::MIDHOOK) { if (t == nt / 2) E.mid(acc, cur, wr, wc, fr, fq); }
            PG8_LDB(B0, 0, 0); PG8_LDB(B1, 0, 1); PG8_SCHED; PG8_LDA(At, 0, 0); PG8_STAGE(PG8_SA(1, 1), a1 + hstep, voffA);
            PG8_WAIT_V(8); PG8_WAIT_L(0); PG8_BAR; PG8_MMA(0, 0, At, B0); PG8_MMA(0, 1, At, B1); PG8_BAR; PG8_SCHED;
            PG8_LDA(At, 0, 1); PG8_STAGE(PG8_SB(0, 0), b2, voffB0); PG8_STAGE(PG8_SB(0, 1), b2, voffB1); PG8_STAGE(PG8_SA(0, 0), a2, voffA);
            PG8_WAIT_V(8); PG8_WAIT_L(0); PG8_BAR; PG8_MMA(1, 0, At, B0); PG8_MMA(1, 1, At, B1); PG8_BAR; PG8_SCHED;
            PG8_LDB(B0, 1, 0); PG8_LDB(B1, 1, 1); PG8_SCHED; PG8_LDA(At, 1, 0); PG8_STAGE(PG8_SA(0, 1), a2 + hstep, voffA);
            PG8_WAIT_V(8); PG8_WAIT_L(0); PG8_BAR; PG8_MMA(0, 0, At, B0); PG8_MMA(0, 1, At, B1); PG8_BAR; PG8_SCHED;
            PG8_LDA(At, 1, 1); PG8_STAGE(PG8_SB(1, 0), b3, voffB0); PG8_STAGE(PG8_SB(1, 1), b3, voffB1); PG8_STAGE(PG8_SA(1, 0), a3, voffA);
            PG8_WAIT_V(8); PG8_WAIT_L(0); PG8_BAR; PG8_MMA(1, 0, At, B0); PG8_MMA(1, 1, At, B1); PG8_BAR; PG8_SCHED;
        }
        if (wr == 0) PG8_BAR;
        E(acc, cur, wr, wc, fr, fq);
        if (!has_next) break;
#pragma unroll
        for (int a = 0; a < 2; ++a)
#pragma unroll
            for (int b = 0; b < 2; ++b)
#pragma unroll
                for (int m = 0; m < 4; ++m)
#pragma unroll
                    for (int n = 0; n < 2; ++n) acc[a][b][m][n] = (f32x4){0.f, 0.f, 0.f, 0.f};
        cur = nxt; cA = nA; cB = nB; ++ui;
        if (wr == 1) PG8_BAR;
    }
    PG8_WAIT_V(0);
    PG8_BAR;
#undef PG8_SA
#undef PG8_SB
#undef PG8_STAGE
#undef PG8_LDA
#undef PG8_LDB
#undef PG8_MMA
#undef PG8_WAIT_V
#undef PG8_WAIT_L
#undef PG8_BAR
#undef PG8_SCHED
}
}
using pg8::Unit;
typedef f32x4 AccT[2][2][4][2];

__device__ const float ROPE_IREV[32] = {1.591549367e-01f, 1.193493679e-01f, 8.949939907e-02f, 6.711508334e-02f, 5.032921210e-02f, 3.774158657e-02f, 2.830219641e-02f, 2.122365311e-02f,
    1.591549441e-02f, 1.193493698e-02f, 8.949940093e-03f, 6.711508147e-03f, 5.032920744e-03f, 3.774158657e-03f, 2.830219688e-03f, 2.122365171e-03f,
    1.591549371e-03f, 1.193493721e-03f, 8.949940093e-04f, 6.711508031e-04f, 5.032921326e-04f, 3.774158540e-04f, 2.830219746e-04f, 2.122365258e-04f,
    1.591549517e-04f, 1.193493663e-04f, 8.949940093e-05f, 6.711508468e-05f, 5.032921035e-05f, 3.774158540e-05f, 2.830219637e-05f, 2.122365368e-05f};
struct SchedA : pg8::StaticOrder {
    const char* XB; const char* W;
    __device__ __forceinline__ void ptrs(const Unit& u, const char*& cA, const char*& cB) const {
        const char* x = XB + (size_t)u.pm * (256 * 1024 * 2); const char* w = W + (size_t)u.pn * (256 * 1024 * 2);
        if (u.pn >= 19) { cA = w; cB = x; } else { cA = x; cB = w; }
    }
};
struct SchedP : pg8::StaticOrder {
    const char* A; const char* W;
    __device__ __forceinline__ void ptrs(const Unit& u, const char*& cA, const char*& cB) const { cA = A + (size_t)u.pm * (256 * 1024 * 2); cB = W + (size_t)u.pn * (256 * 1024 * 2); }
};

struct EpiA {
    static constexpr bool MIDHOOK = false;
    unsigned char* ws; bf16_t* GA;
    const float *qn_a, *kn_a, *qn_b, *kn_b;
    __device__ __forceinline__ void mid(AccT&, const Unit&, int, int, int, int) const {}
    __device__ __forceinline__ void qk(const AccT& acc, int row0, int wr, int fr, int fq, bf16_t* dst, int ld, int colh, const float* w, float scale, bool rope) const {
        f32x4 wv[2][2];
        int fq8 = 8 * fq; asm volatile("" : "+v"(fq8));
#pragma unroll
        for (int bj = 0; bj < 2; ++bj)
#pragma unroll
            for (int n = 0; n < 2; ++n) wv[bj][n] = *(const f32x4*)(w + 32 * bj + fq8 + 4 * n) * scale;
        f32x4 irev[2];
#pragma unroll
        for (int n = 0; n < 2; ++n) irev[n] = rope ? *(const f32x4*)(ROPE_IREV + fq8 + 4 * n) : (f32x4){0.f, 0.f, 0.f, 0.f};
#pragma unroll
        for (int ai = 0; ai < 2; ++ai)
#pragma unroll
            for (int m = 0; m < 4; ++m) {
                const int r = row0 + 128 * ai + 64 * wr + 16 * m + fr;
                f32x4 v[2][2]; float ss = 0.f;
#pragma unroll
                for (int bj = 0; bj < 2; ++bj)
#pragma unroll
                    for (int n = 0; n < 2; ++n) { v[bj][n] = acc[ai][bj][m][n]; const f32x4 x = v[bj][n]; ss += (x[0] * x[0] + x[1] * x[1]) + (x[2] * x[2] + x[3] * x[3]); }
                ss += __shfl_xor(ss, 16); ss += __shfl_xor(ss, 32);
                const float inv = __builtin_amdgcn_rsqf(ss * (1.0f / 64.0f) + NORM_EPS);
#pragma unroll
                for (int bj = 0; bj < 2; ++bj)
#pragma unroll
                    for (int n = 0; n < 2; ++n) v[bj][n] = v[bj][n] * inv * wv[bj][n];
                if (rope) {
                    const float fp = (float)(r & (SEQ - 1));
#pragma unroll
                    for (int n = 0; n < 2; ++n) {
                        f32x4 c, s;
#pragma unroll
                        for (int j = 0; j < 4; ++j) { const float fr_ = __builtin_amdgcn_fractf(fp * irev[n][j]); c[j] = __builtin_amdgcn_cosf(fr_); s[j] = __builtin_amdgcn_sinf(fr_); }
                        const f32x4 x1 = v[0][n], x2 = v[1][n];
                        v[0][n] = x1 * c - x2 * s; v[1][n] = x2 * c + x1 * s;
                    }
                }
                bf16_t* rowp = dst + (size_t)r * ld + colh + 8 * fq;
#pragma unroll
                for (int bj = 0; bj < 2; ++bj) { u32x4 o; o.x = cvt_pk_bf16(v[bj][0][0], v[bj][0][1]); o.y = cvt_pk_bf16(v[bj][0][2], v[bj][0][3]); o.z = cvt_pk_bf16(v[bj][1][0], v[bj][1][1]); o.w = cvt_pk_bf16(v[bj][1][2], v[bj][1][3]);
                    *(u32x4*)(rowp + 32 * bj) = o; }
            }
    }
    __device__ __forceinline__ void act(const AccT& acc, int row0, int wr, int wc, int fr, int fq, bf16_t* dst, int ld, int col0) const {
#pragma unroll
        for (int ai = 0; ai < 2; ++ai)
#pragma unroll
            for (int m = 0; m < 4; ++m) {
                const int r = row0 + 128 * ai + 64 * wr + 16 * m + fr;
                bf16_t* rowp = dst + (size_t)r * ld + col0 + 64 * wc + 8 * fq;
#pragma unroll
                for (int bj = 0; bj < 2; ++bj) { unsigned w[4];
#pragma unroll
                    for (int n = 0; n < 2; ++n)
#pragma unroll
                        for (int h = 0; h < 2; ++h) { const f32x2_t x = {acc[ai][bj][m][n][2 * h], acc[ai][bj][m][n][2 * h + 1]};
                            const f32x2_t t = x * (-LOG2E); f32x2_t e; e[0] = __builtin_amdgcn_exp2f(t[0]); e[1] = __builtin_amdgcn_exp2f(t[1]);
                            const f32x2_t d = e + 1.0f; f32x2_t sg; sg[0] = __builtin_amdgcn_rcpf(d[0]); sg[1] = __builtin_amdgcn_rcpf(d[1]);
                            const f32x2_t o = x * sg; w[2 * n + h] = cvt_pk_bf16(o[0], o[1]); }
                    u32x4 wv; wv.x = w[0]; wv.y = w[1]; wv.z = w[2]; wv.w = w[3];
                    *(u32x4*)(rowp + 32 * bj) = wv; }
            }
    }
    __device__ __forceinline__ void operator()(AccT& acc, const Unit& u, int wr, int wc, int fr, int fq) const {
        const int pn = u.pn, row0 = u.pm * 256;
        bf16_t* const QA = (bf16_t*)(ws + WS_QA); bf16_t* const KA = (bf16_t*)(ws + WS_KA); bf16_t* const QB = (bf16_t*)(ws + WS_QB); bf16_t* const KB = (bf16_t*)(ws + WS_KB);
        bf16_t* const VBT = (bf16_t*)(ws + WS_VBT); bf16_t* const ZA = (bf16_t*)(ws + WS_ZA); bf16_t* const ZB = (bf16_t*)(ws + WS_ZB); bf16_t* const VAT = (bf16_t*)(ws + WS_VAT);
        bf16_t* const GB = GA + (size_t)T * 1024;
        if (pn < 2) qk(acc, row0, wr, fr, fq, QA, 512, 256 * pn + 64 * wc, qn_a, QSCALE, false);
        else if (pn < 4) qk(acc, row0, wr, fr, fq, KA, 512, 256 * (pn - 2) + 64 * wc, kn_a, 1.0f, false);
        else if (pn < 6) qk(acc, row0, wr, fr, fq, QB, 512, 256 * (pn - 4) + 64 * wc, qn_b, QSCALE, true);
        else if (pn == 6) {
            if (wc < 2) qk(acc, row0, wr, fr, fq, KB, 128, 64 * wc, kn_b, 1.0f, true);
            else {
#pragma unroll
                for (int ai = 0; ai < 2; ++ai)
#pragma unroll
                    for (int m = 0; m < 4; ++m) {
                        const int r = row0 + 128 * ai + 64 * wr + 16 * m + fr;
                        bf16_t* base = VBT + ((size_t)(r >> 3) * 128 + 64 * (wc - 2) + 8 * fq) * 8 + (r & 7);
#pragma unroll
                        for (int bj = 0; bj < 2; ++bj)
#pragma unroll
                            for (int n = 0; n < 2; ++n) { const f32x4 x = acc[ai][bj][m][n];
                                const unsigned p0 = cvt_pk_bf16(x[0], x[1]), p1 = cvt_pk_bf16(x[2], x[3]);
                                bf16_t* q = base + (32 * bj + 4 * n) * 8;
                                q[0] = (bf16_t)(p0 & 0xffffu); q[8] = (bf16_t)(p0 >> 16); q[16] = (bf16_t)(p1 & 0xffffu); q[24] = (bf16_t)(p1 >> 16); }
                    }
            }
        }
        else if (pn < 9) act(acc, row0, wr, wc, fr, fq, ZA, 512, 256 * (pn - 7));
        else if (pn < 11) act(acc, row0, wr, wc, fr, fq, ZB, 512, 256 * (pn - 9));
        else if (pn < 19) {
#pragma unroll
            for (int ai = 0; ai < 2; ++ai)
#pragma unroll
                for (int m = 0; m < 4; ++m) {
                    const int r = row0 + 128 * ai + 64 * wr + 16 * m + fr;
                    unsigned Rw[4], Sw[4];
#pragma unroll
                    for (int n = 0; n < 2; ++n)
#pragma unroll
                        for (int h = 0; h < 2; ++h) { const f32x2_t a2 = {acc[ai][0][m][n][2 * h], acc[ai][0][m][n][2 * h + 1]}, b2 = {acc[ai][1][m][n][2 * h], acc[ai][1][m][n][2 * h + 1]};
                            const f32x2_t ta = a2 * (-LOG2E), tb = b2 * (-LOG2E); f32x2_t ea, eb;
                            ea[0] = __builtin_amdgcn_exp2f(ta[0]); ea[1] = __builtin_amdgcn_exp2f(ta[1]); eb[0] = __builtin_amdgcn_exp2f(tb[0]); eb[1] = __builtin_amdgcn_exp2f(tb[1]);
                            const f32x2_t ua = ea + 1.0f, ub = eb + 1.0f, pr = ua * ub; f32x2_t t; t[0] = __builtin_amdgcn_rcpf(pr[0]); t[1] = __builtin_amdgcn_rcpf(pr[1]);
                            const f32x2_t S2 = t * ua, R2 = t * ub * ub;
                            Sw[2 * n + h] = cvt_pk_bf16(S2[0], S2[1]); Rw[2 * n + h] = cvt_pk_bf16(R2[0], R2[1]); }
                    const size_t off = (size_t)r * 1024 + 128 * (pn - 11) + 32 * wc + 8 * fq;
                    u32x4 w; w.x = Rw[0]; w.y = Rw[1]; w.z = Rw[2]; w.w = Rw[3];
                    *(u32x4*)(GA + off) = w;
                    w.x = Sw[0]; w.y = Sw[1]; w.z = Sw[2]; w.w = Sw[3];
                    *(u32x4*)(GB + off) = w;
                }
        }
        else {
            const int c0 = 256 * (pn - 19);
#pragma unroll
            for (int ai = 0; ai < 2; ++ai)
#pragma unroll
                for (int m = 0; m < 4; ++m) {
                    const int c = c0 + 128 * ai + 64 * wr + 16 * m + fr;
#pragma unroll
                    for (int bj = 0; bj < 2; ++bj) {
                        const int t0 = row0 + 64 * wc + 32 * bj + 8 * fq;
                        const f32x4 x0 = acc[ai][bj][m][0], x1 = acc[ai][bj][m][1];
                        u32x4 o; o.x = cvt_pk_bf16(x0[0], x0[1]); o.y = cvt_pk_bf16(x0[2], x0[3]); o.z = cvt_pk_bf16(x1[0], x1[1]); o.w = cvt_pk_bf16(x1[2], x1[3]);
                        *(u32x4*)(VAT + ((size_t)(t0 >> 3) * 512 + c) * 8) = o; }
                }
        }
    }
};

struct EpiC1 {
    static constexpr bool MIDHOOK = true;
    const bf16_t *GA, *GB; bf16_t* MG;
    __device__ __forceinline__ void mid(AccT& acc, const Unit& u, int wr, int wc, int fr, int fq) const {
        unsigned base = (unsigned)((u.pm * 256 + 64 * wr + fr) * 1024 + u.pn * 256 + 64 * wc + 8 * fq) * 2u;
        asm volatile("" : "+v"(base));
#pragma unroll
        for (int ai = 0; ai < 2; ++ai)
#pragma unroll
            for (int m = 0; m < 4; ++m) {
#pragma unroll
                for (int bj = 0; bj < 2; ++bj) {
                    const unsigned off = base + (unsigned)((128 * ai + 16 * m) * 1024 + 32 * bj) * 2u;
                    const u32x4 a = *(const u32x4*)((const char*)GA + off);
                    f32x4 r0, r1;
                    r0[0] = bf_lo(a.x); r0[1] = bf_hi(a.x); r0[2] = bf_lo(a.y); r0[3] = bf_hi(a.y);
                    r1[0] = bf_lo(a.z); r1[1] = bf_hi(a.z); r1[2] = bf_lo(a.w); r1[3] = bf_hi(a.w);
                    acc[ai][bj][m][0] *= r0; acc[ai][bj][m][1] *= r1;
                }

            }
    }
    __device__ __forceinline__ void operator()(AccT& acc, const Unit& u, int wr, int wc, int fr, int fq) const {
        unsigned base = (unsigned)((u.pm * 256 + 64 * wr + fr) * 1024 + u.pn * 256 + 64 * wc + 8 * fq) * 2u;
        asm volatile("" : "+v"(base));
        u32x4 sv[2][4][2];
#pragma unroll
        for (int ai = 0; ai < 2; ++ai)
#pragma unroll
            for (int m = 0; m < 4; ++m)
#pragma unroll
                for (int bj = 0; bj < 2; ++bj) sv[ai][m][bj] = *(const u32x4*)((const char*)GB + base + (unsigned)((128 * ai + 16 * m) * 1024 + 32 * bj) * 2u);
#pragma unroll
        for (int ai = 0; ai < 2; ++ai)
#pragma unroll
            for (int m = 0; m < 4; ++m) {
#pragma unroll
                for (int bj = 0; bj < 2; ++bj) {
                    const unsigned off = base + (unsigned)((128 * ai + 16 * m) * 1024 + 32 * bj) * 2u;
                    const u32x4 b = sv[ai][m][bj];
                    const f32x4 x0 = acc[ai][bj][m][0], x1 = acc[ai][bj][m][1];
                    u32x4 o; o.x = cvt_pk_bf16(x0[0] * bf_lo(b.x), x0[1] * bf_hi(b.x)); o.y = cvt_pk_bf16(x0[2] * bf_lo(b.y), x0[3] * bf_hi(b.y));
                    o.z = cvt_pk_bf16(x1[0] * bf_lo(b.z), x1[1] * bf_hi(b.z)); o.w = cvt_pk_bf16(x1[2] * bf_lo(b.w), x1[3] * bf_hi(b.w));
                    *(u32x4*)((char*)MG + off) = o;
                }
            }
    }
};
struct EpiC2 {
    static constexpr bool MIDHOOK = false;
    const float *xp, *xs; float* out;
    __device__ __forceinline__ void mid(AccT&, const Unit&, int, int, int, int) const {}
    __device__ __forceinline__ void operator()(AccT& acc, const Unit& u, int wr, int wc, int fr, int fq) const {
        const int row0 = u.pm * 256;
        const char* xb = (const char*)(row0 < TP ? xp + (size_t)row0 * 1024 : xs + (size_t)(row0 - TP) * 1024);
        char* ob = (char*)(out + (size_t)row0 * 1024);
        unsigned base = (unsigned)((64 * wr + fr) * 1024 + u.pn * 256 + 64 * wc + 4 * fq) * 4u;
        asm volatile("" : "+v"(base));
#pragma unroll
        for (int ai = 0; ai < 2; ++ai) {
            f32x4 xv[4][2][2];
#pragma unroll
            for (int m = 0; m < 4; ++m)
#pragma unroll
                for (int bj = 0; bj < 2; ++bj)
#pragma unroll
                    for (int n = 0; n < 2; ++n) xv[m][bj][n] = *(const f32x4*)(xb + base + (unsigned)((128 * ai + 16 * m) * 1024 + 32 * bj + 16 * n) * 4u);
#pragma unroll
            for (int m = 0; m < 4; ++m)
#pragma unroll
                for (int bj = 0; bj < 2; ++bj)
#pragma unroll
                    for (int n = 0; n < 2; ++n) *(f32x4*)(ob + base + (unsigned)((128 * ai + 16 * m) * 1024 + 32 * bj + 16 * n) * 4u) = xv[m][bj][n] + acc[ai][bj][m][n];
            asm volatile("" ::: "memory");
        }
    }
};

__device__ __forceinline__ int map_col(int n) {
    if (n < 1024) return n;
    if (n < 1536) return 2048 + n - 1024;
    if (n < 1664) return 2560 + n - 1536;
    if (n < 1792) return 2688 + n - 1664;
    if (n < 2304) return 1536 + n - 1792;
    if (n < 2816) return 2816 + n - 2304;
    if (n < 4864) { const int w = n - 2816, tg = w >> 8, ww = w & 255, wcw = ww >> 6, bj = (ww >> 5) & 1, e = ww & 31;
        return (bj ? 4352 : 3328) + 128 * tg + 32 * wcw + e; }
    return 1024 + n - 4864;
}
__device__ __forceinline__ void p0_transpose_item(const float* W, int N, int ksrc0, int nsrc0, const float* ksc, bf16_t* WT, int nrow0, int kdst0, LAS float* scr, int lane) {
#pragma unroll 8
    for (int i = 0; i < 32; ++i) { const int kk = 2 * i + (lane >> 5); float v = W[(size_t)(ksrc0 + kk) * N + nsrc0 + (lane & 31)]; if (ksc) v *= ksc[ksrc0 + kk]; scr[kk * 33 + (lane & 31)] = v; }
    asm volatile("s_waitcnt lgkmcnt(0)" ::: "memory");
    const int c = lane & 7;
#pragma unroll
    for (int j = 0; j < 4; ++j) { const int n = (lane >> 3) + 8 * j; const LAS float* s = scr + (8 * c) * 33 + n;
        u32x4 o; o.x = cvt_pk_bf16(s[0 * 33], s[1 * 33]); o.y = cvt_pk_bf16(s[2 * 33], s[3 * 33]); o.z = cvt_pk_bf16(s[4 * 33], s[5 * 33]); o.w = cvt_pk_bf16(s[6 * 33], s[7 * 33]);
        *(u32x4*)(WT + (size_t)(nrow0 + n) * 1024 + kdst0 + 8 * c) = o; }
    asm volatile("s_waitcnt lgkmcnt(0)" ::: "memory");
}

struct Args { const float* in[13]; float* out; unsigned char* ws; int ph_lo, ph_hi; };

__device__ __forceinline__ void p0_load4(const Args& a, int m0, int NGW, int lane, f32x4 (&v)[4][4]) {
#pragma unroll
    for (int u = 0; u < 4; ++u) { const int m = min(m0 + u * NGW, T - 1);
        const float* xrow = m < TP ? a.in[0] + (size_t)m * 1024 : a.in[1] + (size_t)(m - TP) * 1024;
        const f32x4* xr = (const f32x4*)xrow + lane;
#pragma unroll
        for (int j = 0; j < 4; ++j) v[u][j] = xr[64 * j]; }
}
__device__ __forceinline__ void p0_proc4(bf16_t* XB, int m0, int NGW, int lane, const f32x4 (&v)[4][4]) {
    float s[4];
#pragma unroll
    for (int u = 0; u < 4; ++u) { float t = 0.f;
#pragma unroll
        for (int j = 0; j < 4; ++j) t += (v[u][j][0] * v[u][j][0] + v[u][j][1] * v[u][j][1]) + (v[u][j][2] * v[u][j][2] + v[u][j][3] * v[u][j][3]);
        s[u] = t; }
#pragma unroll
    for (int o = 1; o < 64; o <<= 1) {
#pragma unroll
        for (int u = 0; u < 4; ++u) s[u] += __shfl_xor(s[u], o); }
#pragma unroll
    for (int u = 0; u < 4; ++u) { const int m = m0 + u * NGW; if (m >= T) break;
        const float rstd = 1.0f / sqrtf(s[u] * (1.0f / 1024.0f) + NORM_EPS);
        u32x2* o8 = (u32x2*)(XB + (size_t)m * 1024) + lane;
#pragma unroll
        for (int j = 0; j < 4; ++j) { u32x2 w; w.x = cvt_pk_bf16(v[u][j][0] * rstd, v[u][j][1] * rstd); w.y = cvt_pk_bf16(v[u][j][2] * rstd, v[u][j][3] * rstd); o8[64 * j] = w; } }
}

__device__ __forceinline__ void p0_prologue(const Args& a, LAS unsigned char* lds, int wave, int lane) {
    if (wave < 5) {
        LAS float* scr = (LAS float*)(lds + wave * 16384);
        const int gw = blockIdx.x * 5 + wave, NGW = gridDim.x * 5;
        const float* w_in = a.in[3]; const float* w_oa = a.in[10]; const float* w_ob = a.in[11]; const float* w_o = a.in[12]; const float* ng = a.in[2];
        bf16_t* WIN = (bf16_t*)(a.ws + WS_WIN); bf16_t* WAB = (bf16_t*)(a.ws + WS_WAB); bf16_t* WO = (bf16_t*)(a.ws + WS_WO);
        constexpr int I_IN = 16 * 168, I_OA = 8 * 32, I_OB = 8 * 32, I_O = 16 * 32, NITEMS = I_IN + I_OA + I_OB + I_O;
        for (int it = gw; it < NITEMS; it += NGW) {
            int r = it;
            if (r < I_IN) { const int kb = r / 168, nb = r % 168; p0_transpose_item(w_in, NIN, 64 * kb, map_col(32 * nb), ng, WIN, 32 * nb, 64 * kb, scr, lane); continue; } r -= I_IN;
            if (r < I_OA) { const int kb = r / 32, nb = r % 32; p0_transpose_item(w_oa, 1024, 64 * kb, 32 * nb, nullptr, WAB, 32 * nb, 64 * kb, scr, lane); continue; } r -= I_OA;
            if (r < I_OB) { const int kb = r / 32, nb = r % 32; p0_transpose_item(w_ob, 1024, 64 * kb, 32 * nb, nullptr, WAB, 32 * nb, 512 + 64 * kb, scr, lane); continue; } r -= I_OB;
            { const int kb = r / 32, nb = r % 32; p0_transpose_item(w_o, 1024, 64 * kb, 32 * nb, nullptr, WO, 32 * nb, 64 * kb, scr, lane); }
        }
    } else {
        bf16_t* XB = (bf16_t*)(a.ws + WS_XB);
        const int gw = blockIdx.x * 3 + (wave - 5), NGW = gridDim.x * 3;
        f32x4 va[4][4], vb[4][4];
        int m0 = gw;
        if (m0 < T) p0_load4(a, m0, NGW, lane, va);
        while (m0 < T) {
            const int m1 = m0 + 4 * NGW; const bool has1 = m1 < T;
            if (has1) p0_load4(a, m1, NGW, lane, vb);
            p0_proc4(XB, m0, NGW, lane, va);
            if (!has1) break;
            const int m2 = m1 + 4 * NGW; const bool has2 = m2 < T;
            if (has2) p0_load4(a, m2, NGW, lane, va);
            p0_proc4(XB, m1, NGW, lane, vb);
            if (!has2) break;
            m0 = m2;
        }
    }
}

struct AttnP { const bf16_t *QA, *KA, *VAT, *ZA, *QB, *KB, *VBT, *ZB; bf16_t* Y; const float* sink; const float* rpb; };
constexpr int ATT_VOFF = 73728, ATT_RPB = 147456;
__device__ __forceinline__ int att_vpos(int d) { return (d & 32) | ((d & 4) << 2) | ((d & 24) >> 1) | (d & 3); }

template <bool SWA> struct AttStage { u32x4 k[SWA ? 6 : 9]; u32x4 v[SWA ? 6 : 9]; };

template <bool SWA>
__device__ __forceinline__ void att_decode(int item, int& b, int& h, int& x) {
    if (SWA) { x = item & 31; h = (item >> 5) & 1; b = item >> 6; }
    else { x = item & 31; h = (item >> 5) & 7; b = item >> 8; }
}
template <bool SWA>
__device__ __forceinline__ void att_load(const AttnP& P, int item, int tid, AttStage<SWA>& st) {
    constexpr int NCH = SWA ? 6 : 9, KLD = SWA ? 128 : 512;
    int b, h, x; att_decode<SWA>(item, b, h, x);
    const int tb = b * SEQ, kcol = h * 64;
    const bf16_t* Kp = SWA ? P.KB : P.KA; const bf16_t* VT = SWA ? P.VBT : P.VAT;
    const int base = SWA ? 128 * x - 128 : min(max(2 * x - 4, 0), 56);
#pragma unroll
    for (int i = 0; i < NCH; ++i) {
        const int idx = tid + 512 * i;
        { const int k = idx >> 3, c = idx & 7; int tok;
          if (SWA) tok = min(max(base + k, 0), SEQ - 1); else tok = min(base + (k >> 6), 63) * 64 + (k & 63);
          st.k[i] = *(const u32x4*)(Kp + (size_t)(tb + tok) * KLD + kcol + 8 * c); }
        { const int kb = idx >> 6, d = idx & 63; int tok;
          if (SWA) tok = min(max(base + 8 * kb, 0), SEQ - 8); else tok = min(base + (kb >> 3), 63) * 64 + 8 * (kb & 7);
          st.v[i] = *(const u32x4*)(VT + ((size_t)((tb + tok) >> 3) * KLD + kcol + d) * 8); }
    }
}
template <bool SWA>
__device__ __forceinline__ void att_store(LAS unsigned char* lds, int tid, const AttStage<SWA>& st) {
    constexpr int NCH = SWA ? 6 : 9;
#pragma unroll
    for (int i = 0; i < NCH; ++i) {
        const int idx = tid + 512 * i, k = idx >> 3, c = idx & 7;
        *(LAS u32x4*)(lds + k * 128 + ((c ^ ((k >> 1) & 7)) << 4)) = st.k[i];
        *(LAS u32x4*)(lds + ATT_VOFF + ((idx & ~63) + att_vpos(idx & 63)) * 16) = st.v[i];
    }
}

struct AttQZ { bf16x8 q0, q1; u32x4 z[2]; };
template <bool SWA>
__device__ __forceinline__ void att_load_qz(const AttnP& P, int lane, int tb, int qpos0, int hq, AttQZ& o) {
    const int li = lane & 15, fq = lane >> 4;
    const bf16_t* Q = SWA ? P.QB : P.QA; const bf16_t* Z = SWA ? P.ZB : P.ZA;
    const bf16_t* qrow = Q + (size_t)(tb + qpos0 + li) * 512 + hq * 64 + 8 * fq;
    o.q0 = *(const bf16x8*)qrow; o.q1 = *(const bf16x8*)(qrow + 32);
    const bf16_t* zrow = Z + (size_t)(tb + qpos0 + li) * 512 + hq * 64 + 8 * fq;
#pragma unroll
    for (int hh = 0; hh < 2; ++hh) o.z[hh] = *(const u32x4*)(zrow + 32 * hh);
}
template <bool SWA, bool FAST>
__device__ __forceinline__ void att_tile(const AttnP& P, LAS unsigned char* lds, int lane, int tb, int qpos0, int hq, int kloc0, int r, int ct, int kr0, int kc0, const AttQZ& qz, float shift) {
    constexpr int NSEG = SWA ? 9 : 8, KMAX = SWA ? 383 : 575;
    const int li = lane & 15, fq = lane >> 4;
    const bf16x8 bq0 = qz.q0, bq1 = qz.q1;
    f32x4 sc[NSEG][2];
    constexpr int GS = SWA ? 3 : 2;
    const int krow0 = (SWA ? kloc0 : kc0) + li, ksw = (krow0 >> 1) & 7;
    const LAS unsigned char* kb0 = lds + krow0 * 128 + ((fq ^ ksw) << 4);
    const LAS unsigned char* kb1 = lds + krow0 * 128 + (((fq + 4) ^ ksw) << 4);
#pragma unroll
    for (int s0 = 0; s0 < NSEG; s0 += GS) {
        bf16x8 kf[GS][2][2];
#pragma unroll
        for (int g = 0; g < GS; ++g)
#pragma unroll
            for (int kt = 0; kt < 2; ++kt) { const int s = s0 + g;
                const int segoff = SWA ? (32 * s + 16 * kt) * 128 : (((kr0 + s) % 9) * 64 + 16 * kt) * 128;
                kf[g][kt][0] = *(const LAS bf16x8*)(kb0 + segoff); kf[g][kt][1] = *(const LAS bf16x8*)(kb1 + segoff); }
        __builtin_amdgcn_sched_barrier(0);
        __builtin_amdgcn_s_setprio(1);
#pragma unroll
        for (int g = 0; g < GS; ++g)
#pragma unroll
            for (int kt = 0; kt < 2; ++kt) {
                f32x4 z = FAST ? (f32x4){-shift, -shift, -shift, -shift} : (f32x4){0.f, 0.f, 0.f, 0.f};
                z = __builtin_amdgcn_mfma_f32_16x16x32_bf16(kf[g][kt][0], bq0, z, 0, 0, 0);
                z = __builtin_amdgcn_mfma_f32_16x16x32_bf16(kf[g][kt][1], bq1, z, 0, 0, 0);
                sc[s0 + g][kt] = z; }
        __builtin_amdgcn_s_setprio(0);
        __builtin_amdgcn_sched_barrier(0);
    }
    float mx = -1e30f;
    if (SWA) {
        const int qp = qpos0 + li;
#pragma unroll
        for (int s = 0; s < NSEG; ++s) {
            const int kb0 = qpos0 - 128 + 32 * s;
            if (s >= 1 && s <= 7 && kb0 >= 0 && kb0 + 31 < SEQ) {
#pragma unroll
                for (int kt = 0; kt < 2; ++kt)
#pragma unroll
                    for (int j = 0; j < 4; ++j) { if (!FAST) mx = fmaxf(mx, sc[s][kt][j]); }
            } else {
                asm volatile("");
#pragma unroll
                for (int kt = 0; kt < 2; ++kt)
#pragma unroll
                    for (int j = 0; j < 4; ++j) { const int kp = kb0 + 16 * kt + 4 * fq + j; const int d = kp - qp;
                        const bool ok = (kp >= 0) && (kp < SEQ) && (d <= 128) && (d >= -128);
                        const float v = ok ? sc[s][kt][j] : -1e30f; sc[s][kt][j] = v; if (!FAST) mx = fmaxf(mx, v); }
            }
        }
    } else if (!FAST) {
        const int c = 16 * ct + li, cs = min(max(c - 8, 0), 48);
        const LAS float* rp = (const LAS float*)(lds + ATT_RPB) + (kr0 - r + 7) * 64 + (kc0 + 4 * fq - c + 31);
#pragma unroll
        for (int s = 0; s < NSEG; ++s) {
            float bias[2][4];
#pragma unroll
            for (int kt = 0; kt < 2; ++kt)
#pragma unroll
                for (int j = 0; j < 4; ++j) bias[kt][j] = rp[s * 64 + 16 * kt + j];
#pragma unroll
            for (int kt = 0; kt < 2; ++kt)
#pragma unroll
                for (int j = 0; j < 4; ++j) { const int kc = kc0 + 16 * kt + 4 * fq + j; const bool ok = (kc >= cs) && (kc < cs + 16);
                    float t = sc[s][kt][j] + bias[kt][j]; asm volatile("" : "+v"(t));
                    const float v = ok ? t : -1e30f; sc[s][kt][j] = v; if (!FAST) mx = fmaxf(mx, v); }
        }
    }
    if (!FAST) { mx = fmaxf(mx, __shfl_xor(mx, 16)); mx = fmaxf(mx, __shfl_xor(mx, 32)); }
    float sk = 0.f;
    if (SWA) { sk = P.sink[hq] * LOG2E; if (!FAST) mx = fmaxf(mx, sk); }
    float l = 0.f; f32x2_t l2 = {0.f, 0.f};
    bf16x8 pb[NSEG];
    if constexpr (!SWA && FAST) {
        const int c = 16 * ct + li, cs = min(max(c - 8, 0), 48), w = cs - kc0;
        const LAS float* rp = (const LAS float*)(lds + ATT_RPB) + (kr0 - r + 7) * 64 + (kc0 + 4 * fq - c + 31);
        bool hi[4]; const LAS float* rpj[4];
#pragma unroll
        for (int j = 0; j < 4; ++j) { hi[j] = (4 * fq + j) < w; rpj[j] = rp + (hi[j] ? 16 : 0) + j; }
        const unsigned m01 = (hi[0] ? 0u : 0xffffu) | (hi[1] ? 0u : 0xffff0000u), m23 = (hi[2] ? 0u : 0xffffu) | (hi[3] ? 0u : 0xffff0000u);
#pragma unroll
        for (int s = 0; s < NSEG; ++s) {
            float p[4];
#pragma unroll
            for (int j = 0; j < 4; ++j) { const float v = hi[j] ? sc[s][1][j] : sc[s][0][j]; p[j] = __builtin_amdgcn_exp2f(v + rpj[j][s * 64]); }
            l2 += (f32x2_t){p[0], p[1]}; l2 += (f32x2_t){p[2], p[3]};
            const unsigned pk01 = cvt_pk_bf16(p[0], p[1]), pk23 = cvt_pk_bf16(p[2], p[3]);
            u32x4 wv; wv.x = pk01 & m01; wv.y = pk23 & m23; wv.z = pk01 & ~m01; wv.w = pk23 & ~m23;
            pb[s] = __builtin_bit_cast(bf16x8, wv);
        }
    } else
#pragma unroll
    for (int s = 0; s < NSEG; ++s) {
        float p[8];
#pragma unroll
        for (int kt = 0; kt < 2; ++kt)
#pragma unroll
            for (int j = 0; j < 4; ++j) p[4 * kt + j] = __builtin_amdgcn_exp2f(FAST ? sc[s][kt][j] : sc[s][kt][j] - mx);
#pragma unroll
        for (int e = 0; e < 8; e += 2) l2 += (f32x2_t){p[e], p[e + 1]};
        u32x4 w; w.x = cvt_pk_bf16(p[0], p[1]); w.y = cvt_pk_bf16(p[2], p[3]); w.z = cvt_pk_bf16(p[4], p[5]); w.w = cvt_pk_bf16(p[6], p[7]);
        pb[s] = __builtin_bit_cast(bf16x8, w);
    }
    l += l2[0] + l2[1];
    l += __shfl_xor(l, 16); l += __shfl_xor(l, 32);
    if (SWA) l += __builtin_amdgcn_exp2f(FAST ? sk - shift : sk - mx);
    const float rl = 1.0f / l;
    f32x4 oacc[4];
#pragma unroll
    for (int dt = 0; dt < 4; ++dt) oacc[dt] = (f32x4){0.f, 0.f, 0.f, 0.f};
    constexpr int GV = SWA ? 3 : 2;
    const int g0l = (SWA ? kloc0 : kc0) + 4 * fq;
    const LAS unsigned char* vb0 = lds + ATT_VOFF + (g0l >> 3) * 1024 + li * 16 + (g0l & 7) * 2;
#pragma unroll
    for (int s0 = 0; s0 < NSEG; s0 += GV) {
        u32x2 vf[GV][4][2];
#pragma unroll
        for (int g = 0; g < GV; ++g) { const int s = s0 + g;
            const int segv = SWA ? s * 4096 : ((kr0 + s) % 9) * 8192;
#pragma unroll
            for (int dt = 0; dt < 4; ++dt) {
                vf[g][dt][0] = *(const LAS u32x2*)(vb0 + segv + dt * 256); asm volatile("" ::: "memory");
                vf[g][dt][1] = *(const LAS u32x2*)(vb0 + segv + dt * 256 + 2048); asm volatile("" ::: "memory"); } }
        __builtin_amdgcn_sched_barrier(0);
        __builtin_amdgcn_s_setprio(1);
#pragma unroll
        for (int g = 0; g < GV; ++g)
#pragma unroll
            for (int dt = 0; dt < 4; ++dt) {
                u32x4 w; w.x = vf[g][dt][0].x; w.y = vf[g][dt][0].y; w.z = vf[g][dt][1].x; w.w = vf[g][dt][1].y;
                oacc[dt] = __builtin_amdgcn_mfma_f32_16x16x32_bf16(__builtin_bit_cast(bf16x8, w), pb[s0 + g], oacc[dt], 0, 0, 0); }
        __builtin_amdgcn_s_setprio(0);
        __builtin_amdgcn_sched_barrier(0);
    }
    const size_t tq = (size_t)(tb + qpos0 + li);
#pragma unroll
    for (int hh = 0; hh < 2; ++hh) {
        const u32x4 z = qz.z[hh]; const f32x4 a = oacc[2 * hh], b = oacc[2 * hh + 1];
        u32x4 o; o.x = cvt_pk_bf16(a[0] * rl * bf_lo(z.x), a[1] * rl * bf_hi(z.x)); o.y = cvt_pk_bf16(a[2] * rl * bf_lo(z.y), a[3] * rl * bf_hi(z.y));
        o.z = cvt_pk_bf16(b[0] * rl * bf_lo(z.z), b[1] * rl * bf_hi(z.z)); o.w = cvt_pk_bf16(b[2] * rl * bf_lo(z.w), b[3] * rl * bf_hi(z.w));
        *(u32x4*)(P.Y + tq * 1024 + (SWA ? 512 : 0) + hq * 64 + 32 * hh + 8 * fq) = o;
    }
}

template <bool SWA>
__device__ __forceinline__ void att_phase(const AttnP& P, LAS unsigned char* lds, int tid, int wave, int lane, bool fast, float shift, AttStage<SWA>& st, AttQZ& qzn, bool pre) {
    constexpr int NITEMS = SWA ? 768 : 3072;
    int item = blockIdx.x;
#define ATT_QPOS(x) (SWA ? 128 * (x) + 16 * wave : (2 * (x) + (wave >> 2)) * 64 + 16 * (wave & 3))
    if (!pre && item < NITEMS) { int b, h, x; att_decode<SWA>(item, b, h, x); att_load<SWA>(P, item, tid, st); att_load_qz<SWA>(P, lane, b * SEQ, ATT_QPOS(x), SWA ? 4 * h : h, qzn); }
    for (; item < NITEMS; item += gridDim.x) {
        int b, h, x; att_decode<SWA>(item, b, h, x);
        att_store<SWA>(lds, tid, st);
        if (!SWA) { if (tid < 465) ((LAS float*)(lds + ATT_RPB))[tid] = P.rpb[h * 465 + tid] * LOG2E; }
        __syncthreads();
        const int nitem = item + (int)gridDim.x; const bool has_next = nitem < NITEMS;
        int nb = 0, nh = 0, nx = 0; if (has_next) { att_decode<SWA>(nitem, nb, nh, nx); att_load<SWA>(P, nitem, tid, st); }
        const int tb = b * SEQ;
        if (SWA) {
#pragma unroll 1
            for (int j = 0; j < 4; ++j) { int kl = 16 * wave; asm volatile("" : "+v"(kl));
                const AttQZ qz = qzn;
                if (j < 3) att_load_qz<true>(P, lane, tb, ATT_QPOS(x), 4 * h + j + 1, qzn);
                else if (has_next) att_load_qz<true>(P, lane, nb * SEQ, ATT_QPOS(nx), 4 * nh, qzn);
                if (fast) att_tile<true, true>(P, lds, lane, tb, 128 * x + 16 * wave, 4 * h + j, kl, 0, 0, 0, 0, qz, shift);
                else att_tile<true, false>(P, lds, lane, tb, 128 * x + 16 * wave, 4 * h + j, kl, 0, 0, 0, 0, qz, 0.f); }
        } else {
            const AttQZ qz = qzn;
            if (has_next) att_load_qz<false>(P, lane, nb * SEQ, ATT_QPOS(nx), nh, qzn);
            const int basee = min(max(2 * x - 4, 0), 56), r = 2 * x + (wave >> 2), ct = wave & 3, kr0 = min(max(r - 4, 0), 56);
            const int kc0 = ct == 0 ? 0 : (ct == 1 ? 8 : (ct == 2 ? 24 : 32));
            att_tile<false, false>(P, lds, lane, tb, r * 64 + 16 * ct, h, (kr0 - basee) * 64 + kc0, r, ct, kr0, kc0, qz, 0.f);
        }
        __syncthreads();
    }
#undef ATT_QPOS
}


struct NaStep { int b, h, rp, first, nrows; bool full; };
__device__ __forceinline__ NaStep na_step(int t, int spw, int c) {
    NaStep o; const int g = c * spw + t, bh = g >> 5; o.rp = g & 31; o.h = bh & 7; o.b = bh >> 3;
    const int base = min(max(2 * o.rp - 4, 0), 56);
    o.full = (t == 0) || (o.rp == 0);
    if (o.full) { o.first = base; o.nrows = 9; }
    else { const int pb = min(max(2 * o.rp - 6, 0), 56); o.first = pb + 9; o.nrows = base - pb; }
    return o;
}
__device__ __forceinline__ void na_load(const AttnP& P, const NaStep& st, int tid, AttStage<false>& r) {
    const int tb = st.b * SEQ, kcol = st.h * 64;
#pragma unroll
    for (int i = 0; i < 9; ++i) if (i < st.nrows) {
        const int row = min(st.first + i, 63);
        r.k[i] = *(const u32x4*)(P.KA + (size_t)(tb + row * 64 + (tid >> 3)) * 512 + kcol + 8 * (tid & 7));
        r.v[i] = *(const u32x4*)(P.VAT + ((size_t)((tb + row * 64) >> 3) + (tid >> 6)) * 4096 + (size_t)(kcol + (tid & 63)) * 8);
    }
}
__device__ __forceinline__ void na_store(LAS unsigned char* lds, const NaStep& st, int tid, const AttStage<false>& r) {
#pragma unroll
    for (int i = 0; i < 9; ++i) if (i < st.nrows) {
        const int slot = (st.first + i) % 9, k = slot * 64 + (tid >> 3), c = tid & 7;
        *(LAS u32x4*)(lds + k * 128 + ((c ^ ((k >> 1) & 7)) << 4)) = r.k[i];
        *(LAS u32x4*)(lds + ATT_VOFF + (slot * 8 + (tid >> 6)) * 1024 + att_vpos(tid & 63) * 16) = r.v[i];
    }
}
__device__ __forceinline__ void na_phase(const AttnP& P, LAS unsigned char* lds, int tid, int wave, int lane, bool fast, float shift, AttStage<true>& swa_st, AttQZ& swa_qz) {
    const int G = gridDim.x, c = blockIdx.x;
    const int spw = (3072 + G - 1) / G;
    const int nsteps = min(spw, max(3072 - c * spw, 0));
    AttStage<false> rg; AttQZ qzn;
    if (nsteps > 0) { const NaStep s0 = na_step(0, spw, c); na_load(P, s0, tid, rg); att_load_qz<false>(P, lane, s0.b * SEQ, (2 * s0.rp + (wave >> 2)) * 64 + 16 * (wave & 3), s0.h, qzn); }
#define NA_STEP(T, ...) do { \
        const NaStep st = na_step((T), spw, c); \
        na_store(lds, st, tid, rg); \
        if (st.full) {        \
            _Pragma("unroll") for (int i = 0; i < 2; ++i) { const int e = tid + 512 * i, row = e >> 6, dc = (e & 63) - 16; \
                if (e < 960) ((LAS float*)(lds + ATT_RPB))[e] = (dc >= 0 && dc <= 30) ? P.rpb[st.h * 465 + row * 31 + dc] * LOG2E : 0.f; } } \
        __syncthreads(); \
        const AttQZ qz = qzn; \
        __VA_ARGS__; \
        const int r = 2 * st.rp + (wave >> 2), ct = wave & 3, kr0 = min(max(r - 4, 0), 56); \
        const int kc0 = ct == 0 ? 0 : (ct == 1 ? 8 : (ct == 2 ? 24 : 32)); \
        if (fast) att_tile<false, true>(P, lds, lane, st.b * SEQ, r * 64 + 16 * ct, st.h, 0, r, ct, kr0, kc0, qz, shift); \
        else att_tile<false, false>(P, lds, lane, st.b * SEQ, r * 64 + 16 * ct, st.h, 0, r, ct, kr0, kc0, qz, 0.f); \
        __syncthreads(); } while (0)
    for (int t = 0; t + 1 < nsteps; ++t)
        NA_STEP(t, { const NaStep sn = na_step(t + 1, spw, c); na_load(P, sn, tid, rg); att_load_qz<false>(P, lane, sn.b * SEQ, (2 * sn.rp + (wave >> 2)) * 64 + 16 * (wave & 3), sn.h, qzn); });
    if (nsteps > 0)
        NA_STEP(nsteps - 1, { if (c < 768) { int sb, sh, sx; att_decode<true>(c, sb, sh, sx); att_load<true>(P, c, tid, swa_st); att_load_qz<true>(P, lane, sb * SEQ, 128 * sx + 16 * wave, 4 * sh, swa_qz); } });
#undef NA_STEP
}

#define XB_TMO      128
#define XB_XCNT(j)  (256  + 64 * (j))
#define XB_XSUB(j)  (1280 + 64 * (j))
#define XB_XGEN(j)  (2304 + 64 * (j))
#define XB_TOP      3328
#define XB_TOPGEN   3392
#define XCD_BAR_WORDS 3456
#define XB_SPIN_CAP (1u << 18)
__device__ __forceinline__ unsigned xb_ld(unsigned* p)              { return __hip_atomic_load(p, __ATOMIC_RELAXED, __HIP_MEMORY_SCOPE_AGENT); }
__device__ __forceinline__ unsigned xb_add(unsigned* p, unsigned v) { return __hip_atomic_fetch_add(p, v, __ATOMIC_RELAXED, __HIP_MEMORY_SCOPE_AGENT); }
__device__ __forceinline__ unsigned xb_xcc_id() { return (unsigned)__builtin_amdgcn_s_getreg((3 << 11) | 20) & 0xFu; }
#define XB_SPIN(cond, bar) do { unsigned _sp = 0; while (cond) { __builtin_amdgcn_s_sleep(1); \
    if ((++_sp & 255u) == 0u) { if (xb_ld(&(bar)[XB_TMO])) break; if (_sp > XB_SPIN_CAP) { atomicAdd(&(bar)[XB_TMO], 1u); break; } } } } while (0)
struct XcdBarrier { unsigned* bar; unsigned x; volatile LAS unsigned* st; };
__device__ __forceinline__ XcdBarrier xcd_barrier_post(unsigned* bar, volatile LAS unsigned* st) {
    XcdBarrier b; b.bar = bar; b.x = xb_xcc_id(); b.st = st;
    if (threadIdx.x == 0) (void)xb_add(&bar[XB_XCNT(b.x)], 1u);
    return b;
}
__device__ __forceinline__ void xcd_barrier_complete(unsigned* bar, unsigned x, unsigned& nloc, unsigned& nx) {
    const unsigned G = gridDim.x * gridDim.y * gridDim.z;
    unsigned sum, cnt, mine, sp = 0u;
    for (;;) {
        sum = 0u; cnt = 0u; mine = 0u;
#pragma unroll
        for (unsigned j = 0; j < 16; ++j) { const unsigned c = xb_ld(&bar[XB_XCNT(j)]); sum += c; cnt += (c > 0u) ? 1u : 0u; mine = (j == x) ? c : mine; }
        if (sum == G) break;
        __builtin_amdgcn_s_sleep(1);
        if ((++sp & 255u) == 0u) { if (xb_ld(&bar[XB_TMO])) break; if (sp > XB_SPIN_CAP) { atomicAdd(&bar[XB_TMO], 1u); break; } }
    }
    nloc = mine > 0u ? mine : 1u; nx = cnt > 0u ? cnt : 1u;
}
__device__ __forceinline__ void xcd_barrier(const XcdBarrier& b) {
    asm volatile("s_waitcnt vmcnt(0)" ::: "memory");
    __syncthreads();
    if (threadIdx.x == 0) {
        unsigned* bar = b.bar;
        __builtin_amdgcn_s_waitcnt(0);
        unsigned nloc = b.st[0], nx = b.st[1];
        if (nloc == 0u) { xcd_barrier_complete(bar, b.x, nloc, nx); b.st[0] = nloc; b.st[1] = nx; }
        const unsigned old = xb_add(&bar[XB_XSUB(b.x)], 1u);
        const unsigned gen = old / nloc;
        if (old + 1u == (gen + 1u) * nloc) {
            __builtin_amdgcn_fence(__ATOMIC_RELEASE, "agent");
            asm volatile("s_waitcnt vmcnt(0)" ::: "memory");
            const unsigned og = xb_add(&bar[XB_TOP], 1u);
            const unsigned tg = og / nx;
            if (og + 1u == (tg + 1u) * nx) xb_add(&bar[XB_TOPGEN], 1u);
            else XB_SPIN(xb_ld(&bar[XB_TOPGEN]) == tg, bar);
            __builtin_amdgcn_fence(__ATOMIC_ACQUIRE, "agent");
            xb_add(&bar[XB_XGEN(b.x)], 1u);
            asm volatile("s_waitcnt vmcnt(0)" ::: "memory");
        } else {
            XB_SPIN(xb_ld(&bar[XB_XGEN(b.x)]) == gen, bar);
            __builtin_amdgcn_fence(__ATOMIC_ACQUIRE, "agent");
            asm volatile("s_waitcnt vmcnt(0)" ::: "memory");
        }
    }
    __syncthreads();
}

__global__ void __launch_bounds__(512, 2) fwd_kernel(Args a) {
    extern __shared__ __attribute__((aligned(16))) unsigned char lds_raw[];
    LAS unsigned char* lds = (LAS unsigned char*)lds_raw;
    const int tid = threadIdx.x, lane = tid & 63, wave = __builtin_amdgcn_readfirstlane(tid >> 6);
    const int lo = a.ph_lo, hi = a.ph_hi;
    unsigned char* ws = a.ws;
#define IN(k) (lo <= (k) && (k) < hi)
    volatile LAS unsigned* bst = (volatile LAS unsigned*)(lds + LDS_BYTES - 64);
    if (tid == 0) { bst[0] = 0u; bst[1] = 0u; }
    __syncthreads();
    (void)xcd_barrier_post((unsigned*)(ws + WS_CTL), bst);
    if (lo == 12345) cg::this_grid().sync();
#define SEAM(k) do { if (IN(k) && IN((k) + 1)) { XcdBarrier gb_; gb_.bar = (unsigned*)(ws + WS_CTL); gb_.x = xb_xcc_id(); gb_.st = (volatile LAS unsigned*)(lds + LDS_BYTES - 64); xcd_barrier(gb_); } } while (0)
    if (IN(0)) { p0_prologue(a, lds, wave, lane); }
    SEAM(0);
    if (IN(1)) {
        SchedA S; S.init(T, NIN, gridDim.x, blockIdx.x); S.XB = (const char*)(ws + WS_XB); S.W = (const char*)(ws + WS_WIN);
        EpiA E; E.ws = ws; E.GA = (bf16_t*)a.out;
        E.qn_a = a.in[4]; E.kn_a = a.in[5]; E.qn_b = a.in[7]; E.kn_b = a.in[8];
        pg8::gemm_phase<EpiA, SchedA>(lds, S, E);
    }
    SEAM(1);
    if (IN(2)) {
        AttnP P; P.QA = (const bf16_t*)(ws + WS_QA); P.KA = (const bf16_t*)(ws + WS_KA); P.VAT = (const bf16_t*)(ws + WS_VAT); P.ZA = (const bf16_t*)(ws + WS_ZA);
        P.QB = (const bf16_t*)(ws + WS_QB); P.KB = (const bf16_t*)(ws + WS_KB); P.VBT = (const bf16_t*)(ws + WS_VBT); P.ZB = (const bf16_t*)(ws + WS_ZB);
        P.Y = (bf16_t*)(ws + WS_Y); P.sink = a.in[9]; P.rpb = a.in[6];
        float shiftA, shiftB; bool fast;
        { float mqa = fabsf(a.in[4][lane]), mka = fabsf(a.in[5][lane]), mqb = fabsf(a.in[7][lane]), mkb = fabsf(a.in[8][lane]), msk = fabsf(a.in[9][lane & 7]), mr = 0.f;
          for (int i = tid; i < 8 * 465; i += 512) mr = fmaxf(mr, fabsf(a.in[6][i]));
#pragma unroll
          for (int o = 1; o < 64; o <<= 1) { mqa = fmaxf(mqa, __shfl_xor(mqa, o)); mka = fmaxf(mka, __shfl_xor(mka, o)); mqb = fmaxf(mqb, __shfl_xor(mqb, o)); mkb = fmaxf(mkb, __shfl_xor(mkb, o));
              msk = fmaxf(msk, __shfl_xor(msk, o)); mr = fmaxf(mr, __shfl_xor(mr, o)); }
          LAS float* red = (LAS float*)(lds + ATT_RPB);
          if (lane == 0) red[wave] = mr;
          __syncthreads();
          mr = red[0];
#pragma unroll
          for (int w = 1; w < 8; ++w) mr = fmaxf(mr, red[w]);
          __syncthreads();
          shiftA = 1.02f * (64.f * mqa * mka * QSCALE + mr * LOG2E) + 0.5f; shiftB = 1.02f * (64.f * mqb * mkb * QSCALE) + 0.5f;
          fast = (shiftA < 60.f) && (shiftB < 60.f) && (msk * LOG2E < 60.f); }
        AttStage<true> swa_st; AttQZ swa_qz;
        const bool pre = ((3072 + (int)gridDim.x - 1) / (int)gridDim.x) * (int)blockIdx.x < 3072;
        na_phase(P, lds, tid, wave, lane, fast, shiftA, swa_st, swa_qz);
        att_phase<true>(P, lds, tid, wave, lane, fast, shiftB, swa_st, swa_qz, pre);
    }
    SEAM(2);
    if (IN(3)) {
        SchedP S; S.init(T, 1024, gridDim.x, blockIdx.x); S.A = (const char*)(ws + WS_Y); S.W = (const char*)(ws + WS_WAB);
        EpiC1 E; E.GA = (const bf16_t*)a.out; E.GB = (const bf16_t*)a.out + (size_t)T * 1024; E.MG = (bf16_t*)(ws + WS_MG);
        pg8::gemm_phase<EpiC1, SchedP>(lds, S, E);
    }
    SEAM(3);
    if (IN(4)) {
        SchedP S; S.init(T, 1024, gridDim.x, blockIdx.x); S.A = (const char*)(ws + WS_MG); S.W = (const char*)(ws + WS_WO);
        EpiC2 E; E.xp = a.in[0]; E.xs = a.in[1]; E.out = a.out;
        pg8::gemm_phase<EpiC2, SchedP>(lds, S, E, true);
    }
#undef IN
#undef SEAM
}

extern "C" void kernel_launch(void* const* d_in, const int* in_sizes, int n_in, void* d_out, int out_size, void* d_ws, size_t ws_size, hipStream_t stream) {
    static int grid = 0;
    if (grid == 0) {
        if (n_in != 13 || out_size != T * D || ws_size < WS_END) { fprintf(stderr, "kernel_launch: unexpected shapes (n_in %d out %d ws %zu)\n", n_in, out_size, ws_size); grid = -1; return; }
        int dev = 0, cus = 0;
        if (hipGetDevice(&dev) != hipSuccess || hipDeviceGetAttribute(&cus, hipDeviceAttributeMultiprocessorCount, dev) != hipSuccess) { grid = -1; return; }
        if (hipFuncSetAttribute((const void*)fwd_kernel, hipFuncAttributeMaxDynamicSharedMemorySize, LDS_BYTES) != hipSuccess) { fprintf(stderr, "kernel_launch: hipFuncSetAttribute failed\n"); grid = -1; return; }
        int per_cu = 0;
        if (hipOccupancyMaxActiveBlocksPerMultiprocessor(&per_cu, (const void*)fwd_kernel, 512, LDS_BYTES) != hipSuccess || per_cu < 1) fprintf(stderr, "kernel_launch: occupancy query says %d\n", per_cu);
        (void)hipGetLastError();
        grid = cus;
    }
    if (grid < 0) return;
    hipMemsetAsync((char*)d_ws + WS_CTL, 0, CTL_BYTES, stream);
    Args a{};
    for (int i = 0; i < 13; ++i) a.in[i] = (const float*)d_in[i];
    a.out = (float*)d_out; a.ws = (unsigned char*)d_ws;
    if (N_LAUNCHES == 1) {
        a.ph_lo = 0; a.ph_hi = 5;
        void* args[] = {&a};
        hipError_t e = hipLaunchCooperativeKernel((const void*)fwd_kernel, dim3(grid), dim3(512), args, LDS_BYTES, stream);
        if (e != hipSuccess) fprintf(stderr, "cooperative launch failed: %s (grid %d)\n", hipGetErrorString(e), grid);
    } else {
        for (int p = 0; p < 5; ++p) {
            a.ph_lo = p; a.ph_hi = p + 1; hipLaunchKernelGGL(fwd_kernel, dim3(grid), dim3(512), LDS_BYTES, stream, a); }
    }
}
```

```cpp
#include <hip/hip_runtime.h>
#include <hip/hip_cooperative_groups.h>
#include <cstdio>
namespace cg = cooperative_groups;

#ifndef N_LAUNCHES
#define N_LAUNCHES 1
#endif

#define LAS __attribute__((address_space(3)))
typedef unsigned short bf16_t;
typedef short bf16x8 __attribute__((ext_vector_type(8)));
typedef short bf16x4 __attribute__((ext_vector_type(4)));
typedef float f32x4 __attribute__((ext_vector_type(4)));
typedef unsigned u32x4 __attribute__((ext_vector_type(4)));
typedef unsigned u32x2 __attribute__((ext_vector_type(2)));

constexpr int T = 49152, TP = 32768, D = 1024, NIN = 5376, SEQ = 4096;
constexpr float LOG2E = 1.4426950408889634f;
constexpr float QSCALE = 0.125f * LOG2E;
constexpr float NORM_EPS = 1e-6f;
constexpr size_t MiB = 1u << 20;
constexpr size_t WS_WIN = 0, WS_WAB = 11 * MiB, WS_WO = 13 * MiB, WS_ROPE = 15 * MiB, WS_XB = 17 * MiB, WS_QA = 113 * MiB, WS_KA = 161 * MiB, WS_QB = 209 * MiB,
                 WS_ZA = 257 * MiB, WS_ZB = 305 * MiB, WS_VAT = 353 * MiB, WS_KB = 401 * MiB, WS_VBT = 413 * MiB, WS_END = 425 * MiB;
constexpr size_t WS_CTL = 11 * MiB - 65536, CTL_BYTES = 16384;
constexpr size_t WS_Y = WS_XB;
constexpr size_t WS_MG = WS_QA;
constexpr int LDS_BYTES = 155648;

typedef __bf16 bf16x2_t __attribute__((ext_vector_type(2)));
typedef float f32x2_t __attribute__((ext_vector_type(2)));
__device__ __forceinline__ unsigned cvt_pk_bf16(float lo, float hi) { const f32x2_t v = {lo, hi}; const bf16x2_t r = __builtin_convertvector(v, bf16x2_t); return __builtin_bit_cast(unsigned, r); }
__device__ __forceinline__ float bf_lo(unsigned w) { return __uint_as_float(w << 16); }
__device__ __forceinline__ float bf_hi(unsigned w) { return __uint_as_float(w & 0xffff0000u); }
__device__ __forceinline__ float fast_sigmoid(float v) { return __builtin_amdgcn_rcpf(1.0f + __builtin_amdgcn_exp2f(-v * LOG2E)); }

namespace pg8 {
constexpr int BM = 256, BK = 64, HALF = 128, HTB = HALF * BK * 2, STAGE_BYTES = 8 * HTB, NXCD = 8, WGM = 4, K = 1024;
__device__ __forceinline__ int lds_byte(int r, int c) { const int st = (r >> 4) * 2 + (c >> 5), rr = r & 15, cc = c & 31, ob = rr * 64 + cc * 2; return st * 1024 + (ob ^ (((ob >> 9) & 1) << 5)); }
__device__ __forceinline__ void stage_rc(int b, int& R, int& C) { const int st = b / 1024, sb = b % 1024, swz = sb ^ (((sb >> 9) & 1) << 5); R = (st >> 1) * 16 + swz / 64; C = (st & 1) * 32 + (swz % 64) / 2; }
__device__ __forceinline__ int perm32(int rho) { const int n = rho >> 4, i = rho & 15; return 8 * (i >> 2) + 4 * n + (i & 3); }
struct Unit { int pm, pn; };
struct StaticOrder {
    int nM, nN, nwg, G, c;
    __device__ void init(int M, int N, int G_, int c_) { nM = M / BM; nN = N / BM; nwg = nM * nN; G = G_; c = c_; }
    __device__ bool next(int i, Unit& u) const {
        const long L = (long)i * G + c; if (L >= nwg) return false;
        int wgid = (int)L; { const int q = nwg / NXCD, r = nwg % NXCD, xcd = wgid % NXCD, off = wgid / NXCD; wgid = (xcd < r ? xcd * (q + 1) : r * (q + 1) + (xcd - r) * q) + off; }
        const int nig = WGM * nN, gid = wgid / nig, fm = gid * WGM, gsz = (nM - fm) < WGM ? (nM - fm) : WGM;
        u.pm = fm + ((wgid % nig) % gsz); u.pn = (wgid % nig) / gsz; return true;
    }
};
template <class Epi, class Sched>
__device__ __forceinline__ void gemm_phase(LAS unsigned char* lds, const Sched& S, const Epi& E, bool natural = false) {
    const int tid = threadIdx.x, wid = __builtin_amdgcn_readfirstlane(tid >> 6), lane = tid & 63, wr = wid >> 2, wc = wid & 3, fr = lane & 15, fq = lane >> 4;
    constexpr int nt = K / BK;
    unsigned voffA[2], voffB0[2], voffB1[2];
#pragma unroll
    for (int i = 0; i < 2; ++i) { int R, C; stage_rc(tid * 16 + i * 8192, R, C);
        const int Rb = 64 * (R >> 5) + (natural ? (R & 31) : perm32(R & 31));
        voffA[i] = (unsigned)(R * K + C) * 2u; voffB0[i] = (unsigned)(Rb * K + C) * 2u; voffB1[i] = (unsigned)((Rb + 32) * K + C) * 2u; }
    constexpr size_t kstep = (size_t)(BK * 2);
    constexpr size_t hstep = (size_t)HALF * K * 2;
    const unsigned ldsw = (unsigned)wid * 1024u;
    const int aoff = lds_byte(wr * 64 + fr, fq * 8), boff = lds_byte(wc * 32 + fr, fq * 8);
#define PG8_SA(b, h) (((b) * 2 + (h)) * HTB)
#define PG8_SB(b, h) ((4 + (b) * 2 + (h)) * HTB)
#define PG8_STAGE(bufoff, gbase, voff) do { _Pragma("unroll") for (int _i = 0; _i < 2; ++_i) \
        __builtin_amdgcn_global_load_lds((const unsigned*)((const char*)(gbase) + (voff)[_i]), (LAS unsigned*)(lds + (bufoff) + ldsw + _i * 8192), 16, 0, 0); } while (0)
#define PG8_LDA(dst, b, h) do { _Pragma("unroll") for (int m = 0; m < 4; ++m) _Pragma("unroll") for (int k = 0; k < 2; ++k) dst[m][k] = *(const LAS bf16x8*)(lds + PG8_SA(b, h) + aoff + m * 2048 + k * 1024); } while (0)
#define PG8_LDB(dst, b, h) do { _Pragma("unroll") for (int n = 0; n < 2; ++n) _Pragma("unroll") for (int k = 0; k < 2; ++k) dst[n][k] = *(const LAS bf16x8*)(lds + PG8_SB(b, h) + boff + n * 2048 + k * 1024); } while (0)
#define PG8_MMA(ai, bj, At, Bt) do { __builtin_amdgcn_s_setprio(1); _Pragma("unroll") for (int m = 0; m < 4; ++m) _Pragma("unroll") for (int n = 0; n < 2; ++n) _Pragma("unroll") for (int k = 0; k < 2; ++k) \
        acc[ai][bj][m][n] = __builtin_amdgcn_mfma_f32_16x16x32_bf16(Bt[n][k], At[m][k], acc[ai][bj][m][n], 0, 0, 0); __builtin_amdgcn_s_setprio(0); } while (0)
#define PG8_WAIT_V(n) asm volatile("s_waitcnt vmcnt(" #n ")" ::: "memory")
#define PG8_WAIT_L(n) asm volatile("s_waitcnt lgkmcnt(" #n ")" ::: "memory")
#define PG8_BAR __builtin_amdgcn_s_barrier()
#define PG8_SCHED __builtin_amdgcn_sched_barrier(0)
    Unit cur, nxt; int ui = 0;
    if (!S.next(0, cur)) return;
    f32x4 acc[2][2][4][2];
#pragma unroll
    for (int a = 0; a < 2; ++a)
#pragma unroll
        for (int b = 0; b < 2; ++b)
#pragma unroll
            for (int m = 0; m < 4; ++m)
#pragma unroll
                for (int n = 0; n < 2; ++n) acc[a][b][m][n] = (f32x4){0.f, 0.f, 0.f, 0.f};
    bf16x8 At[4][2], B0[2][2], B1[2][2];
    const char* cA; const char* cB; S.ptrs(cur, cA, cB);
    PG8_STAGE(PG8_SB(0, 0), cB, voffB0); PG8_STAGE(PG8_SB(0, 1), cB, voffB1); PG8_STAGE(PG8_SA(0, 0), cA, voffA); PG8_STAGE(PG8_SA(0, 1), cA + hstep, voffA);
    if (wr == 1) PG8_BAR;
    PG8_WAIT_V(2); PG8_BAR;
    PG8_STAGE(PG8_SB(1, 0), cB + kstep, voffB0); PG8_STAGE(PG8_SA(1, 0), cA + kstep, voffA); PG8_STAGE(PG8_SB(1, 1), cB + kstep, voffB1);
    PG8_WAIT_V(6); PG8_BAR;
    for (;;) {
        const bool has_next = S.next(ui + 1, nxt);
        const char* nA = cA; const char* nB = cB; if (has_next) S.ptrs(nxt, nA, nB);
        for (int t = 0; t < nt; t += 2) {
            const bool last = (t == nt - 2);
            const char* a1 = cA + (size_t)(t + 1) * kstep;
            const char* a2 = last ? nA : cA + (size_t)(t + 2) * kstep; const char* b2 = last ? nB : cB + (size_t)(t + 2) * kstep;
            const char* a3 = a2 + kstep; const char* b3 = b2 + kstep;
            if constexpr (Epi::MIDHOOK) { if (t == nt / 2) E.mid(acc, cur, wr, wc, fr, fq); }
            PG8_LDB(B0, 0, 0); PG8_LDB(B1, 0, 1); PG8_SCHED; PG8_LDA(At, 0, 0); PG8_STAGE(PG8_SA(1, 1), a1 + hstep, voffA);
            PG8_WAIT_V(8); PG8_WAIT_L(0); PG8_BAR; PG8_MMA(0, 0, At, B0); PG8_MMA(0, 1, At, B1); PG8_BAR; PG8_SCHED;
            PG8_LDA(At, 0, 1); PG8_STAGE(PG8_SB(0, 0), b2, voffB0); PG8_STAGE(PG8_SB(0, 1), b2, voffB1); PG8_STAGE(PG8_SA(0, 0), a2, voffA);
            PG8_WAIT_V(8); PG8_WAIT_L(0); PG8_BAR; PG8_MMA(1, 0, At, B0); PG8_MMA(1, 1, At, B1); PG8_BAR; PG8_SCHED;
            PG8_LDB(B0, 1, 0); PG8_LDB(B1, 1, 1); PG8_SCHED; PG8_LDA(At, 1, 0); PG8_STAGE(PG8_SA(0, 1), a2 + hstep, voffA);
            PG8_WAIT_V(8); PG8_WAIT_L(0); PG8_BAR; PG8_MMA(0, 0, At, B0); PG8_MMA(0, 1, At, B1); PG8_BAR; PG8_SCHED;
            PG8_LDA(At, 1, 1); PG8_STAGE(PG8_SB(1, 0), b3, voffB0); PG8_STAGE(PG8_SB(1, 1), b3, voffB1); PG8_STAGE(PG8_SA(1, 0), a3, voffA);
            PG8_WAIT_V(8); PG8_WAIT_L(0); PG8_BAR; PG8_MMA(1, 0, At, B0); PG8_MMA(1, 1, At, B1); PG8_BAR; PG8_SCHED;
        }
        if (wr == 0) PG8_BAR;
        E(acc, cur, wr, wc, fr, fq);
        if (!has_next) break;
#pragma unroll
        for (int a = 0; a < 2; ++a)
#pragma unroll
            for (int b = 0; b < 2; ++b)
#pragma unroll
                for (int m = 0; m < 4; ++m)
#pragma unroll
                    for (int n = 0; n < 2; ++n) acc[a][b][m][n] = (f32x4){0.f, 0.f, 0.f, 0.f};
        cur = nxt; cA = nA; cB = nB; ++ui;
        if (wr == 1) PG8_BAR;
    }
    PG8_WAIT_V(0);
    PG8_BAR;
#undef PG8_SA
#undef PG8_SB
#undef PG8_STAGE
#undef PG8_LDA
#undef PG8_LDB
#undef PG8_MMA
#undef PG8_WAIT_V
#undef PG8_WAIT_L
#undef PG8_BAR
#undef PG8_SCHED
}
}
using pg8::Unit;
typedef f32x4 AccT[2][2][4][2];

__device__ const float ROPE_IREV[32] = {1.591549367e-01f, 1.193493679e-01f, 8.949939907e-02f, 6.711508334e-02f, 5.032921210e-02f, 3.774158657e-02f, 2.830219641e-02f, 2.122365311e-02f,
    1.591549441e-02f, 1.193493698e-02f, 8.949940093e-03f, 6.711508147e-03f, 5.032920744e-03f, 3.774158657e-03f, 2.830219688e-03f, 2.122365171e-03f,
    1.591549371e-03f, 1.193493721e-03f, 8.949940093e-04f, 6.711508031e-04f, 5.032921326e-04f, 3.774158540e-04f, 2.830219746e-04f, 2.122365258e-04f,
    1.591549517e-04f, 1.193493663e-04f, 8.949940093e-05f, 6.711508468e-05f, 5.032921035e-05f, 3.774158540e-05f, 2.830219637e-05f, 2.122365368e-05f};
struct SchedA : pg8::StaticOrder {
    const char* XB; const char* W;
    __device__ __forceinline__ void ptrs(const Unit& u, const char*& cA, const char*& cB) const {
        const char* x = XB + (size_t)u.pm * (256 * 1024 * 2); const char* w = W + (size_t)u.pn * (256 * 1024 * 2);
        if (u.pn >= 19) { cA = w; cB = x; } else { cA = x; cB = w; }
    }
};
struct SchedP : pg8::StaticOrder {
    const char* A; const char* W;
    __device__ __forceinline__ void ptrs(const Unit& u, const char*& cA, const char*& cB) const { cA = A + (size_t)u.pm * (256 * 1024 * 2); cB = W + (size_t)u.pn * (256 * 1024 * 2); }
};

struct EpiA {
    static constexpr bool MIDHOOK = false;
    unsigned char* ws; bf16_t* GA;
    const float *qn_a, *kn_a, *qn_b, *kn_b;
    __device__ __forceinline__ void mid(AccT&, const Unit&, int, int, int, int) const {}
    __device__ __forceinline__ void qk(const AccT& acc, int row0, int wr, int fr, int fq, bf16_t* dst, int ld, int colh, const float* w, float scale, bool rope) const {
        f32x4 wv[2][2];
        int fq8 = 8 * fq; asm volatile("" : "+v"(fq8));
#pragma unroll
        for (int bj = 0; bj < 2; ++bj)
#pragma unroll
            for (int n = 0; n < 2; ++n) wv[bj][n] = *(const f32x4*)(w + 32 * bj + fq8 + 4 * n) * scale;
        f32x4 irev[2];
#pragma unroll
        for (int n = 0; n < 2; ++n) irev[n] = rope ? *(const f32x4*)(ROPE_IREV + fq8 + 4 * n) : (f32x4){0.f, 0.f, 0.f, 0.f};
#pragma unroll
        for (int ai = 0; ai < 2; ++ai)
#pragma unroll
            for (int m = 0; m < 4; ++m) {
                const int r = row0 + 128 * ai + 64 * wr + 16 * m + fr;
                f32x4 v[2][2]; float ss = 0.f;
#pragma unroll
                for (int bj = 0; bj < 2; ++bj)
#pragma unroll
                    for (int n = 0; n < 2; ++n) { v[bj][n] = acc[ai][bj][m][n]; const f32x4 x = v[bj][n]; ss += (x[0] * x[0] + x[1] * x[1]) + (x[2] * x[2] + x[3] * x[3]); }
                ss += __shfl_xor(ss, 16); ss += __shfl_xor(ss, 32);
                const float inv = __builtin_amdgcn_rsqf(ss * (1.0f / 64.0f) + NORM_EPS);
#pragma unroll
                for (int bj = 0; bj < 2; ++bj)
#pragma unroll
                    for (int n = 0; n < 2; ++n) v[bj][n] = v[bj][n] * inv * wv[bj][n];
                if (rope) {
                    const float fp = (float)(r & (SEQ - 1));
#pragma unroll
                    for (int n = 0; n < 2; ++n) {
                        f32x4 c, s;
#pragma unroll
                        for (int j = 0; j < 4; ++j) { const float fr_ = __builtin_amdgcn_fractf(fp * irev[n][j]); c[j] = __builtin_amdgcn_cosf(fr_); s[j] = __builtin_amdgcn_sinf(fr_); }
                        const f32x4 x1 = v[0][n], x2 = v[1][n];
                        v[0][n] = x1 * c - x2 * s; v[1][n] = x2 * c + x1 * s;
                    }
                }
                bf16_t* rowp = dst + (size_t)r * ld + colh + 8 * fq;
#pragma unroll
                for (int bj = 0; bj < 2; ++bj) { u32x4 o; o.x = cvt_pk_bf16(v[bj][0][0], v[bj][0][1]); o.y = cvt_pk_bf16(v[bj][0][2], v[bj][0][3]); o.z = cvt_pk_bf16(v[bj][1][0], v[bj][1][1]); o.w = cvt_pk_bf16(v[bj][1][2], v[bj][1][3]);
                    *(u32x4*)(rowp + 32 * bj) = o; }
            }
    }
    __device__ __forceinline__ void act(const AccT& acc, int row0, int wr, int wc, int fr, int fq, bf16_t* dst, int ld, int col0) const {
#pragma unroll
        for (int ai = 0; ai < 2; ++ai)
#pragma unroll
            for (int m = 0; m < 4; ++m) {
                const int r = row0 + 128 * ai + 64 * wr + 16 * m + fr;
                bf16_t* rowp = dst + (size_t)r * ld + col0 + 64 * wc + 8 * fq;
#pragma unroll
                for (int bj = 0; bj < 2; ++bj) { unsigned w[4];
#pragma unroll
                    for (int n = 0; n < 2; ++n)
#pragma unroll
                        for (int h = 0; h < 2; ++h) { const f32x2_t x = {acc[ai][bj][m][n][2 * h], acc[ai][bj][m][n][2 * h + 1]};
                            const f32x2_t t = x * (-LOG2E); f32x2_t e; e[0] = __builtin_amdgcn_exp2f(t[0]); e[1] = __builtin_amdgcn_exp2f(t[1]);
                            const f32x2_t d = e + 1.0f; f32x2_t sg; sg[0] = __builtin_amdgcn_rcpf(d[0]); sg[1] = __builtin_amdgcn_rcpf(d[1]);
                            const f32x2_t o = x * sg; w[2 * n + h] = cvt_pk_bf16(o[0], o[1]); }
                    u32x4 wv; wv.x = w[0]; wv.y = w[1]; wv.z = w[2]; wv.w = w[3];
                    *(u32x4*)(rowp + 32 * bj) = wv; }
            }
    }
    __device__ __forceinline__ void operator()(AccT& acc, const Unit& u, int wr, int wc, int fr, int fq) const {
        const int pn = u.pn, row0 = u.pm * 256;
        bf16_t* const QA = (bf16_t*)(ws + WS_QA); bf16_t* const KA = (bf16_t*)(ws + WS_KA); bf16_t* const QB = (bf16_t*)(ws + WS_QB); bf16_t* const KB = (bf16_t*)(ws + WS_KB);
        bf16_t* const VBT = (bf16_t*)(ws + WS_VBT); bf16_t* const ZA = (bf16_t*)(ws + WS_ZA); bf16_t* const ZB = (bf16_t*)(ws + WS_ZB); bf16_t* const VAT = (bf16_t*)(ws + WS_VAT);
        bf16_t* const GB = GA + (size_t)T * 1024;
        if (pn < 2) qk(acc, row0, wr, fr, fq, QA, 512, 256 * pn + 64 * wc, qn_a, QSCALE, false);
        else if (pn < 4) qk(acc, row0, wr, fr, fq, KA, 512, 256 * (pn - 2) + 64 * wc, kn_a, 1.0f, false);
        else if (pn < 6) qk(acc, row0, wr, fr, fq, QB, 512, 256 * (pn - 4) + 64 * wc, qn_b, QSCALE, true);
        else if (pn == 6) {
            if (wc < 2) qk(acc, row0, wr, fr, fq, KB, 128, 64 * wc, kn_b, 1.0f, true);
            else {
#pragma unroll
                for (int ai = 0; ai < 2; ++ai)
#pragma unroll
                    for (int m = 0; m < 4; ++m) {
                        const int r = row0 + 128 * ai + 64 * wr + 16 * m + fr;
                        bf16_t* base = VBT + ((size_t)(r >> 3) * 128 + 64 * (wc - 2) + 8 * fq) * 8 + (r & 7);
#pragma unroll
                        for (int bj = 0; bj < 2; ++bj)
#pragma unroll
                            for (int n = 0; n < 2; ++n) { const f32x4 x = acc[ai][bj][m][n];
                                const unsigned p0 = cvt_pk_bf16(x[0], x[1]), p1 = cvt_pk_bf16(x[2], x[3]);
                                bf16_t* q = base + (32 * bj + 4 * n) * 8;
                                q[0] = (bf16_t)(p0 & 0xffffu); q[8] = (bf16_t)(p0 >> 16); q[16] = (bf16_t)(p1 & 0xffffu); q[24] = (bf16_t)(p1 >> 16); }
                    }
            }
        }
        else if (pn < 9) act(acc, row0, wr, wc, fr, fq, ZA, 512, 256 * (pn - 7));
        else if (pn < 11) act(acc, row0, wr, wc, fr, fq, ZB, 512, 256 * (pn - 9));
        else if (pn < 19) {
#pragma unroll
            for (int ai = 0; ai < 2; ++ai)
#pragma unroll
                for (int m = 0; m < 4; ++m) {
                    const int r = row0 + 128 * ai + 64 * wr + 16 * m + fr;
                    unsigned Rw[4], Sw[4];
#pragma unroll
                    for (int n = 0; n < 2; ++n)
#pragma unroll
                        for (int h = 0; h < 2; ++h) { const f32x2_t a2 = {acc[ai][0][m][n][2 * h], acc[ai][0][m][n][2 * h + 1]}, b2 = {acc[ai][1][m][n][2 * h], acc[ai][1][m][n][2 * h + 1]};
                            const f32x2_t ta = a2 * (-LOG2E), tb = b2 * (-LOG2E); f32x2_t ea, eb;
                            ea[0] = __builtin_amdgcn_exp2f(ta[0]); ea[1] = __builtin_amdgcn_exp2f(ta[1]); eb[0] = __builtin_amdgcn_exp2f(tb[0]); eb[1] = __builtin_amdgcn_exp2f(tb[1]);
                            const f32x2_t ua = ea + 1.0f, ub = eb + 1.0f, pr = ua * ub; f32x2_t t; t[0] = __builtin_amdgcn_rcpf(pr[0]); t[1] = __builtin_amdgcn_rcpf(pr[1]);
                            const f32x2_t S2 = t * ua, R2 = t * ub * ub;
                            Sw[2 * n + h] = cvt_pk_bf16(S2[0], S2[1]); Rw[2 * n + h] = cvt_pk_bf16(R2[0], R2[1]); }
                    const size_t off = (size_t)r * 1024 + 128 * (pn - 11) + 32 * wc + 8 * fq;
                    u32x4 w; w.x = Rw[0]; w.y = Rw[1]; w.z = Rw[2]; w.w = Rw[3];
                    *(u32x4*)(GA + off) = w;
                    w.x = Sw[0]; w.y = Sw[1]; w.z = Sw[2]; w.w = Sw[3];
                    *(u32x4*)(GB + off) = w;
                }
        }
        else {
            const int c0 = 256 * (pn - 19);
#pragma unroll
            for (int ai = 0; ai < 2; ++ai)
#pragma unroll
                for (int m = 0; m < 4; ++m) {
                    const int c = c0 + 128 * ai + 64 * wr + 16 * m + fr;
#pragma unroll
                    for (int bj = 0; bj < 2; ++bj) {
                        const int t0 = row0 + 64 * wc + 32 * bj + 8 * fq;
                        const f32x4 x0 = acc[ai][bj][m][0], x1 = acc[ai][bj][m][1];
                        u32x4 o; o.x = cvt_pk_bf16(x0[0], x0[1]); o.y = cvt_pk_bf16(x0[2], x0[3]); o.z = cvt_pk_bf16(x1[0], x1[1]); o.w = cvt_pk_bf16(x1[2], x1[3]);
                        *(u32x4*)(VAT + ((size_t)(t0 >> 3) * 512 + c) * 8) = o; }
                }
        }
    }
};

struct EpiC1 {
    static constexpr bool MIDHOOK = true;
    const bf16_t *GA, *GB; bf16_t* MG;
    __device__ __forceinline__ void mid(AccT& acc, const Unit& u, int wr, int wc, int fr, int fq) const {
        unsigned base = (unsigned)((u.pm * 256 + 64 * wr + fr) * 1024 + u.pn * 256 + 64 * wc + 8 * fq) * 2u;
        asm volatile("" : "+v"(base));
#pragma unroll
        for (int ai = 0; ai < 2; ++ai)
#pragma unroll
            for (int m = 0; m < 4; ++m) {
#pragma unroll
                for (int bj = 0; bj < 2; ++bj) {
                    const unsigned off = base + (unsigned)((128 * ai + 16 * m) * 1024 + 32 * bj) * 2u;
                    const u32x4 a = *(const u32x4*)((const char*)GA + off);
                    f32x4 r0, r1;
                    r0[0] = bf_lo(a.x); r0[1] = bf_hi(a.x); r0[2] = bf_lo(a.y); r0[3] = bf_hi(a.y);
                    r1[0] = bf_lo(a.z); r1[1] = bf_hi(a.z); r1[2] = bf_lo(a.w); r1[3] = bf_hi(a.w);
                    acc[ai][bj][m][0] *= r0; acc[ai][bj][m][1] *= r1;
                }

            }
    }
    __device__ __forceinline__ void operator()(AccT& acc, const Unit& u, int wr, int wc, int fr, int fq) const {
        unsigned base = (unsigned)((u.pm * 256 + 64 * wr + fr) * 1024 + u.pn * 256 + 64 * wc + 8 * fq) * 2u;
        asm volatile("" : "+v"(base));
        u32x4 sv[2][4][2];
#pragma unroll
        for (int ai = 0; ai < 2; ++ai)
#pragma unroll
            for (int m = 0; m < 4; ++m)
#pragma unroll
                for (int bj = 0; bj < 2; ++bj) sv[ai][m][bj] = *(const u32x4*)((const char*)GB + base + (unsigned)((128 * ai + 16 * m) * 1024 + 32 * bj) * 2u);
#pragma unroll
        for (int ai = 0; ai < 2; ++ai)
#pragma unroll
            for (int m = 0; m < 4; ++m) {
#pragma unroll
                for (int bj = 0; bj < 2; ++bj) {
                    const unsigned off = base + (unsigned)((128 * ai + 16 * m) * 1024 + 32 * bj) * 2u;
                    const u32x4 b = sv[ai][m][bj];
                    const f32x4 x0 = acc[ai][bj][m][0], x1 = acc[ai][bj][m][1];
                    u32x4 o; o.x = cvt_pk_bf16(x0[0] * bf_lo(b.x), x0[1] * bf_hi(b.x)); o.y = cvt_pk_bf16(x0[2] * bf_lo(b.y), x0[3] * bf_hi(b.y));
                    o.z = cvt_pk_bf16(x1[0] * bf_lo(b.z), x1[1] * bf_hi(b.z)); o.w = cvt_pk_bf16(x1[2] * bf_lo(b.w), x1[3] * bf_hi(b.w));
                    *(u32x4*)((char*)MG + off) = o;
                }
            }
    }
};
struct EpiC2 {
    static constexpr bool MIDHOOK = false;
    const float *xp, *xs; float* out;
    __device__ __forceinline__ void mid(AccT&, const Unit&, int, int, int, int) const {}
    __device__ __forceinline__ void operator()(AccT& acc, const Unit& u, int wr, int wc, int fr, int fq) const {
        const int row0 = u.pm * 256;
        const char* xb = (const char*)(row0 < TP ? xp + (size_t)row0 * 1024 : xs + (size_t)(row0 - TP) * 1024);
        char* ob = (char*)(out + (size_t)row0 * 1024);
        unsigned base = (unsigned)((64 * wr + fr) * 1024 + u.pn * 256 + 64 * wc + 4 * fq) * 4u;
        asm volatile("" : "+v"(base));
#pragma unroll
        for (int ai = 0; ai < 2; ++ai) {
            f32x4 xv[4][2][2];
#pragma unroll
            for (int m = 0; m < 4; ++m)
#pragma unroll
                for (int bj = 0; bj < 2; ++bj)
#pragma unroll
                    for (int n = 0; n < 2; ++n) xv[m][bj][n] = *(const f32x4*)(xb + base + (unsigned)((128 * ai + 16 * m) * 1024 + 32 * bj + 16 * n) * 4u);
#pragma unroll
            for (int m = 0; m < 4; ++m)
#pragma unroll
                for (int bj = 0; bj < 2; ++bj)
#pragma unroll
                    for (int n = 0; n < 2; ++n) *(f32x4*)(ob + base + (unsigned)((128 * ai + 16 * m) * 1024 + 32 * bj + 16 * n) * 4u) = xv[m][bj][n] + acc[ai][bj][m][n];
            asm volatile("" ::: "memory");
        }
    }
};

__device__ __forceinline__ int map_col(int n) {
    if (n < 1024) return n;
    if (n < 1536) return 2048 + n - 1024;
    if (n < 1664) return 2560 + n - 1536;
    if (n < 1792) return 2688 + n - 1664;
    if (n < 2304) return 1536 + n - 1792;
    if (n < 2816) return 2816 + n - 2304;
    if (n < 4864) { const int w = n - 2816, tg = w >> 8, ww = w & 255, wcw = ww >> 6, bj = (ww >> 5) & 1, e = ww & 31;
        return (bj ? 4352 : 3328) + 128 * tg + 32 * wcw + e; }
    return 1024 + n - 4864;
}
__device__ __forceinline__ void p0_transpose_item(const float* W, int N, int ksrc0, int nsrc0, const float* ksc, bf16_t* WT, int nrow0, int kdst0, LAS float* scr, int lane) {
#pragma unroll 8
    for (int i = 0; i < 32; ++i) { const int kk = 2 * i + (lane >> 5); float v = W[(size_t)(ksrc0 + kk) * N + nsrc0 + (lane & 31)]; if (ksc) v *= ksc[ksrc0 + kk]; scr[kk * 33 + (lane & 31)] = v; }
    asm volatile("s_waitcnt lgkmcnt(0)" ::: "memory");
    const int c = lane & 7;
#pragma unroll
    for (int j = 0; j < 4; ++j) { const int n = (lane >> 3) + 8 * j; const LAS float* s = scr + (8 * c) * 33 + n;
        u32x4 o; o.x = cvt_pk_bf16(s[0 * 33], s[1 * 33]); o.y = cvt_pk_bf16(s[2 * 33], s[3 * 33]); o.z = cvt_pk_bf16(s[4 * 33], s[5 * 33]); o.w = cvt_pk_bf16(s[6 * 33], s[7 * 33]);
        *(u32x4*)(WT + (size_t)(nrow0 + n) * 1024 + kdst0 + 8 * c) = o; }
    asm volatile("s_waitcnt lgkmcnt(0)" ::: "memory");
}

struct Args { const float* in[13]; float* out; unsigned char* ws; int ph_lo, ph_hi; };

__device__ __forceinline__ void p0_load4(const Args& a, int m0, int NGW, int lane, f32x4 (&v)[4][4]) {
#pragma unroll
    for (int u = 0; u < 4; ++u) { const int m = min(m0 + u * NGW, T - 1);
        const float* xrow = m < TP ? a.in[0] + (size_t)m * 1024 : a.in[1] + (size_t)(m - TP) * 1024;
        const f32x4* xr = (const f32x4*)xrow + lane;
#pragma unroll
        for (int j = 0; j < 4; ++j) v[u][j] = xr[64 * j]; }
}
__device__ __forceinline__ void p0_proc4(bf16_t* XB, int m0, int NGW, int lane, const f32x4 (&v)[4][4]) {
    float s[4];
#pragma unroll
    for (int u = 0; u < 4; ++u) { float t = 0.f;
#pragma unroll
        for (int j = 0; j < 4; ++j) t += (v[u][j][0] * v[u][j][0] + v[u][j][1] * v[u][j][1]) + (v[u][j][2] * v[u][j][2] + v[u][j][3] * v[u][j][3]);
        s[u] = t; }
#pragma unroll
    for (int o = 1; o < 64; o <<= 1) {
#pragma unroll
        for (int u = 0; u < 4; ++u) s[u] += __shfl_xor(s[u], o); }
#pragma unroll
    for (int u = 0; u < 4; ++u) { const int m = m0 + u * NGW; if (m >= T) break;
        const float rstd = 1.0f / sqrtf(s[u] * (1.0f / 1024.0f) + NORM_EPS);
        u32x2* o8 = (u32x2*)(XB + (size_t)m * 1024) + lane;
#pragma unroll
        for (int j = 0; j < 4; ++j) { u32x2 w; w.x = cvt_pk_bf16(v[u][j][0] * rstd, v[u][j][1] * rstd); w.y = cvt_pk_bf16(v[u][j][2] * rstd, v[u][j][3] * rstd); o8[64 * j] = w; } }
}

__device__ __forceinline__ void p0_prologue(const Args& a, LAS unsigned char* lds, int wave, int lane) {
    if (wave < 6) {
        LAS float* scr = (LAS float*)(lds + wave * 16384);
        const int gw = blockIdx.x * 6 + wave, NGW = gridDim.x * 6;
        const float* w_in = a.in[3]; const float* w_oa = a.in[10]; const float* w_ob = a.in[11]; const float* w_o = a.in[12]; const float* ng = a.in[2];
        bf16_t* WIN = (bf16_t*)(a.ws + WS_WIN); bf16_t* WAB = (bf16_t*)(a.ws + WS_WAB); bf16_t* WO = (bf16_t*)(a.ws + WS_WO);
        constexpr int I_IN = 16 * 168, I_OA = 8 * 32, I_OB = 8 * 32, I_O = 16 * 32, NITEMS = I_IN + I_OA + I_OB + I_O;
        for (int it = gw; it < NITEMS; it += NGW) {
            int r = it;
            if (r < I_IN) { const int kb = r / 168, nb = r % 168; p0_transpose_item(w_in, NIN, 64 * kb, map_col(32 * nb), ng, WIN, 32 * nb, 64 * kb, scr, lane); continue; } r -= I_IN;
            if (r < I_OA) { const int kb = r / 32, nb = r % 32; p0_transpose_item(w_oa, 1024, 64 * kb, 32 * nb, nullptr, WAB, 32 * nb, 64 * kb, scr, lane); continue; } r -= I_OA;
            if (r < I_OB) { const int kb = r / 32, nb = r % 32; p0_transpose_item(w_ob, 1024, 64 * kb, 32 * nb, nullptr, WAB, 32 * nb, 512 + 64 * kb, scr, lane); continue; } r -= I_OB;
            { const int kb = r / 32, nb = r % 32; p0_transpose_item(w_o, 1024, 64 * kb, 32 * nb, nullptr, WO, 32 * nb, 64 * kb, scr, lane); }
        }
    } else {
        bf16_t* XB = (bf16_t*)(a.ws + WS_XB);
        const int gw = blockIdx.x * 2 + (wave - 6), NGW = gridDim.x * 2;
        f32x4 va[4][4], vb[4][4];
        int m0 = gw;
        if (m0 < T) p0_load4(a, m0, NGW, lane, va);
        while (m0 < T) {
            const int m1 = m0 + 4 * NGW; const bool has1 = m1 < T;
            if (has1) p0_load4(a, m1, NGW, lane, vb);
            p0_proc4(XB, m0, NGW, lane, va);
            if (!has1) break;
            const int m2 = m1 + 4 * NGW; const bool has2 = m2 < T;
            if (has2) p0_load4(a, m2, NGW, lane, va);
            p0_proc4(XB, m1, NGW, lane, vb);
            if (!has2) break;
            m0 = m2;
        }
    }
}

struct AttnP { const bf16_t *QA, *KA, *VAT, *ZA, *QB, *KB, *VBT, *ZB; bf16_t* Y; const float* sink; const float* rpb; };
constexpr int ATT_VOFF = 73728, ATT_RPB = 147456;
__device__ __forceinline__ int att_vpos(int d) { return (d & 32) | ((d & 4) << 2) | ((d & 24) >> 1) | (d & 3); }

template <bool SWA> struct AttStage { u32x4 k[SWA ? 6 : 9]; u32x4 v[SWA ? 6 : 9]; };

template <bool SWA>
__device__ __forceinline__ void att_decode(int item, int& b, int& h, int& x) {
    if (SWA) { x = item & 31; h = (item >> 5) & 1; b = item >> 6; }
    else { x = item & 31; h = (item >> 5) & 7; b = item >> 8; }
}
template <bool SWA>
__device__ __forceinline__ void att_load(const AttnP& P, int item, int tid, AttStage<SWA>& st) {
    constexpr int NCH = SWA ? 6 : 9, KLD = SWA ? 128 : 512;
    int b, h, x; att_decode<SWA>(item, b, h, x);
    const int tb = b * SEQ, kcol = h * 64;
    const bf16_t* Kp = SWA ? P.KB : P.KA; const bf16_t* VT = SWA ? P.VBT : P.VAT;
    const int base = SWA ? 128 * x - 128 : min(max(2 * x - 4, 0), 56);
#pragma unroll
    for (int i = 0; i < NCH; ++i) {
        const int idx = tid + 512 * i;
        { const int k = idx >> 3, c = idx & 7; int tok;
          if (SWA) tok = min(max(base + k, 0), SEQ - 1); else tok = min(base + (k >> 6), 63) * 64 + (k & 63);
          st.k[i] = *(const u32x4*)(Kp + (size_t)(tb + tok) * KLD + kcol + 8 * c); }
        { const int kb = idx >> 6, d = idx & 63; int tok;
          if (SWA) tok = min(max(base + 8 * kb, 0), SEQ - 8); else tok = min(base + (kb >> 3), 63) * 64 + 8 * (kb & 7);
          st.v[i] = *(const u32x4*)(VT + ((size_t)((tb + tok) >> 3) * KLD + kcol + d) * 8); }
    }
}
template <bool SWA>
__device__ __forceinline__ void att_store(LAS unsigned char* lds, int tid, const AttStage<SWA>& st) {
    constexpr int NCH = SWA ? 6 : 9;
#pragma unroll
    for (int i = 0; i < NCH; ++i) {
        const int idx = tid + 512 * i, k = idx >> 3, c = idx & 7;
        *(LAS u32x4*)(lds + k * 128 + ((c ^ ((k >> 1) & 7)) << 4)) = st.k[i];
        *(LAS u32x4*)(lds + ATT_VOFF + ((idx & ~63) + att_vpos(idx & 63)) * 16) = st.v[i];
    }
}

struct AttQZ { bf16x8 q0, q1; u32x4 z[2]; };
template <bool SWA>
__device__ __forceinline__ void att_load_qz(const AttnP& P, int lane, int tb, int qpos0, int hq, AttQZ& o) {
    const int li = lane & 15, fq = lane >> 4;
    const bf16_t* Q = SWA ? P.QB : P.QA; const bf16_t* Z = SWA ? P.ZB : P.ZA;
    const bf16_t* qrow = Q + (size_t)(tb + qpos0 + li) * 512 + hq * 64 + 8 * fq;
    o.q0 = *(const bf16x8*)qrow; o.q1 = *(const bf16x8*)(qrow + 32);
    const bf16_t* zrow = Z + (size_t)(tb + qpos0 + li) * 512 + hq * 64 + 8 * fq;
#pragma unroll
    for (int hh = 0; hh < 2; ++hh) o.z[hh] = *(const u32x4*)(zrow + 32 * hh);
}
template <bool SWA, bool FAST>
__device__ __forceinline__ void att_tile(const AttnP& P, LAS unsigned char* lds, int lane, int tb, int qpos0, int hq, int kloc0, int r, int ct, int kr0, int kc0, const AttQZ& qz, float shift) {
    constexpr int NSEG = SWA ? 9 : 8, KMAX = SWA ? 383 : 575;
    const int li = lane & 15, fq = lane >> 4;
    const bf16x8 bq0 = qz.q0, bq1 = qz.q1;
    f32x4 sc[NSEG][2];
    constexpr int GS = SWA ? 3 : 2;
    const int krow0 = (SWA ? kloc0 : kc0) + li, ksw = (krow0 >> 1) & 7;
    const LAS unsigned char* kb0 = lds + krow0 * 128 + ((fq ^ ksw) << 4);
    const LAS unsigned char* kb1 = lds + krow0 * 128 + (((fq + 4) ^ ksw) << 4);
#pragma unroll
    for (int s0 = 0; s0 < NSEG; s0 += GS) {
        bf16x8 kf[GS][2][2];
#pragma unroll
        for (int g = 0; g < GS; ++g)
#pragma unroll
            for (int kt = 0; kt < 2; ++kt) { const int s = s0 + g;
                const int segoff = SWA ? (32 * s + 16 * kt) * 128 : (((kr0 + s) % 9) * 64 + 16 * kt) * 128;
                kf[g][kt][0] = *(const LAS bf16x8*)(kb0 + segoff); kf[g][kt][1] = *(const LAS bf16x8*)(kb1 + segoff); }
        __builtin_amdgcn_sched_barrier(0);
        __builtin_amdgcn_s_setprio(1);
#pragma unroll
        for (int g = 0; g < GS; ++g)
#pragma unroll
            for (int kt = 0; kt < 2; ++kt) {
                f32x4 z = FAST ? (f32x4){-shift, -shift, -shift, -shift} : (f32x4){0.f, 0.f, 0.f, 0.f};
                z = __builtin_amdgcn_mfma_f32_16x16x32_bf16(kf[g][kt][0], bq0, z, 0, 0, 0);
                z = __builtin_amdgcn_mfma_f32_16x16x32_bf16(kf[g][kt][1], bq1, z, 0, 0, 0);
                sc[s0 + g][kt] = z; }
        __builtin_amdgcn_s_setprio(0);
        __builtin_amdgcn_sched_barrier(0);
    }
    float mx = -1e30f;
    if (SWA) {
        const int qp = qpos0 + li;
#pragma unroll
        for (int s = 0; s < NSEG; ++s) {
            const int kb0 = qpos0 - 128 + 32 * s;
            if (s >= 1 && s <= 7 && kb0 >= 0 && kb0 + 31 < SEQ) {
#pragma unroll
                for (int kt = 0; kt < 2; ++kt)
#pragma unroll
                    for (int j = 0; j < 4; ++j) { if (!FAST) mx = fmaxf(mx, sc[s][kt][j]); }
            } else {
                asm volatile("");
#pragma unroll
                for (int kt = 0; kt < 2; ++kt)
#pragma unroll
                    for (int j = 0; j < 4; ++j) { const int kp = kb0 + 16 * kt + 4 * fq + j; const int d = kp - qp;
                        const bool ok = (kp >= 0) && (kp < SEQ) && (d <= 128) && (d >= -128);
                        const float v = ok ? sc[s][kt][j] : -1e30f; sc[s][kt][j] = v; if (!FAST) mx = fmaxf(mx, v); }
            }
        }
    } else if (!FAST) {
        const int c = 16 * ct + li, cs = min(max(c - 8, 0), 48);
        const LAS float* rp = (const LAS float*)(lds + ATT_RPB) + (kr0 - r + 7) * 64 + (kc0 + 4 * fq - c + 31);
#pragma unroll
        for (int s = 0; s < NSEG; ++s) {
            float bias[2][4];
#pragma unroll
            for (int kt = 0; kt < 2; ++kt)
#pragma unroll
                for (int j = 0; j < 4; ++j) bias[kt][j] = rp[s * 64 + 16 * kt + j];
#pragma unroll
            for (int kt = 0; kt < 2; ++kt)
#pragma unroll
                for (int j = 0; j < 4; ++j) { const int kc = kc0 + 16 * kt + 4 * fq + j; const bool ok = (kc >= cs) && (kc < cs + 16);
                    float t = sc[s][kt][j] + bias[kt][j]; asm volatile("" : "+v"(t));
                    const float v = ok ? t : -1e30f; sc[s][kt][j] = v; if (!FAST) mx = fmaxf(mx, v); }
        }
    }
    if (!FAST) { mx = fmaxf(mx, __shfl_xor(mx, 16)); mx = fmaxf(mx, __shfl_xor(mx, 32)); }
    float sk = 0.f;
    if (SWA) { sk = P.sink[hq] * LOG2E; if (!FAST) mx = fmaxf(mx, sk); }
    float l = 0.f; f32x2_t l2 = {0.f, 0.f};
    bf16x8 pb[NSEG];
    if constexpr (!SWA && FAST) {
        const int c = 16 * ct + li, cs = min(max(c - 8, 0), 48), w = cs - kc0;
        const LAS float* rp = (const LAS float*)(lds + ATT_RPB) + (kr0 - r + 7) * 64 + (kc0 + 4 * fq - c + 31);
        bool hi[4]; const LAS float* rpj[4];
#pragma unroll
        for (int j = 0; j < 4; ++j) { hi[j] = (4 * fq + j) < w; rpj[j] = rp + (hi[j] ? 16 : 0) + j; }
        const unsigned m01 = (hi[0] ? 0u : 0xffffu) | (hi[1] ? 0u : 0xffff0000u), m23 = (hi[2] ? 0u : 0xffffu) | (hi[3] ? 0u : 0xffff0000u);
#pragma unroll
        for (int s = 0; s < NSEG; ++s) {
            float p[4];
#pragma unroll
            for (int j = 0; j < 4; ++j) { const float v = hi[j] ? sc[s][1][j] : sc[s][0][j]; p[j] = __builtin_amdgcn_exp2f(v + rpj[j][s * 64]); }
            l2 += (f32x2_t){p[0], p[1]}; l2 += (f32x2_t){p[2], p[3]};
            const unsigned pk01 = cvt_pk_bf16(p[0], p[1]), pk23 = cvt_pk_bf16(p[2], p[3]);
            u32x4 wv; wv.x = pk01 & m01; wv.y = pk23 & m23; wv.z = pk01 & ~m01; wv.w = pk23 & ~m23;
            pb[s] = __builtin_bit_cast(bf16x8, wv);
        }
    } else
#pragma unroll
    for (int s = 0; s < NSEG; ++s) {
        float p[8];
#pragma unroll
        for (int kt = 0; kt < 2; ++kt)
#pragma unroll
            for (int j = 0; j < 4; ++j) p[4 * kt + j] = __builtin_amdgcn_exp2f(FAST ? sc[s][kt][j] : sc[s][kt][j] - mx);
#pragma unroll
        for (int e = 0; e < 8; e += 2) l2 += (f32x2_t){p[e], p[e + 1]};
        u32x4 w; w.x = cvt_pk_bf16(p[0], p[1]); w.y = cvt_pk_bf16(p[2], p[3]); w.z = cvt_pk_bf16(p[4], p[5]); w.w = cvt_pk_bf16(p[6], p[7]);
        pb[s] = __builtin_bit_cast(bf16x8, w);
    }
    l += l2[0] + l2[1];
    l += __shfl_xor(l, 16); l += __shfl_xor(l, 32);
    if (SWA) l += __builtin_amdgcn_exp2f(FAST ? sk - shift : sk - mx);
    const float rl = 1.0f / l;
    f32x4 oacc[4];
#pragma unroll
    for (int dt = 0; dt < 4; ++dt) oacc[dt] = (f32x4){0.f, 0.f, 0.f, 0.f};
    constexpr int GV = SWA ? 3 : 2;
    const int g0l = (SWA ? kloc0 : kc0) + 4 * fq;
    const LAS unsigned char* vb0 = lds + ATT_VOFF + (g0l >> 3) * 1024 + li * 16 + (g0l & 7) * 2;
#pragma unroll
    for (int s0 = 0; s0 < NSEG; s0 += GV) {
        u32x2 vf[GV][4][2];
#pragma unroll
        for (int g = 0; g < GV; ++g) { const int s = s0 + g;
            const int segv = SWA ? s * 4096 : ((kr0 + s) % 9) * 8192;
#pragma unroll
            for (int dt = 0; dt < 4; ++dt) {
                vf[g][dt][0] = *(const LAS u32x2*)(vb0 + segv + dt * 256); asm volatile("" ::: "memory");
                vf[g][dt][1] = *(const LAS u32x2*)(vb0 + segv + dt * 256 + 2048); asm volatile("" ::: "memory"); } }
        __builtin_amdgcn_sched_barrier(0);
        __builtin_amdgcn_s_setprio(1);
#pragma unroll
        for (int g = 0; g < GV; ++g)
#pragma unroll
            for (int dt = 0; dt < 4; ++dt) {
                u32x4 w; w.x = vf[g][dt][0].x; w.y = vf[g][dt][0].y; w.z = vf[g][dt][1].x; w.w = vf[g][dt][1].y;
                oacc[dt] = __builtin_amdgcn_mfma_f32_16x16x32_bf16(__builtin_bit_cast(bf16x8, w), pb[s0 + g], oacc[dt], 0, 0, 0); }
        __builtin_amdgcn_s_setprio(0);
        __builtin_amdgcn_sched_barrier(0);
    }
    const size_t tq = (size_t)(tb + qpos0 + li);
#pragma unroll
    for (int hh = 0; hh < 2; ++hh) {
        const u32x4 z = qz.z[hh]; const f32x4 a = oacc[2 * hh], b = oacc[2 * hh + 1];
        u32x4 o; o.x = cvt_pk_bf16(a[0] * rl * bf_lo(z.x), a[1] * rl * bf_hi(z.x)); o.y = cvt_pk_bf16(a[2] * rl * bf_lo(z.y), a[3] * rl * bf_hi(z.y));
        o.z = cvt_pk_bf16(b[0] * rl * bf_lo(z.z), b[1] * rl * bf_hi(z.z)); o.w = cvt_pk_bf16(b[2] * rl * bf_lo(z.w), b[3] * rl * bf_hi(z.w));
        *(u32x4*)(P.Y + tq * 1024 + (SWA ? 512 : 0) + hq * 64 + 32 * hh + 8 * fq) = o;
    }
}

template <bool SWA>
__device__ __forceinline__ void att_phase(const AttnP& P, LAS unsigned char* lds, int tid, int wave, int lane, bool fast, float shift, AttStage<SWA>& st, AttQZ& qzn, bool pre) {
    constexpr int NITEMS = SWA ? 768 : 3072;
    int item = blockIdx.x;
#define ATT_QPOS(x) (SWA ? 128 * (x) + 16 * wave : (2 * (x) + (wave >> 2)) * 64 + 16 * (wave & 3))
    if (!pre && item < NITEMS) { int b, h, x; att_decode<SWA>(item, b, h, x); att_load<SWA>(P, item, tid, st); att_load_qz<SWA>(P, lane, b * SEQ, ATT_QPOS(x), SWA ? 4 * h : h, qzn); }
    for (; item < NITEMS; item += gridDim.x) {
        int b, h, x; att_decode<SWA>(item, b, h, x);
        att_store<SWA>(lds, tid, st);
        if (!SWA) { if (tid < 465) ((LAS float*)(lds + ATT_RPB))[tid] = P.rpb[h * 465 + tid] * LOG2E; }
        __syncthreads();
        const int nitem = item + (int)gridDim.x; const bool has_next = nitem < NITEMS;
        int nb = 0, nh = 0, nx = 0; if (has_next) { att_decode<SWA>(nitem, nb, nh, nx); att_load<SWA>(P, nitem, tid, st); }
        const int tb = b * SEQ;
        if (SWA) {
#pragma unroll 1
            for (int j = 0; j < 4; ++j) { int kl = 16 * wave; asm volatile("" : "+v"(kl));
                const AttQZ qz = qzn;
                if (j < 3) att_load_qz<true>(P, lane, tb, ATT_QPOS(x), 4 * h + j + 1, qzn);
                else if (has_next) att_load_qz<true>(P, lane, nb * SEQ, ATT_QPOS(nx), 4 * nh, qzn);
                if (fast) att_tile<true, true>(P, lds, lane, tb, 128 * x + 16 * wave, 4 * h + j, kl, 0, 0, 0, 0, qz, shift);
                else att_tile<true, false>(P, lds, lane, tb, 128 * x + 16 * wave, 4 * h + j, kl, 0, 0, 0, 0, qz, 0.f); }
        } else {
            const AttQZ qz = qzn;
            if (has_next) att_load_qz<false>(P, lane, nb * SEQ, ATT_QPOS(nx), nh, qzn);
            const int basee = min(max(2 * x - 4, 0), 56), r = 2 * x + (wave >> 2), ct = wave & 3, kr0 = min(max(r - 4, 0), 56);
            const int kc0 = ct == 0 ? 0 : (ct == 1 ? 8 : (ct == 2 ? 24 : 32));
            att_tile<false, false>(P, lds, lane, tb, r * 64 + 16 * ct, h, (kr0 - basee) * 64 + kc0, r, ct, kr0, kc0, qz, 0.f);
        }
        __syncthreads();
    }
#undef ATT_QPOS
}


struct NaStep { int b, h, rp, first, nrows; bool full; };
__device__ __forceinline__ NaStep na_step(int t, int spw, int c) {
    NaStep o; const int g = c * spw + t, bh = g >> 5; o.rp = g & 31; o.h = bh & 7; o.b = bh >> 3;
    const int base = min(max(2 * o.rp - 4, 0), 56);
    o.full = (t == 0) || (o.rp == 0);
    if (o.full) { o.first = base; o.nrows = 9; }
    else { const int pb = min(max(2 * o.rp - 6, 0), 56); o.first = pb + 9; o.nrows = base - pb; }
    return o;
}
__device__ __forceinline__ void na_load(const AttnP& P, const NaStep& st, int tid, AttStage<false>& r) {
    const int tb = st.b * SEQ, kcol = st.h * 64;
#pragma unroll
    for (int i = 0; i < 9; ++i) if (i < st.nrows) {
        const int row = min(st.first + i, 63);
        r.k[i] = *(const u32x4*)(P.KA + (size_t)(tb + row * 64 + (tid >> 3)) * 512 + kcol + 8 * (tid & 7));
        r.v[i] = *(const u32x4*)(P.VAT + ((size_t)((tb + row * 64) >> 3) + (tid >> 6)) * 4096 + (size_t)(kcol + (tid & 63)) * 8);
    }
}
__device__ __forceinline__ void na_store(LAS unsigned char* lds, const NaStep& st, int tid, const AttStage<false>& r) {
#pragma unroll
    for (int i = 0; i < 9; ++i) if (i < st.nrows) {
        const int slot = (st.first + i) % 9, k = slot * 64 + (tid >> 3), c = tid & 7;
        *(LAS u32x4*)(lds + k * 128 + ((c ^ ((k >> 1) & 7)) << 4)) = r.k[i];
        *(LAS u32x4*)(lds + ATT_VOFF + (slot * 8 + (tid >> 6)) * 1024 + att_vpos(tid & 63) * 16) = r.v[i];
    }
}
__device__ __forceinline__ void na_phase(const AttnP& P, LAS unsigned char* lds, int tid, int wave, int lane, bool fast, float shift, AttStage<true>& swa_st, AttQZ& swa_qz) {
    const int G = gridDim.x, c = blockIdx.x;
    const int spw = (3072 + G - 1) / G;
    const int nsteps = min(spw, max(3072 - c * spw, 0));
    AttStage<false> rg; AttQZ qzn;
    if (nsteps > 0) { const NaStep s0 = na_step(0, spw, c); na_load(P, s0, tid, rg); att_load_qz<false>(P, lane, s0.b * SEQ, (2 * s0.rp + (wave >> 2)) * 64 + 16 * (wave & 3), s0.h, qzn); }
#define NA_STEP(T, ...) do { \
        const NaStep st = na_step((T), spw, c); \
        na_store(lds, st, tid, rg); \
        if (st.full) {        \
            _Pragma("unroll") for (int i = 0; i < 2; ++i) { const int e = tid + 512 * i, row = e >> 6, dc = (e & 63) - 16; \
                if (e < 960) ((LAS float*)(lds + ATT_RPB))[e] = (dc >= 0 && dc <= 30) ? P.rpb[st.h * 465 + row * 31 + dc] * LOG2E : 0.f; } } \
        __syncthreads(); \
        const AttQZ qz = qzn; \
        __VA_ARGS__; \
        const int r = 2 * st.rp + (wave >> 2), ct = wave & 3, kr0 = min(max(r - 4, 0), 56); \
        const int kc0 = ct == 0 ? 0 : (ct == 1 ? 8 : (ct == 2 ? 24 : 32)); \
        if (fast) att_tile<false, true>(P, lds, lane, st.b * SEQ, r * 64 + 16 * ct, st.h, 0, r, ct, kr0, kc0, qz, shift); \
        else att_tile<false, false>(P, lds, lane, st.b * SEQ, r * 64 + 16 * ct, st.h, 0, r, ct, kr0, kc0, qz, 0.f); \
        __syncthreads(); } while (0)
    for (int t = 0; t + 1 < nsteps; ++t)
        NA_STEP(t, { const NaStep sn = na_step(t + 1, spw, c); na_load(P, sn, tid, rg); att_load_qz<false>(P, lane, sn.b * SEQ, (2 * sn.rp + (wave >> 2)) * 64 + 16 * (wave & 3), sn.h, qzn); });
    if (nsteps > 0)
        NA_STEP(nsteps - 1, { if (c < 768) { int sb, sh, sx; att_decode<true>(c, sb, sh, sx); att_load<true>(P, c, tid, swa_st); att_load_qz<true>(P, lane, sb * SEQ, 128 * sx + 16 * wave, 4 * sh, swa_qz); } });
#undef NA_STEP
}

#define XB_TMO      128
#define XB_XCNT(j)  (256  + 64 * (j))
#define XB_XSUB(j)  (1280 + 64 * (j))
#define XB_XGEN(j)  (2304 + 64 * (j))
#define XB_TOP      3328
#define XB_TOPGEN   3392
#define XCD_BAR_WORDS 3456
#define XB_SPIN_CAP (1u << 18)
__device__ __forceinline__ unsigned xb_ld(unsigned* p)              { return __hip_atomic_load(p, __ATOMIC_RELAXED, __HIP_MEMORY_SCOPE_AGENT); }
__device__ __forceinline__ unsigned xb_add(unsigned* p, unsigned v) { return __hip_atomic_fetch_add(p, v, __ATOMIC_RELAXED, __HIP_MEMORY_SCOPE_AGENT); }
__device__ __forceinline__ unsigned xb_xcc_id() { return (unsigned)__builtin_amdgcn_s_getreg((3 << 11) | 20) & 0xFu; }
#define XB_SPIN(cond, bar) do { unsigned _sp = 0; while (cond) { __builtin_amdgcn_s_sleep(1); \
    if ((++_sp & 255u) == 0u) { if (xb_ld(&(bar)[XB_TMO])) break; if (_sp > XB_SPIN_CAP) { atomicAdd(&(bar)[XB_TMO], 1u); break; } } } } while (0)
struct XcdBarrier { unsigned* bar; unsigned x; volatile LAS unsigned* st; };
__device__ __forceinline__ XcdBarrier xcd_barrier_post(unsigned* bar, volatile LAS unsigned* st) {
    XcdBarrier b; b.bar = bar; b.x = xb_xcc_id(); b.st = st;
    if (threadIdx.x == 0) (void)xb_add(&bar[XB_XCNT(b.x)], 1u);
    return b;
}
__device__ __forceinline__ void xcd_barrier_complete(unsigned* bar, unsigned x, unsigned& nloc, unsigned& nx) {
    const unsigned G = gridDim.x * gridDim.y * gridDim.z;
    unsigned sum, cnt, mine, sp = 0u;
    for (;;) {
        sum = 0u; cnt = 0u; mine = 0u;
#pragma unroll
        for (unsigned j = 0; j < 16; ++j) { const unsigned c = xb_ld(&bar[XB_XCNT(j)]); sum += c; cnt += (c > 0u) ? 1u : 0u; mine = (j == x) ? c : mine; }
        if (sum == G) break;
        __builtin_amdgcn_s_sleep(1);
        if ((++sp & 255u) == 0u) { if (xb_ld(&bar[XB_TMO])) break; if (sp > XB_SPIN_CAP) { atomicAdd(&bar[XB_TMO], 1u); break; } }
    }
    nloc = mine > 0u ? mine : 1u; nx = cnt > 0u ? cnt : 1u;
}
__device__ __forceinline__ void xcd_barrier(const XcdBarrier& b) {
    asm volatile("s_waitcnt vmcnt(0)" ::: "memory");
    __syncthreads();
    if (threadIdx.x == 0) {
        unsigned* bar = b.bar;
        __builtin_amdgcn_s_waitcnt(0);
        unsigned nloc = b.st[0], nx = b.st[1];
        if (nloc == 0u) { xcd_barrier_complete(bar, b.x, nloc, nx); b.st[0] = nloc; b.st[1] = nx; }
        const unsigned old = xb_add(&bar[XB_XSUB(b.x)], 1u);
        const unsigned gen = old / nloc;
        if (old + 1u == (gen + 1u) * nloc) {
            __builtin_amdgcn_fence(__ATOMIC_RELEASE, "agent");
            asm volatile("s_waitcnt vmcnt(0)" ::: "memory");
            const unsigned og = xb_add(&bar[XB_TOP], 1u);
            const unsigned tg = og / nx;
            if (og + 1u == (tg + 1u) * nx) xb_add(&bar[XB_TOPGEN], 1u);
            else XB_SPIN(xb_ld(&bar[XB_TOPGEN]) == tg, bar);
            __builtin_amdgcn_fence(__ATOMIC_ACQUIRE, "agent");
            xb_add(&bar[XB_XGEN(b.x)], 1u);
            asm volatile("s_waitcnt vmcnt(0)" ::: "memory");
        } else {
            XB_SPIN(xb_ld(&bar[XB_XGEN(b.x)]) == gen, bar);
            __builtin_amdgcn_fence(__ATOMIC_ACQUIRE, "agent");
            asm volatile("s_waitcnt vmcnt(0)" ::: "memory");
        }
    }
    __syncthreads();
}

__global__ void __launch_bounds__(512, 2) fwd_kernel(Args a) {
    extern __shared__ __attribute__((aligned(16))) unsigned char lds_raw[];
    LAS unsigned char* lds = (LAS unsigned char*)lds_raw;
    const int tid = threadIdx.x, lane = tid & 63, wave = __builtin_amdgcn_readfirstlane(tid >> 6);
    const int lo = a.ph_lo, hi = a.ph_hi;
    unsigned char* ws = a.ws;
#define IN(k) (lo <= (k) && (k) < hi)
    volatile LAS unsigned* bst = (volatile LAS unsigned*)(lds + LDS_BYTES - 64);
    if (tid == 0) { bst[0] = 0u; bst[1] = 0u; }
    __syncthreads();
    (void)xcd_barrier_post((unsigned*)(ws + WS_CTL), bst);
    if (lo == 12345) cg::this_grid().sync();
#define SEAM(k) do { if (IN(k) && IN((k) + 1)) { XcdBarrier gb_; gb_.bar = (unsigned*)(ws + WS_CTL); gb_.x = xb_xcc_id(); gb_.st = (volatile LAS unsigned*)(lds + LDS_BYTES - 64); xcd_barrier(gb_); } } while (0)
    if (IN(0)) { p0_prologue(a, lds, wave, lane); }
    SEAM(0);
    if (IN(1)) {
        SchedA S; S.init(T, NIN, gridDim.x, blockIdx.x); S.XB = (const char*)(ws + WS_XB); S.W = (const char*)(ws + WS_WIN);
        EpiA E; E.ws = ws; E.GA = (bf16_t*)a.out;
        E.qn_a = a.in[4]; E.kn_a = a.in[5]; E.qn_b = a.in[7]; E.kn_b = a.in[8];
        pg8::gemm_phase<EpiA, SchedA>(lds, S, E);
    }
    SEAM(1);
    if (IN(2)) {
        AttnP P; P.QA = (const bf16_t*)(ws + WS_QA); P.KA = (const bf16_t*)(ws + WS_KA); P.VAT = (const bf16_t*)(ws + WS_VAT); P.ZA = (const bf16_t*)(ws + WS_ZA);
        P.QB = (const bf16_t*)(ws + WS_QB); P.KB = (const bf16_t*)(ws + WS_KB); P.VBT = (const bf16_t*)(ws + WS_VBT); P.ZB = (const bf16_t*)(ws + WS_ZB);
        P.Y = (bf16_t*)(ws + WS_Y); P.sink = a.in[9]; P.rpb = a.in[6];
        float shiftA, shiftB; bool fast;
        { float mqa = fabsf(a.in[4][lane]), mka = fabsf(a.in[5][lane]), mqb = fabsf(a.in[7][lane]), mkb = fabsf(a.in[8][lane]), msk = fabsf(a.in[9][lane & 7]), mr = 0.f;
          for (int i = tid; i < 8 * 465; i += 512) mr = fmaxf(mr, fabsf(a.in[6][i]));
#pragma unroll
          for (int o = 1; o < 64; o <<= 1) { mqa = fmaxf(mqa, __shfl_xor(mqa, o)); mka = fmaxf(mka, __shfl_xor(mka, o)); mqb = fmaxf(mqb, __shfl_xor(mqb, o)); mkb = fmaxf(mkb, __shfl_xor(mkb, o));
              msk = fmaxf(msk, __shfl_xor(msk, o)); mr = fmaxf(mr, __shfl_xor(mr, o)); }
          LAS float* red = (LAS float*)(lds + ATT_RPB);
          if (lane == 0) red[wave] = mr;
          __syncthreads();
          mr = red[0];
#pragma unroll
          for (int w = 1; w < 8; ++w) mr = fmaxf(mr, red[w]);
          __syncthreads();
          shiftA = 1.02f * (64.f * mqa * mka * QSCALE + mr * LOG2E) + 0.5f; shiftB = 1.02f * (64.f * mqb * mkb * QSCALE) + 0.5f;
          fast = (shiftA < 60.f) && (shiftB < 60.f) && (msk * LOG2E < 60.f); }
        AttStage<true> swa_st; AttQZ swa_qz;
        const bool pre = ((3072 + (int)gridDim.x - 1) / (int)gridDim.x) * (int)blockIdx.x < 3072;
        na_phase(P, lds, tid, wave, lane, fast, shiftA, swa_st, swa_qz);
        att_phase<true>(P, lds, tid, wave, lane, fast, shiftB, swa_st, swa_qz, pre);
    }
    SEAM(2);
    if (IN(3)) {
        SchedP S; S.init(T, 1024, gridDim.x, blockIdx.x); S.A = (const char*)(ws + WS_Y); S.W = (const char*)(ws + WS_WAB);
        EpiC1 E; E.GA = (const bf16_t*)a.out; E.GB = (const bf16_t*)a.out + (size_t)T * 1024; E.MG = (bf16_t*)(ws + WS_MG);
        pg8::gemm_phase<EpiC1, SchedP>(lds, S, E);
    }
    SEAM(3);
    if (IN(4)) {
        SchedP S; S.init(T, 1024, gridDim.x, blockIdx.x); S.A = (const char*)(ws + WS_MG); S.W = (const char*)(ws + WS_WO);
        EpiC2 E; E.xp = a.in[0]; E.xs = a.in[1]; E.out = a.out;
        pg8::gemm_phase<EpiC2, SchedP>(lds, S, E, true);
    }
#undef IN
#undef SEAM
}

extern "C" void kernel_launch(void* const* d_in, const int* in_sizes, int n_in, void* d_out, int out_size, void* d_ws, size_t ws_size, hipStream_t stream) {
    static int grid = 0;
    if (grid == 0) {
        if (n_in != 13 || out_size != T * D || ws_size < WS_END) { fprintf(stderr, "kernel_launch: unexpected shapes (n_in %d out %d ws %zu)\n", n_in, out_size, ws_size); grid = -1; return; }
        int dev = 0, cus = 0;
        if (hipGetDevice(&dev) != hipSuccess || hipDeviceGetAttribute(&cus, hipDeviceAttributeMultiprocessorCount, dev) != hipSuccess) { grid = -1; return; }
        if (hipFuncSetAttribute((const void*)fwd_kernel, hipFuncAttributeMaxDynamicSharedMemorySize, LDS_BYTES) != hipSuccess) { fprintf(stderr, "kernel_launch: hipFuncSetAttribute failed\n"); grid = -1; return; }
        int per_cu = 0;
        if (hipOccupancyMaxActiveBlocksPerMultiprocessor(&per_cu, (const void*)fwd_kernel, 512, LDS_BYTES) != hipSuccess || per_cu < 1) fprintf(stderr, "kernel_launch: occupancy query says %d\n", per_cu);
        (void)hipGetLastError();
        grid = cus;
    }
    if (grid < 0) return;
    hipMemsetAsync((char*)d_ws + WS_CTL, 0, CTL_BYTES, stream);
    Args a{};
    for (int i = 0; i < 13; ++i) a.in[i] = (const float*)d_in[i];
    a.out = (float*)d_out; a.ws = (unsigned char*)d_ws;
    if (N_LAUNCHES == 1) {
        a.ph_lo = 0; a.ph_hi = 5;
        void* args[] = {&a};
        hipError_t e = hipLaunchCooperativeKernel((const void*)fwd_kernel, dim3(grid), dim3(512), args, LDS_BYTES, stream);
        if (e != hipSuccess) fprintf(stderr, "cooperative launch failed: %s (grid %d)\n", hipGetErrorString(e), grid);
    } else {
        for (int p = 0; p < 5; ++p) {
            a.ph_lo = p; a.ph_hi = p + 1; hipLaunchKernelGGL(fwd_kernel, dim3(grid), dim3(512), LDS_BYTES, stream, a); }
    }
}
```

```cpp
#include <hip/hip_runtime.h>
#include <hip/hip_cooperative_groups.h>
#include <cstdio>
namespace cg = cooperative_groups;

#ifndef N_LAUNCHES
#define N_LAUNCHES 1
#endif

#define LAS __attribute__((address_space(3)))
typedef unsigned short bf16_t;
typedef short bf16x8 __attribute__((ext_vector_type(8)));
typedef short bf16x4 __attribute__((ext_vector_type(4)));
typedef float f32x4 __attribute__((ext_vector_type(4)));
typedef unsigned u32x4 __attribute__((ext_vector_type(4)));
typedef unsigned u32x2 __attribute__((ext_vector_type(2)));

constexpr int T = 49152, TP = 32768, D = 1024, NIN = 5376, SEQ = 4096;
constexpr float LOG2E = 1.4426950408889634f;
constexpr float QSCALE = 0.125f * LOG2E;
constexpr float NORM_EPS = 1e-6f;
constexpr size_t MiB = 1u << 20;
constexpr size_t WS_WIN = 0, WS_WAB = 11 * MiB, WS_WO = 13 * MiB, WS_ROPE = 15 * MiB, WS_XB = 17 * MiB, WS_QA = 113 * MiB, WS_KA = 161 * MiB, WS_QB = 209 * MiB,
                 WS_ZA = 257 * MiB, WS_ZB = 305 * MiB, WS_VAT = 353 * MiB, WS_KB = 401 * MiB, WS_VBT = 413 * MiB, WS_END = 425 * MiB;
constexpr size_t WS_CTL = 11 * MiB - 65536, CTL_BYTES = 16384;
constexpr size_t WS_Y = WS_XB;
constexpr size_t WS_MG = WS_QA;
constexpr int LDS_BYTES = 155648;

typedef __bf16 bf16x2_t __attribute__((ext_vector_type(2)));
typedef float f32x2_t __attribute__((ext_vector_type(2)));
__device__ __forceinline__ unsigned cvt_pk_bf16(float lo, float hi) { const f32x2_t v = {lo, hi}; const bf16x2_t r = __builtin_convertvector(v, bf16x2_t); return __builtin_bit_cast(unsigned, r); }
__device__ __forceinline__ float bf_lo(unsigned w) { return __uint_as_float(w << 16); }
__device__ __forceinline__ float bf_hi(unsigned w) { return __uint_as_float(w & 0xffff0000u); }
__device__ __forceinline__ float fast_sigmoid(float v) { return __builtin_amdgcn_rcpf(1.0f + __builtin_amdgcn_exp2f(-v * LOG2E)); }

namespace pg8 {
constexpr int BM = 256, BK = 64, HALF = 128, HTB = HALF * BK * 2, STAGE_BYTES = 8 * HTB, NXCD = 8, WGM = 4, K = 1024;
__device__ __forceinline__ int lds_byte(int r, int c) { const int st = (r >> 4) * 2 + (c >> 5), rr = r & 15, cc = c & 31, ob = rr * 64 + cc * 2; return st * 1024 + (ob ^ (((ob >> 9) & 1) << 5)); }
__device__ __forceinline__ void stage_rc(int b, int& R, int& C) { const int st = b / 1024, sb = b % 1024, swz = sb ^ (((sb >> 9) & 1) << 5); R = (st >> 1) * 16 + swz / 64; C = (st & 1) * 32 + (swz % 64) / 2; }
__device__ __forceinline__ int perm32(int rho) { const int n = rho >> 4, i = rho & 15; return 8 * (i >> 2) + 4 * n + (i & 3); }
struct Unit { int pm, pn; };
struct StaticOrder {
    int nM, nN, nwg, G, c;
    __device__ void init(int M, int N, int G_, int c_) { nM = M / BM; nN = N / BM; nwg = nM * nN; G = G_; c = c_; }
    __device__ bool next(int i, Unit& u) const {
        const long L = (long)i * G + c; if (L >= nwg) return false;
        int wgid = (int)L; { const int q = nwg / NXCD, r = nwg % NXCD, xcd = wgid % NXCD, off = wgid / NXCD; wgid = (xcd < r ? xcd * (q + 1) : r * (q + 1) + (xcd - r) * q) + off; }
        const int nig = WGM * nN, gid = wgid / nig, fm = gid * WGM, gsz = (nM - fm) < WGM ? (nM - fm) : WGM;
        u.pm = fm + ((wgid % nig) % gsz); u.pn = (wgid % nig) / gsz; return true;
    }
};
template <class Epi, class Sched>
__device__ __forceinline__ void gemm_phase(LAS unsigned char* lds, const Sched& S, const Epi& E, bool natural = false) {
    const int tid = threadIdx.x, wid = __builtin_amdgcn_readfirstlane(tid >> 6), lane = tid & 63, wr = wid >> 2, wc = wid & 3, fr = lane & 15, fq = lane >> 4;
    constexpr int nt = K / BK;
    unsigned voffA[2], voffB0[2], voffB1[2];
#pragma unroll
    for (int i = 0; i < 2; ++i) { int R, C; stage_rc(tid * 16 + i * 8192, R, C);
        const int Rb = 64 * (R >> 5) + (natural ? (R & 31) : perm32(R & 31));
        voffA[i] = (unsigned)(R * K + C) * 2u; voffB0[i] = (unsigned)(Rb * K + C) * 2u; voffB1[i] = (unsigned)((Rb + 32) * K + C) * 2u; }
    constexpr size_t kstep = (size_t)(BK * 2);
    constexpr size_t hstep = (size_t)HALF * K * 2;
    const unsigned ldsw = (unsigned)wid * 1024u;
    const int aoff = lds_byte(wr * 64 + fr, fq * 8), boff = lds_byte(wc * 32 + fr, fq * 8);
#define PG8_SA(b, h) (((b) * 2 + (h)) * HTB)
#define PG8_SB(b, h) ((4 + (b) * 2 + (h)) * HTB)
#define PG8_STAGE(bufoff, gbase, voff) do { _Pragma("unroll") for (int _i = 0; _i < 2; ++_i) \
        __builtin_amdgcn_global_load_lds((const unsigned*)((const char*)(gbase) + (voff)[_i]), (LAS unsigned*)(lds + (bufoff) + ldsw + _i * 8192), 16, 0, 0); } while (0)
#define PG8_LDA(dst, b, h) do { _Pragma("unroll") for (int m = 0; m < 4; ++m) _Pragma("unroll") for (int k = 0; k < 2; ++k) dst[m][k] = *(const LAS bf16x8*)(lds + PG8_SA(b, h) + aoff + m * 2048 + k * 1024); } while (0)
#define PG8_LDB(dst, b, h) do { _Pragma("unroll") for (int n = 0; n < 2; ++n) _Pragma("unroll") for (int k = 0; k < 2; ++k) dst[n][k] = *(const LAS bf16x8*)(lds + PG8_SB(b, h) + boff + n * 2048 + k * 1024); } while (0)
#define PG8_MMA(ai, bj, At, Bt) do { __builtin_amdgcn_s_setprio(1); _Pragma("unroll") for (int m = 0; m < 4; ++m) _Pragma("unroll") for (int n = 0; n < 2; ++n) _Pragma("unroll") for (int k = 0; k < 2; ++k) \
        acc[ai][bj][m][n] = __builtin_amdgcn_mfma_f32_16x16x32_bf16(Bt[n][k], At[m][k], acc[ai][bj][m][n], 0, 0, 0); __builtin_amdgcn_s_setprio(0); } while (0)
#define PG8_WAIT_V(n) asm volatile("s_waitcnt vmcnt(" #n ")" ::: "memory")
#define PG8_WAIT_L(n) asm volatile("s_waitcnt lgkmcnt(" #n ")" ::: "memory")
#define PG8_BAR __builtin_amdgcn_s_barrier()
#define PG8_SCHED __builtin_amdgcn_sched_barrier(0)
    Unit cur, nxt; int ui = 0;
    if (!S.next(0, cur)) return;
    f32x4 acc[2][2][4][2];
#pragma unroll
    for (int a = 0; a < 2; ++a)
#pragma unroll
        for (int b = 0; b < 2; ++b)
#pragma unroll
            for (int m = 0; m < 4; ++m)
#pragma unroll
                for (int n = 0; n < 2; ++n) acc[a][b][m][n] = (f32x4){0.f, 0.f, 0.f, 0.f};
    bf16x8 At[4][2], B0[2][2], B1[2][2];
    const char* cA; const char* cB; S.ptrs(cur, cA, cB);
    PG8_STAGE(PG8_SB(0, 0), cB, voffB0); PG8_STAGE(PG8_SB(0, 1), cB, voffB1); PG8_STAGE(PG8_SA(0, 0), cA, voffA); PG8_STAGE(PG8_SA(0, 1), cA + hstep, voffA);
    if (wr == 1) PG8_BAR;
    PG8_WAIT_V(2); PG8_BAR;
    PG8_STAGE(PG8_SB(1, 0), cB + kstep, voffB0); PG8_STAGE(PG8_SA(1, 0), cA + kstep, voffA); PG8_STAGE(PG8_SB(1, 1), cB + kstep, voffB1);
    PG8_WAIT_V(6); PG8_BAR;
    for (;;) {
        const bool has_next = S.next(ui + 1, nxt);
        const char* nA = cA; const char* nB = cB; if (has_next) S.ptrs(nxt, nA, nB);
        for (int t = 0; t < nt; t += 2) {
            const bool last = (t == nt - 2);
            const char* a1 = cA + (size_t)(t + 1) * kstep;
            const char* a2 = last ? nA : cA + (size_t)(t + 2) * kstep; const char* b2 = last ? nB : cB + (size_t)(t + 2) * kstep;
            const char* a3 = a2 + kstep; const char* b3 = b2 + kstep;
            if constexpr (Epi::MIDHOOK) { if (t == nt / 2) E.mid(acc, cur, wr, wc, fr, fq); }
            PG8_LDB(B0, 0, 0); PG8_LDB(B1, 0, 1); PG8_SCHED; PG8_LDA(At, 0, 0); PG8_STAGE(PG8_SA(1, 1), a1 + hstep, voffA);
            PG8_WAIT_V(8); PG8_WAIT_L(0); PG8_BAR; PG8_MMA(0, 0, At, B0); PG8_MMA(0, 1, At, B1); PG8_BAR; PG8_SCHED;
            PG8_LDA(At, 0, 1); PG8_STAGE(PG8_SB(0, 0), b2, voffB0); PG8_STAGE(PG8_SB(0, 1), b2, voffB1); PG8_STAGE(PG8_SA(0, 0), a2, voffA);
            PG8_WAIT_V(8); PG8_WAIT_L(0); PG8_BAR; PG8_MMA(1, 0, At, B0); PG8_MMA(1, 1, At, B1); PG8_BAR; PG8_SCHED;
            PG8_LDB(B0, 1, 0); PG8_LDB(B1, 1, 1); PG8_SCHED; PG8_LDA(At, 1, 0); PG8_STAGE(PG8_SA(0, 1), a2 + hstep, voffA);
            PG8_WAIT_V(8); PG8_WAIT_L(0); PG8_BAR; PG8_MMA(0, 0, At, B0); PG8_MMA(0, 1, At, B1); PG8_BAR; PG8_SCHED;
            PG8_LDA(At, 1, 1); PG8_STAGE(PG8_SB(1, 0), b3, voffB0); PG8_STAGE(PG8_SB(1, 1), b3, voffB1); PG8_STAGE(PG8_SA(1, 0), a3, voffA);
            PG8_WAIT_V(8); PG8_WAIT_L(0); PG8_BAR; PG8_MMA(1, 0, At, B0); PG8_MMA(1, 1, At, B1); PG8_BAR; PG8_SCHED;
        }
        if (wr == 0) PG8_BAR;
        E(acc, cur, wr, wc, fr, fq);
        if (!has_next) break;
#pragma unroll
        for (int a = 0; a < 2; ++a)
#pragma unroll
            for (int b = 0; b < 2; ++b)
#pragma unroll
                for (int m = 0; m < 4; ++m)
#pragma unroll
                    for (int n = 0; n < 2; ++n) acc[a][b][m][n] = (f32x4){0.f, 0.f, 0.f, 0.f};
        cur = nxt; cA = nA; cB = nB; ++ui;
        if (wr == 1) PG8_BAR;
    }
    PG8_WAIT_V(0);
    PG8_BAR;
#undef PG8_SA
#undef PG8_SB
#undef PG8_STAGE
#undef PG8_LDA
#undef PG8_LDB
#undef PG8_MMA
#undef PG8_WAIT_V
#undef PG8_WAIT_L
#undef PG8_BAR
#undef PG8_SCHED
}
}
using pg8::Unit;
typedef f32x4 AccT[2][2][4][2];

__device__ const float ROPE_IREV[32] = {1.591549367e-01f, 1.193493679e-01f, 8.949939907e-02f, 6.711508334e-02f, 5.032921210e-02f, 3.774158657e-02f, 2.830219641e-02f, 2.122365311e-02f,
    1.591549441e-02f, 1.193493698e-02f, 8.949940093e-03f, 6.711508147e-03f, 5.032920744e-03f, 3.774158657e-03f, 2.830219688e-03f, 2.122365171e-03f,
    1.591549371e-03f, 1.193493721e-03f, 8.949940093e-04f, 6.711508031e-04f, 5.032921326e-04f, 3.774158540e-04f, 2.830219746e-04f, 2.122365258e-04f,
    1.591549517e-04f, 1.193493663e-04f, 8.949940093e-05f, 6.711508468e-05f, 5.032921035e-05f, 3.774158540e-05f, 2.830219637e-05f, 2.122365368e-05f};
struct SchedA : pg8::StaticOrder {
    const char* XB; const char* W;
    __device__ __forceinline__ void ptrs(const Unit& u, const char*& cA, const char*& cB) const {
        const char* x = XB + (size_t)u.pm * (256 * 1024 * 2); const char* w = W + (size_t)u.pn * (256 * 1024 * 2);
        if (u.pn >= 19) { cA = w; cB = x; } else { cA = x; cB = w; }
    }
};
struct SchedP : pg8::StaticOrder {
    const char* A; const char* W;
    __device__ __forceinline__ void ptrs(const Unit& u, const char*& cA, const char*& cB) const { cA = A + (size_t)u.pm * (256 * 1024 * 2); cB = W + (size_t)u.pn * (256 * 1024 * 2); }
};

struct EpiA {
    static constexpr bool MIDHOOK = false;
    unsigned char* ws; bf16_t* GA;
    const float *qn_a, *kn_a, *qn_b, *kn_b;
    __device__ __forceinline__ void mid(AccT&, const Unit&, int, int, int, int) const {}
    __device__ __forceinline__ void qk(const AccT& acc, int row0, int wr, int fr, int fq, bf16_t* dst, int ld, int colh, const float* w, float scale, bool rope) const {
        f32x4 wv[2][2];
        int fq8 = 8 * fq; asm volatile("" : "+v"(fq8));
#pragma unroll
        for (int bj = 0; bj < 2; ++bj)
#pragma unroll
            for (int n = 0; n < 2; ++n) wv[bj][n] = *(const f32x4*)(w + 32 * bj + fq8 + 4 * n) * scale;
        f32x4 irev[2];
#pragma unroll
        for (int n = 0; n < 2; ++n) irev[n] = rope ? *(const f32x4*)(ROPE_IREV + fq8 + 4 * n) : (f32x4){0.f, 0.f, 0.f, 0.f};
#pragma unroll
        for (int ai = 0; ai < 2; ++ai)
#pragma unroll
            for (int m = 0; m < 4; ++m) {
                const int r = row0 + 128 * ai + 64 * wr + 16 * m + fr;
                f32x4 v[2][2]; float ss = 0.f;
#pragma unroll
                for (int bj = 0; bj < 2; ++bj)
#pragma unroll
                    for (int n = 0; n < 2; ++n) { v[bj][n] = acc[ai][bj][m][n]; const f32x4 x = v[bj][n]; ss += (x[0] * x[0] + x[1] * x[1]) + (x[2] * x[2] + x[3] * x[3]); }
                ss += __shfl_xor(ss, 16); ss += __shfl_xor(ss, 32);
                const float inv = __builtin_amdgcn_rsqf(ss * (1.0f / 64.0f) + NORM_EPS);
#pragma unroll
                for (int bj = 0; bj < 2; ++bj)
#pragma unroll
                    for (int n = 0; n < 2; ++n) v[bj][n] = v[bj][n] * inv * wv[bj][n];
                if (rope) {
                    const float fp = (float)(r & (SEQ - 1));
#pragma unroll
                    for (int n = 0; n < 2; ++n) {
                        f32x4 c, s;
#pragma unroll
                        for (int j = 0; j < 4; ++j) { const float fr_ = __builtin_amdgcn_fractf(fp * irev[n][j]); c[j] = __builtin_amdgcn_cosf(fr_); s[j] = __builtin_amdgcn_sinf(fr_); }
                        const f32x4 x1 = v[0][n], x2 = v[1][n];
                        v[0][n] = x1 * c - x2 * s; v[1][n] = x2 * c + x1 * s;
                    }
                }
                bf16_t* rowp = dst + (size_t)r * ld + colh + 8 * fq;
#pragma unroll
                for (int bj = 0; bj < 2; ++bj) { u32x4 o; o.x = cvt_pk_bf16(v[bj][0][0], v[bj][0][1]); o.y = cvt_pk_bf16(v[bj][0][2], v[bj][0][3]); o.z = cvt_pk_bf16(v[bj][1][0], v[bj][1][1]); o.w = cvt_pk_bf16(v[bj][1][2], v[bj][1][3]);
                    *(u32x4*)(rowp + 32 * bj) = o; }
            }
    }
    __device__ __forceinline__ void act(const AccT& acc, int row0, int wr, int wc, int fr, int fq, bf16_t* dst, int ld, int col0) const {
#pragma unroll
        for (int ai = 0; ai < 2; ++ai)
#pragma unroll
            for (int m = 0; m < 4; ++m) {
                const int r = row0 + 128 * ai + 64 * wr + 16 * m + fr;
                bf16_t* rowp = dst + (size_t)r * ld + col0 + 64 * wc + 8 * fq;
#pragma unroll
                for (int bj = 0; bj < 2; ++bj) { unsigned w[4];
#pragma unroll
                    for (int n = 0; n < 2; ++n)
#pragma unroll
                        for (int h = 0; h < 2; ++h) { const f32x2_t x = {acc[ai][bj][m][n][2 * h], acc[ai][bj][m][n][2 * h + 1]};
                            const f32x2_t t = x * (-LOG2E); f32x2_t e; e[0] = __builtin_amdgcn_exp2f(t[0]); e[1] = __builtin_amdgcn_exp2f(t[1]);
                            const f32x2_t d = e + 1.0f; f32x2_t sg; sg[0] = __builtin_amdgcn_rcpf(d[0]); sg[1] = __builtin_amdgcn_rcpf(d[1]);
                            const f32x2_t o = x * sg; w[2 * n + h] = cvt_pk_bf16(o[0], o[1]); }
                    u32x4 wv; wv.x = w[0]; wv.y = w[1]; wv.z = w[2]; wv.w = w[3];
                    *(u32x4*)(rowp + 32 * bj) = wv; }
            }
    }
    __device__ __forceinline__ void operator()(AccT& acc, const Unit& u, int wr, int wc, int fr, int fq) const {
        const int pn = u.pn, row0 = u.pm * 256;
        bf16_t* const QA = (bf16_t*)(ws + WS_QA); bf16_t* const KA = (bf16_t*)(ws + WS_KA); bf16_t* const QB = (bf16_t*)(ws + WS_QB); bf16_t* const KB = (bf16_t*)(ws + WS_KB);
        bf16_t* const VBT = (bf16_t*)(ws + WS_VBT); bf16_t* const ZA = (bf16_t*)(ws + WS_ZA); bf16_t* const ZB = (bf16_t*)(ws + WS_ZB); bf16_t* const VAT = (bf16_t*)(ws + WS_VAT);
        bf16_t* const GB = GA + (size_t)T * 1024;
        if (pn < 2) qk(acc, row0, wr, fr, fq, QA, 512, 256 * pn + 64 * wc, qn_a, QSCALE, false);
        else if (pn < 4) qk(acc, row0, wr, fr, fq, KA, 512, 256 * (pn - 2) + 64 * wc, kn_a, 1.0f, false);
        else if (pn < 6) qk(acc, row0, wr, fr, fq, QB, 512, 256 * (pn - 4) + 64 * wc, qn_b, QSCALE, true);
        else if (pn == 6) {
            if (wc < 2) qk(acc, row0, wr, fr, fq, KB, 128, 64 * wc, kn_b, 1.0f, true);
            else {
#pragma unroll
                for (int ai = 0; ai < 2; ++ai)
#pragma unroll
                    for (int m = 0; m < 4; ++m) {
                        const int r = row0 + 128 * ai + 64 * wr + 16 * m + fr;
                        bf16_t* base = VBT + ((size_t)(r >> 3) * 128 + 64 * (wc - 2) + 8 * fq) * 8 + (r & 7);
#pragma unroll
                        for (int bj = 0; bj < 2; ++bj)
#pragma unroll
                            for (int n = 0; n < 2; ++n) { const f32x4 x = acc[ai][bj][m][n];
                                const unsigned p0 = cvt_pk_bf16(x[0], x[1]), p1 = cvt_pk_bf16(x[2], x[3]);
                                bf16_t* q = base + (32 * bj + 4 * n) * 8;
                                q[0] = (bf16_t)(p0 & 0xffffu); q[8] = (bf16_t)(p0 >> 16); q[16] = (bf16_t)(p1 & 0xffffu); q[24] = (bf16_t)(p1 >> 16); }
                    }
            }
        }
        else if (pn < 9) act(acc, row0, wr, wc, fr, fq, ZA, 512, 256 * (pn - 7));
        else if (pn < 11) act(acc, row0, wr, wc, fr, fq, ZB, 512, 256 * (pn - 9));
        else if (pn < 19) {
#pragma unroll
            for (int ai = 0; ai < 2; ++ai)
#pragma unroll
                for (int m = 0; m < 4; ++m) {
                    const int r = row0 + 128 * ai + 64 * wr + 16 * m + fr;
                    unsigned Rw[4], Sw[4];
#pragma unroll
                    for (int n = 0; n < 2; ++n)
#pragma unroll
                        for (int h = 0; h < 2; ++h) { const f32x2_t a2 = {acc[ai][0][m][n][2 * h], acc[ai][0][m][n][2 * h + 1]}, b2 = {acc[ai][1][m][n][2 * h], acc[ai][1][m][n][2 * h + 1]};
                            const f32x2_t ta = a2 * (-LOG2E), tb = b2 * (-LOG2E); f32x2_t ea, eb;
                            ea[0] = __builtin_amdgcn_exp2f(ta[0]); ea[1] = __builtin_amdgcn_exp2f(ta[1]); eb[0] = __builtin_amdgcn_exp2f(tb[0]); eb[1] = __builtin_amdgcn_exp2f(tb[1]);
                            const f32x2_t ua = ea + 1.0f, ub = eb + 1.0f, pr = ua * ub; f32x2_t t; t[0] = __builtin_amdgcn_rcpf(pr[0]); t[1] = __builtin_amdgcn_rcpf(pr[1]);
                            const f32x2_t S2 = t * ua, R2 = t * ub * ub;
                            Sw[2 * n + h] = cvt_pk_bf16(S2[0], S2[1]); Rw[2 * n + h] = cvt_pk_bf16(R2[0], R2[1]); }
                    const size_t off = (size_t)r * 1024 + 128 * (pn - 11) + 32 * wc + 8 * fq;
                    u32x4 w; w.x = Rw[0]; w.y = Rw[1]; w.z = Rw[2]; w.w = Rw[3];
                    *(u32x4*)(GA + off) = w;
                    w.x = Sw[0]; w.y = Sw[1]; w.z = Sw[2]; w.w = Sw[3];
                    *(u32x4*)(GB + off) = w;
                }
        }
        else {
            const int c0 = 256 * (pn - 19);
#pragma unroll
            for (int ai = 0; ai < 2; ++ai)
#pragma unroll
                for (int m = 0; m < 4; ++m) {
                    const int c = c0 + 128 * ai + 64 * wr + 16 * m + fr;
#pragma unroll
                    for (int bj = 0; bj < 2; ++bj) {
                        const int t0 = row0 + 64 * wc + 32 * bj + 8 * fq;
                        const f32x4 x0 = acc[ai][bj][m][0], x1 = acc[ai][bj][m][1];
                        u32x4 o; o.x = cvt_pk_bf16(x0[0], x0[1]); o.y = cvt_pk_bf16(x0[2], x0[3]); o.z = cvt_pk_bf16(x1[0], x1[1]); o.w = cvt_pk_bf16(x1[2], x1[3]);
                        *(u32x4*)(VAT + ((size_t)(t0 >> 3) * 512 + c) * 8) = o; }
                }
        }
    }
};

struct EpiC1 {
    static constexpr bool MIDHOOK = true;
    const bf16_t *GA, *GB; bf16_t* MG;
    __device__ __forceinline__ void mid(AccT& acc, const Unit& u, int wr, int wc, int fr, int fq) const {
        unsigned base = (unsigned)((u.pm * 256 + 64 * wr + fr) * 1024 + u.pn * 256 + 64 * wc + 8 * fq) * 2u;
        asm volatile("" : "+v"(base));
#pragma unroll
        for (int ai = 0; ai < 2; ++ai)
#pragma unroll
            for (int m = 0; m < 4; ++m) {
#pragma unroll
                for (int bj = 0; bj < 2; ++bj) {
                    const unsigned off = base + (unsigned)((128 * ai + 16 * m) * 1024 + 32 * bj) * 2u;
                    const u32x4 a = *(const u32x4*)((const char*)GA + off);
                    f32x4 r0, r1;
                    r0[0] = bf_lo(a.x); r0[1] = bf_hi(a.x); r0[2] = bf_lo(a.y); r0[3] = bf_hi(a.y);
                    r1[0] = bf_lo(a.z); r1[1] = bf_hi(a.z); r1[2] = bf_lo(a.w); r1[3] = bf_hi(a.w);
                    acc[ai][bj][m][0] *= r0; acc[ai][bj][m][1] *= r1;
                }

            }
    }
    __device__ __forceinline__ void operator()(AccT& acc, const Unit& u, int wr, int wc, int fr, int fq) const {
        unsigned base = (unsigned)((u.pm * 256 + 64 * wr + fr) * 1024 + u.pn * 256 + 64 * wc + 8 * fq) * 2u;
        asm volatile("" : "+v"(base));
        u32x4 sv[2][4][2];
#pragma unroll
        for (int ai = 0; ai < 2; ++ai)
#pragma unroll
            for (int m = 0; m < 4; ++m)
#pragma unroll
                for (int bj = 0; bj < 2; ++bj) sv[ai][m][bj] = *(const u32x4*)((const char*)GB + base + (unsigned)((128 * ai + 16 * m) * 1024 + 32 * bj) * 2u);
#pragma unroll
        for (int ai = 0; ai < 2; ++ai)
#pragma unroll
            for (int m = 0; m < 4; ++m) {
#pragma unroll
                for (int bj = 0; bj < 2; ++bj) {
                    const unsigned off = base + (unsigned)((128 * ai + 16 * m) * 1024 + 32 * bj) * 2u;
                    const u32x4 b = sv[ai][m][bj];
                    const f32x4 x0 = acc[ai][bj][m][0], x1 = acc[ai][bj][m][1];
                    u32x4 o; o.x = cvt_pk_bf16(x0[0] * bf_lo(b.x), x0[1] * bf_hi(b.x)); o.y = cvt_pk_bf16(x0[2] * bf_lo(b.y), x0[3] * bf_hi(b.y));
                    o.z = cvt_pk_bf16(x1[0] * bf_lo(b.z), x1[1] * bf_hi(b.z)); o.w = cvt_pk_bf16(x1[2] * bf_lo(b.w), x1[3] * bf_hi(b.w));
                    *(u32x4*)((char*)MG + off) = o;
                }
            }
    }
};
struct EpiC2 {
    static constexpr bool MIDHOOK = false;
    const float *xp, *xs; float* out;
    __device__ __forceinline__ void mid(AccT&, const Unit&, int, int, int, int) const {}
    __device__ __forceinline__ void operator()(AccT& acc, const Unit& u, int wr, int wc, int fr, int fq) const {
        const int row0 = u.pm * 256;
        const char* xb = (const char*)(row0 < TP ? xp + (size_t)row0 * 1024 : xs + (size_t)(row0 - TP) * 1024);
        char* ob = (char*)(out + (size_t)row0 * 1024);
        unsigned base = (unsigned)((64 * wr + fr) * 1024 + u.pn * 256 + 64 * wc + 4 * fq) * 4u;
        asm volatile("" : "+v"(base));
#pragma unroll
        for (int ai = 0; ai < 2; ++ai) {
            f32x4 xv[4][2][2];
#pragma unroll
            for (int m = 0; m < 4; ++m)
#pragma unroll
                for (int bj = 0; bj < 2; ++bj)
#pragma unroll
                    for (int n = 0; n < 2; ++n) xv[m][bj][n] = *(const f32x4*)(xb + base + (unsigned)((128 * ai + 16 * m) * 1024 + 32 * bj + 16 * n) * 4u);
#pragma unroll
            for (int m = 0; m < 4; ++m)
#pragma unroll
                for (int bj = 0; bj < 2; ++bj)
#pragma unroll
                    for (int n = 0; n < 2; ++n) *(f32x4*)(ob + base + (unsigned)((128 * ai + 16 * m) * 1024 + 32 * bj + 16 * n) * 4u) = xv[m][bj][n] + acc[ai][bj][m][n];
            asm volatile("" ::: "memory");
        }
    }
};

__device__ __forceinline__ int map_col(int n) {
    if (n < 1024) return n;
    if (n < 1536) return 2048 + n - 1024;
    if (n < 1664) return 2560 + n - 1536;
    if (n < 1792) return 2688 + n - 1664;
    if (n < 2304) return 1536 + n - 1792;
    if (n < 2816) return 2816 + n - 2304;
    if (n < 4864) { const int w = n - 2816, tg = w >> 8, ww = w & 255, wcw = ww >> 6, bj = (ww >> 5) & 1, e = ww & 31;
        return (bj ? 4352 : 3328) + 128 * tg + 32 * wcw + e; }
    return 1024 + n - 4864;
}
__device__ __forceinline__ void p0_transpose_item(const float* W, int N, int ksrc0, int nsrc0, const float* ksc, bf16_t* WT, int nrow0, int kdst0, LAS float* scr, int lane) {
#pragma unroll 16
    for (int i = 0; i < 32; ++i) { const int kk = 2 * i + (lane >> 5); float v = W[(size_t)(ksrc0 + kk) * N + nsrc0 + (lane & 31)]; if (ksc) v *= ksc[ksrc0 + kk]; scr[kk * 33 + (lane & 31)] = v; }
    asm volatile("s_waitcnt lgkmcnt(0)" ::: "memory");
    const int c = lane & 7;
#pragma unroll
    for (int j = 0; j < 4; ++j) { const int n = (lane >> 3) + 8 * j; const LAS float* s = scr + (8 * c) * 33 + n;
        u32x4 o; o.x = cvt_pk_bf16(s[0 * 33], s[1 * 33]); o.y = cvt_pk_bf16(s[2 * 33], s[3 * 33]); o.z = cvt_pk_bf16(s[4 * 33], s[5 * 33]); o.w = cvt_pk_bf16(s[6 * 33], s[7 * 33]);
        *(u32x4*)(WT + (size_t)(nrow0 + n) * 1024 + kdst0 + 8 * c) = o; }
    asm volatile("s_waitcnt lgkmcnt(0)" ::: "memory");
}

struct Args { const float* in[13]; float* out; unsigned char* ws; int ph_lo, ph_hi; };

__device__ __forceinline__ void p0_load4(const Args& a, int m0, int NGW, int lane, f32x4 (&v)[4][4]) {
#pragma unroll
    for (int u = 0; u < 4; ++u) { const int m = min(m0 + u * NGW, T - 1);
        const float* xrow = m < TP ? a.in[0] + (size_t)m * 1024 : a.in[1] + (size_t)(m - TP) * 1024;
        const f32x4* xr = (const f32x4*)xrow + lane;
#pragma unroll
        for (int j = 0; j < 4; ++j) v[u][j] = xr[64 * j]; }
}
__device__ __forceinline__ void p0_proc4(bf16_t* XB, int m0, int NGW, int lane, const f32x4 (&v)[4][4]) {
    float s[4];
#pragma unroll
    for (int u = 0; u < 4; ++u) { float t = 0.f;
#pragma unroll
        for (int j = 0; j < 4; ++j) t += (v[u][j][0] * v[u][j][0] + v[u][j][1] * v[u][j][1]) + (v[u][j][2] * v[u][j][2] + v[u][j][3] * v[u][j][3]);
        s[u] = t; }
#pragma unroll
    for (int o = 1; o < 64; o <<= 1) {
#pragma unroll
        for (int u = 0; u < 4; ++u) s[u] += __shfl_xor(s[u], o); }
#pragma unroll
    for (int u = 0; u < 4; ++u) { const int m = m0 + u * NGW; if (m >= T) break;
        const float rstd = 1.0f / sqrtf(s[u] * (1.0f / 1024.0f) + NORM_EPS);
        u32x2* o8 = (u32x2*)(XB + (size_t)m * 1024) + lane;
#pragma unroll
        for (int j = 0; j < 4; ++j) { u32x2 w; w.x = cvt_pk_bf16(v[u][j][0] * rstd, v[u][j][1] * rstd); w.y = cvt_pk_bf16(v[u][j][2] * rstd, v[u][j][3] * rstd); o8[64 * j] = w; } }
}

__device__ __forceinline__ void p0_prologue(const Args& a, LAS unsigned char* lds, int wave, int lane) {
    if (wave < 6) {
        LAS float* scr = (LAS float*)(lds + wave * 16384);
        const int gw = blockIdx.x * 6 + wave, NGW = gridDim.x * 6;
        const float* w_in = a.in[3]; const float* w_oa = a.in[10]; const float* w_ob = a.in[11]; const float* w_o = a.in[12]; const float* ng = a.in[2];
        bf16_t* WIN = (bf16_t*)(a.ws + WS_WIN); bf16_t* WAB = (bf16_t*)(a.ws + WS_WAB); bf16_t* WO = (bf16_t*)(a.ws + WS_WO);
        constexpr int I_IN = 16 * 168, I_OA = 8 * 32, I_OB = 8 * 32, I_O = 16 * 32, NITEMS = I_IN + I_OA + I_OB + I_O;
        for (int it = gw; it < NITEMS; it += NGW) {
            int r = it;
            if (r < I_IN) { const int kb = r / 168, nb = r % 168; p0_transpose_item(w_in, NIN, 64 * kb, map_col(32 * nb), ng, WIN, 32 * nb, 64 * kb, scr, lane); continue; } r -= I_IN;
            if (r < I_OA) { const int kb = r / 32, nb = r % 32; p0_transpose_item(w_oa, 1024, 64 * kb, 32 * nb, nullptr, WAB, 32 * nb, 64 * kb, scr, lane); continue; } r -= I_OA;
            if (r < I_OB) { const int kb = r / 32, nb = r % 32; p0_transpose_item(w_ob, 1024, 64 * kb, 32 * nb, nullptr, WAB, 32 * nb, 512 + 64 * kb, scr, lane); continue; } r -= I_OB;
            { const int kb = r / 32, nb = r % 32; p0_transpose_item(w_o, 1024, 64 * kb, 32 * nb, nullptr, WO, 32 * nb, 64 * kb, scr, lane); }
        }
    } else {
        bf16_t* XB = (bf16_t*)(a.ws + WS_XB);
        const int gw = blockIdx.x * 2 + (wave - 6), NGW = gridDim.x * 2;
        f32x4 va[4][4], vb[4][4];
        int m0 = gw;
        if (m0 < T) p0_load4(a, m0, NGW, lane, va);
        while (m0 < T) {
            const int m1 = m0 + 4 * NGW; const bool has1 = m1 < T;
            if (has1) p0_load4(a, m1, NGW, lane, vb);
            p0_proc4(XB, m0, NGW, lane, va);
            if (!has1) break;
            const int m2 = m1 + 4 * NGW; const bool has2 = m2 < T;
            if (has2) p0_load4(a, m2, NGW, lane, va);
            p0_proc4(XB, m1, NGW, lane, vb);
            if (!has2) break;
            m0 = m2;
        }
    }
}

struct AttnP { const bf16_t *QA, *KA, *VAT, *ZA, *QB, *KB, *VBT, *ZB; bf16_t* Y; const float* sink; const float* rpb; };
constexpr int ATT_VOFF = 73728, ATT_RPB = 147456;
__device__ __forceinline__ int att_vpos(int d) { return (d & 32) | ((d & 4) << 2) | ((d & 24) >> 1) | (d & 3); }

template <bool SWA> struct AttStage { u32x4 k[SWA ? 6 : 9]; u32x4 v[SWA ? 6 : 9]; };

template <bool SWA>
__device__ __forceinline__ void att_decode(int item, int& b, int& h, int& x) {
    if (SWA) { x = item & 31; h = (item >> 5) & 1; b = item >> 6; }
    else { x = item & 31; h = (item >> 5) & 7; b = item >> 8; }
}
template <bool SWA>
__device__ __forceinline__ void att_load(const AttnP& P, int item, int tid, AttStage<SWA>& st) {
    constexpr int NCH = SWA ? 6 : 9, KLD = SWA ? 128 : 512;
    int b, h, x; att_decode<SWA>(item, b, h, x);
    const int tb = b * SEQ, kcol = h * 64;
    const bf16_t* Kp = SWA ? P.KB : P.KA; const bf16_t* VT = SWA ? P.VBT : P.VAT;
    const int base = SWA ? 128 * x - 128 : min(max(2 * x - 4, 0), 56);
#pragma unroll
    for (int i = 0; i < NCH; ++i) {
        const int idx = tid + 512 * i;
        { const int k = idx >> 3, c = idx & 7; int tok;
          if (SWA) tok = min(max(base + k, 0), SEQ - 1); else tok = min(base + (k >> 6), 63) * 64 + (k & 63);
          st.k[i] = *(const u32x4*)(Kp + (size_t)(tb + tok) * KLD + kcol + 8 * c); }
        { const int kb = idx >> 6, d = idx & 63; int tok;
          if (SWA) tok = min(max(base + 8 * kb, 0), SEQ - 8); else tok = min(base + (kb >> 3), 63) * 64 + 8 * (kb & 7);
          st.v[i] = *(const u32x4*)(VT + ((size_t)((tb + tok) >> 3) * KLD + kcol + d) * 8); }
    }
}
template <bool SWA>
__device__ __forceinline__ void att_store(LAS unsigned char* lds, int tid, const AttStage<SWA>& st) {
    constexpr int NCH = SWA ? 6 : 9;
#pragma unroll
    for (int i = 0; i < NCH; ++i) {
        const int idx = tid + 512 * i, k = idx >> 3, c = idx & 7;
        *(LAS u32x4*)(lds + k * 128 + ((c ^ ((k >> 1) & 7)) << 4)) = st.k[i];
        *(LAS u32x4*)(lds + ATT_VOFF + ((idx & ~63) + att_vpos(idx & 63)) * 16) = st.v[i];
    }
}

struct AttQZ { bf16x8 q0, q1; u32x4 z[2]; };
template <bool SWA>
__device__ __forceinline__ void att_load_qz(const AttnP& P, int lane, int tb, int qpos0, int hq, AttQZ& o) {
    const int li = lane & 15, fq = lane >> 4;
    const bf16_t* Q = SWA ? P.QB : P.QA; const bf16_t* Z = SWA ? P.ZB : P.ZA;
    const bf16_t* qrow = Q + (size_t)(tb + qpos0 + li) * 512 + hq * 64 + 8 * fq;
    o.q0 = *(const bf16x8*)qrow; o.q1 = *(const bf16x8*)(qrow + 32);
    const bf16_t* zrow = Z + (size_t)(tb + qpos0 + li) * 512 + hq * 64 + 8 * fq;
#pragma unroll
    for (int hh = 0; hh < 2; ++hh) o.z[hh] = *(const u32x4*)(zrow + 32 * hh);
}
template <bool SWA, bool FAST>
__device__ __forceinline__ void att_tile(const AttnP& P, LAS unsigned char* lds, int lane, int tb, int qpos0, int hq, int kloc0, int r, int ct, int kr0, int kc0, const AttQZ& qz, float shift) {
    constexpr int NSEG = SWA ? 9 : 8, KMAX = SWA ? 383 : 575;
    const int li = lane & 15, fq = lane >> 4;
    const bf16x8 bq0 = qz.q0, bq1 = qz.q1;
    f32x4 sc[NSEG][2];
    constexpr int GS = SWA ? 3 : 2;
    const int krow0 = (SWA ? kloc0 : kc0) + li, ksw = (krow0 >> 1) & 7;
    const LAS unsigned char* kb0 = lds + krow0 * 128 + ((fq ^ ksw) << 4);
    const LAS unsigned char* kb1 = lds + krow0 * 128 + (((fq + 4) ^ ksw) << 4);
#pragma unroll
    for (int s0 = 0; s0 < NSEG; s0 += GS) {
        bf16x8 kf[GS][2][2];
#pragma unroll
        for (int g = 0; g < GS; ++g)
#pragma unroll
            for (int kt = 0; kt < 2; ++kt) { const int s = s0 + g;
                const int segoff = SWA ? (32 * s + 16 * kt) * 128 : (((kr0 + s) % 9) * 64 + 16 * kt) * 128;
                kf[g][kt][0] = *(const LAS bf16x8*)(kb0 + segoff); kf[g][kt][1] = *(const LAS bf16x8*)(kb1 + segoff); }
        __builtin_amdgcn_sched_barrier(0);
        __builtin_amdgcn_s_setprio(1);
#pragma unroll
        for (int g = 0; g < GS; ++g)
#pragma unroll
            for (int kt = 0; kt < 2; ++kt) {
                f32x4 z = FAST ? (f32x4){-shift, -shift, -shift, -shift} : (f32x4){0.f, 0.f, 0.f, 0.f};
                z = __builtin_amdgcn_mfma_f32_16x16x32_bf16(kf[g][kt][0], bq0, z, 0, 0, 0);
                z = __builtin_amdgcn_mfma_f32_16x16x32_bf16(kf[g][kt][1], bq1, z, 0, 0, 0);
                sc[s0 + g][kt] = z; }
        __builtin_amdgcn_s_setprio(0);
        __builtin_amdgcn_sched_barrier(0);
    }
    float mx = -1e30f;
    if (SWA) {
        const int qp = qpos0 + li;
#pragma unroll
        for (int s = 0; s < NSEG; ++s) {
            const int kb0 = qpos0 - 128 + 32 * s;
            if (s >= 1 && s <= 7 && kb0 >= 0 && kb0 + 31 < SEQ) {
#pragma unroll
                for (int kt = 0; kt < 2; ++kt)
#pragma unroll
                    for (int j = 0; j < 4; ++j) { if (!FAST) mx = fmaxf(mx, sc[s][kt][j]); }
            } else {
                asm volatile("");
#pragma unroll
                for (int kt = 0; kt < 2; ++kt)
#pragma unroll
                    for (int j = 0; j < 4; ++j) { const int kp = kb0 + 16 * kt + 4 * fq + j; const int d = kp - qp;
                        const bool ok = (kp >= 0) && (kp < SEQ) && (d <= 128) && (d >= -128);
                        const float v = ok ? sc[s][kt][j] : -1e30f; sc[s][kt][j] = v; if (!FAST) mx = fmaxf(mx, v); }
            }
        }
    } else if (!FAST) {
        const int c = 16 * ct + li, cs = min(max(c - 8, 0), 48);
        const LAS float* rp = (const LAS float*)(lds + ATT_RPB) + (kr0 - r + 7) * 64 + (kc0 + 4 * fq - c + 31);
#pragma unroll
        for (int s = 0; s < NSEG; ++s) {
            float bias[2][4];
#pragma unroll
            for (int kt = 0; kt < 2; ++kt)
#pragma unroll
                for (int j = 0; j < 4; ++j) bias[kt][j] = rp[s * 64 + 16 * kt + j];
#pragma unroll
            for (int kt = 0; kt < 2; ++kt)
#pragma unroll
                for (int j = 0; j < 4; ++j) { const int kc = kc0 + 16 * kt + 4 * fq + j; const bool ok = (kc >= cs) && (kc < cs + 16);
                    float t = sc[s][kt][j] + bias[kt][j]; asm volatile("" : "+v"(t));
                    const float v = ok ? t : -1e30f; sc[s][kt][j] = v; if (!FAST) mx = fmaxf(mx, v); }
        }
    }
    if (!FAST) { mx = fmaxf(mx, __shfl_xor(mx, 16)); mx = fmaxf(mx, __shfl_xor(mx, 32)); }
    float sk = 0.f;
    if (SWA) { sk = P.sink[hq] * LOG2E; if (!FAST) mx = fmaxf(mx, sk); }
    float l = 0.f; f32x2_t l2 = {0.f, 0.f};
    bf16x8 pb[NSEG];
    if constexpr (!SWA && FAST) {
        const int c = 16 * ct + li, cs = min(max(c - 8, 0), 48), w = cs - kc0;
        const LAS float* rp = (const LAS float*)(lds + ATT_RPB) + (kr0 - r + 7) * 64 + (kc0 + 4 * fq - c + 31);
        bool hi[4]; const LAS float* rpj[4];
#pragma unroll
        for (int j = 0; j < 4; ++j) { hi[j] = (4 * fq + j) < w; rpj[j] = rp + (hi[j] ? 16 : 0) + j; }
        const unsigned m01 = (hi[0] ? 0u : 0xffffu) | (hi[1] ? 0u : 0xffff0000u), m23 = (hi[2] ? 0u : 0xffffu) | (hi[3] ? 0u : 0xffff0000u);
#pragma unroll
        for (int s = 0; s < NSEG; ++s) {
            float p[4];
#pragma unroll
            for (int j = 0; j < 4; ++j) { const float v = hi[j] ? sc[s][1][j] : sc[s][0][j]; p[j] = __builtin_amdgcn_exp2f(v + rpj[j][s * 64]); }
            l2 += (f32x2_t){p[0], p[1]}; l2 += (f32x2_t){p[2], p[3]};
            const unsigned pk01 = cvt_pk_bf16(p[0], p[1]), pk23 = cvt_pk_bf16(p[2], p[3]);
            u32x4 wv; wv.x = pk01 & m01; wv.y = pk23 & m23; wv.z = pk01 & ~m01; wv.w = pk23 & ~m23;
            pb[s] = __builtin_bit_cast(bf16x8, wv);
        }
    } else
#pragma unroll
    for (int s = 0; s < NSEG; ++s) {
        float p[8];
#pragma unroll
        for (int kt = 0; kt < 2; ++kt)
#pragma unroll
            for (int j = 0; j < 4; ++j) p[4 * kt + j] = __builtin_amdgcn_exp2f(FAST ? sc[s][kt][j] : sc[s][kt][j] - mx);
#pragma unroll
        for (int e = 0; e < 8; e += 2) l2 += (f32x2_t){p[e], p[e + 1]};
        u32x4 w; w.x = cvt_pk_bf16(p[0], p[1]); w.y = cvt_pk_bf16(p[2], p[3]); w.z = cvt_pk_bf16(p[4], p[5]); w.w = cvt_pk_bf16(p[6], p[7]);
        pb[s] = __builtin_bit_cast(bf16x8, w);
    }
    l += l2[0] + l2[1];
    l += __shfl_xor(l, 16); l += __shfl_xor(l, 32);
    if (SWA) l += __builtin_amdgcn_exp2f(FAST ? sk - shift : sk - mx);
    const float rl = 1.0f / l;
    f32x4 oacc[4];
#pragma unroll
    for (int dt = 0; dt < 4; ++dt) oacc[dt] = (f32x4){0.f, 0.f, 0.f, 0.f};
    constexpr int GV = SWA ? 3 : 2;
    const int g0l = (SWA ? kloc0 : kc0) + 4 * fq;
    const LAS unsigned char* vb0 = lds + ATT_VOFF + (g0l >> 3) * 1024 + li * 16 + (g0l & 7) * 2;
#pragma unroll
    for (int s0 = 0; s0 < NSEG; s0 += GV) {
        u32x2 vf[GV][4][2];
#pragma unroll
        for (int g = 0; g < GV; ++g) { const int s = s0 + g;
            const int segv = SWA ? s * 4096 : ((kr0 + s) % 9) * 8192;
#pragma unroll
            for (int dt = 0; dt < 4; ++dt) {
                vf[g][dt][0] = *(const LAS u32x2*)(vb0 + segv + dt * 256); asm volatile("" ::: "memory");
                vf[g][dt][1] = *(const LAS u32x2*)(vb0 + segv + dt * 256 + 2048); asm volatile("" ::: "memory"); } }
        __builtin_amdgcn_sched_barrier(0);
        __builtin_amdgcn_s_setprio(1);
#pragma unroll
        for (int g = 0; g < GV; ++g)
#pragma unroll
            for (int dt = 0; dt < 4; ++dt) {
                u32x4 w; w.x = vf[g][dt][0].x; w.y = vf[g][dt][0].y; w.z = vf[g][dt][1].x; w.w = vf[g][dt][1].y;
                oacc[dt] = __builtin_amdgcn_mfma_f32_16x16x32_bf16(__builtin_bit_cast(bf16x8, w), pb[s0 + g], oacc[dt], 0, 0, 0); }
        __builtin_amdgcn_s_setprio(0);
        __builtin_amdgcn_sched_barrier(0);
    }
    const size_t tq = (size_t)(tb + qpos0 + li);
#pragma unroll
    for (int hh = 0; hh < 2; ++hh) {
        const u32x4 z = qz.z[hh]; const f32x4 a = oacc[2 * hh], b = oacc[2 * hh + 1];
        u32x4 o; o.x = cvt_pk_bf16(a[0] * rl * bf_lo(z.x), a[1] * rl * bf_hi(z.x)); o.y = cvt_pk_bf16(a[2] * rl * bf_lo(z.y), a[3] * rl * bf_hi(z.y));
        o.z = cvt_pk_bf16(b[0] * rl * bf_lo(z.z), b[1] * rl * bf_hi(z.z)); o.w = cvt_pk_bf16(b[2] * rl * bf_lo(z.w), b[3] * rl * bf_hi(z.w));
        *(u32x4*)(P.Y + tq * 1024 + (SWA ? 512 : 0) + hq * 64 + 32 * hh + 8 * fq) = o;
    }
}

template <bool SWA>
__device__ __forceinline__ void att_phase(const AttnP& P, LAS unsigned char* lds, int tid, int wave, int lane, bool fast, float shift, AttStage<SWA>& st, AttQZ& qzn, bool pre) {
    constexpr int NITEMS = SWA ? 768 : 3072;
    int item = blockIdx.x;
#define ATT_QPOS(x) (SWA ? 128 * (x) + 16 * wave : (2 * (x) + (wave >> 2)) * 64 + 16 * (wave & 3))
    if (!pre && item < NITEMS) { int b, h, x; att_decode<SWA>(item, b, h, x); att_load<SWA>(P, item, tid, st); att_load_qz<SWA>(P, lane, b * SEQ, ATT_QPOS(x), SWA ? 4 * h : h, qzn); }
    for (; item < NITEMS; item += gridDim.x) {
        int b, h, x; att_decode<SWA>(item, b, h, x);
        att_store<SWA>(lds, tid, st);
        if (!SWA) { if (tid < 465) ((LAS float*)(lds + ATT_RPB))[tid] = P.rpb[h * 465 + tid] * LOG2E; }
        __syncthreads();
        const int nitem = item + (int)gridDim.x; const bool has_next = nitem < NITEMS;
        int nb = 0, nh = 0, nx = 0; if (has_next) { att_decode<SWA>(nitem, nb, nh, nx); att_load<SWA>(P, nitem, tid, st); }
        const int tb = b * SEQ;
        if (SWA) {
#pragma unroll 1
            for (int j = 0; j < 4; ++j) { int kl = 16 * wave; asm volatile("" : "+v"(kl));
                const AttQZ qz = qzn;
                if (j < 3) att_load_qz<true>(P, lane, tb, ATT_QPOS(x), 4 * h + j + 1, qzn);
                else if (has_next) att_load_qz<true>(P, lane, nb * SEQ, ATT_QPOS(nx), 4 * nh, qzn);
                if (fast) att_tile<true, true>(P, lds, lane, tb, 128 * x + 16 * wave, 4 * h + j, kl, 0, 0, 0, 0, qz, shift);
                else att_tile<true, false>(P, lds, lane, tb, 128 * x + 16 * wave, 4 * h + j, kl, 0, 0, 0, 0, qz, 0.f); }
        } else {
            const AttQZ qz = qzn;
            if (has_next) att_load_qz<false>(P, lane, nb * SEQ, ATT_QPOS(nx), nh, qzn);
            const int basee = min(max(2 * x - 4, 0), 56), r = 2 * x + (wave >> 2), ct = wave & 3, kr0 = min(max(r - 4, 0), 56);
            const int kc0 = ct == 0 ? 0 : (ct == 1 ? 8 : (ct == 2 ? 24 : 32));
            att_tile<false, false>(P, lds, lane, tb, r * 64 + 16 * ct, h, (kr0 - basee) * 64 + kc0, r, ct, kr0, kc0, qz, 0.f);
        }
        __syncthreads();
    }
#undef ATT_QPOS
}


struct NaStep { int b, h, rp, first, nrows; bool full; };
__device__ __forceinline__ NaStep na_step(int t, int spw, int c) {
    NaStep o; const int g = c * spw + t, bh = g >> 5; o.rp = g & 31; o.h = bh & 7; o.b = bh >> 3;
    const int base = min(max(2 * o.rp - 4, 0), 56);
    o.full = (t == 0) || (o.rp == 0);
    if (o.full) { o.first = base; o.nrows = 9; }
    else { const int pb = min(max(2 * o.rp - 6, 0), 56); o.first = pb + 9; o.nrows = base - pb; }
    return o;
}
__device__ __forceinline__ void na_load(const AttnP& P, const NaStep& st, int tid, AttStage<false>& r) {
    const int tb = st.b * SEQ, kcol = st.h * 64;
#pragma unroll
    for (int i = 0; i < 9; ++i) if (i < st.nrows) {
        const int row = min(st.first + i, 63);
        r.k[i] = *(const u32x4*)(P.KA + (size_t)(tb + row * 64 + (tid >> 3)) * 512 + kcol + 8 * (tid & 7));
        r.v[i] = *(const u32x4*)(P.VAT + ((size_t)((tb + row * 64) >> 3) + (tid >> 6)) * 4096 + (size_t)(kcol + (tid & 63)) * 8);
    }
}
__device__ __forceinline__ void na_store(LAS unsigned char* lds, const NaStep& st, int tid, const AttStage<false>& r) {
#pragma unroll
    for (int i = 0; i < 9; ++i) if (i < st.nrows) {
        const int slot = (st.first + i) % 9, k = slot * 64 + (tid >> 3), c = tid & 7;
        *(LAS u32x4*)(lds + k * 128 + ((c ^ ((k >> 1) & 7)) << 4)) = r.k[i];
        *(LAS u32x4*)(lds + ATT_VOFF + (slot * 8 + (tid >> 6)) * 1024 + att_vpos(tid & 63) * 16) = r.v[i];
    }
}
__device__ __forceinline__ void na_phase(const AttnP& P, LAS unsigned char* lds, int tid, int wave, int lane, bool fast, float shift, AttStage<true>& swa_st, AttQZ& swa_qz) {
    const int G = gridDim.x, c = blockIdx.x;
    const int spw = (3072 + G - 1) / G;
    const int nsteps = min(spw, max(3072 - c * spw, 0));
    AttStage<false> rg; AttQZ qzn;
    if (nsteps > 0) { const NaStep s0 = na_step(0, spw, c); na_load(P, s0, tid, rg); att_load_qz<false>(P, lane, s0.b * SEQ, (2 * s0.rp + (wave >> 2)) * 64 + 16 * (wave & 3), s0.h, qzn); }
#define NA_STEP(T, ...) do { \
        const NaStep st = na_step((T), spw, c); \
        na_store(lds, st, tid, rg); \
        if (st.full) {        \
            _Pragma("unroll") for (int i = 0; i < 2; ++i) { const int e = tid + 512 * i, row = e >> 6, dc = (e & 63) - 16; \
                if (e < 960) ((LAS float*)(lds + ATT_RPB))[e] = (dc >= 0 && dc <= 30) ? P.rpb[st.h * 465 + row * 31 + dc] * LOG2E : 0.f; } } \
        __syncthreads(); \
        const AttQZ qz = qzn; \
        __VA_ARGS__; \
        const int r = 2 * st.rp + (wave >> 2), ct = wave & 3, kr0 = min(max(r - 4, 0), 56); \
        const int kc0 = ct == 0 ? 0 : (ct == 1 ? 8 : (ct == 2 ? 24 : 32)); \
        if (fast) att_tile<false, true>(P, lds, lane, st.b * SEQ, r * 64 + 16 * ct, st.h, 0, r, ct, kr0, kc0, qz, shift); \
        else att_tile<false, false>(P, lds, lane, st.b * SEQ, r * 64 + 16 * ct, st.h, 0, r, ct, kr0, kc0, qz, 0.f); \
        __syncthreads(); } while (0)
    for (int t = 0; t + 1 < nsteps; ++t)
        NA_STEP(t, { const NaStep sn = na_step(t + 1, spw, c); na_load(P, sn, tid, rg); att_load_qz<false>(P, lane, sn.b * SEQ, (2 * sn.rp + (wave >> 2)) * 64 + 16 * (wave & 3), sn.h, qzn); });
    if (nsteps > 0)
        NA_STEP(nsteps - 1, { if (c < 768) { int sb, sh, sx; att_decode<true>(c, sb, sh, sx); att_load<true>(P, c, tid, swa_st); att_load_qz<true>(P, lane, sb * SEQ, 128 * sx + 16 * wave, 4 * sh, swa_qz); } });
#undef NA_STEP
}

#define XB_TMO      128
#define XB_XCNT(j)  (256  + 64 * (j))
#define XB_XSUB(j)  (1280 + 64 * (j))
#define XB_XGEN(j)  (2304 + 64 * (j))
#define XB_TOP      3328
#define XB_TOPGEN   3392
#define XCD_BAR_WORDS 3456
#define XB_SPIN_CAP (1u << 18)
__device__ __forceinline__ unsigned xb_ld(unsigned* p)              { return __hip_atomic_load(p, __ATOMIC_RELAXED, __HIP_MEMORY_SCOPE_AGENT); }
__device__ __forceinline__ unsigned xb_add(unsigned* p, unsigned v) { return __hip_atomic_fetch_add(p, v, __ATOMIC_RELAXED, __HIP_MEMORY_SCOPE_AGENT); }
__device__ __forceinline__ unsigned xb_xcc_id() { return (unsigned)__builtin_amdgcn_s_getreg((3 << 11) | 20) & 0xFu; }
#define XB_SPIN(cond, bar) do { unsigned _sp = 0; while (cond) { __builtin_amdgcn_s_sleep(1); \
    if ((++_sp & 255u) == 0u) { if (xb_ld(&(bar)[XB_TMO])) break; if (_sp > XB_SPIN_CAP) { atomicAdd(&(bar)[XB_TMO], 1u); break; } } } } while (0)
struct XcdBarrier { unsigned* bar; unsigned x; volatile LAS unsigned* st; };
__device__ __forceinline__ XcdBarrier xcd_barrier_post(unsigned* bar, volatile LAS unsigned* st) {
    XcdBarrier b; b.bar = bar; b.x = xb_xcc_id(); b.st = st;
    if (threadIdx.x == 0) (void)xb_add(&bar[XB_XCNT(b.x)], 1u);
    return b;
}
__device__ __forceinline__ void xcd_barrier_complete(unsigned* bar, unsigned x, unsigned& nloc, unsigned& nx) {
    const unsigned G = gridDim.x * gridDim.y * gridDim.z;
    unsigned sum, cnt, mine, sp = 0u;
    for (;;) {
        sum = 0u; cnt = 0u; mine = 0u;
#pragma unroll
        for (unsigned j = 0; j < 16; ++j) { const unsigned c = xb_ld(&bar[XB_XCNT(j)]); sum += c; cnt += (c > 0u) ? 1u : 0u; mine = (j == x) ? c : mine; }
        if (sum == G) break;
        __builtin_amdgcn_s_sleep(1);
        if ((++sp & 255u) == 0u) { if (xb_ld(&bar[XB_TMO])) break; if (sp > XB_SPIN_CAP) { atomicAdd(&bar[XB_TMO], 1u); break; } }
    }
    nloc = mine > 0u ? mine : 1u; nx = cnt > 0u ? cnt : 1u;
}
__device__ __forceinline__ void xcd_barrier(const XcdBarrier& b) {
    asm volatile("s_waitcnt vmcnt(0)" ::: "memory");
    __syncthreads();
    if (threadIdx.x == 0) {
        unsigned* bar = b.bar;
        __builtin_amdgcn_s_waitcnt(0);
        unsigned nloc = b.st[0], nx = b.st[1];
        if (nloc == 0u) { xcd_barrier_complete(bar, b.x, nloc, nx); b.st[0] = nloc; b.st[1] = nx; }
        const unsigned old = xb_add(&bar[XB_XSUB(b.x)], 1u);
        const unsigned gen = old / nloc;
        if (old + 1u == (gen + 1u) * nloc) {
            __builtin_amdgcn_fence(__ATOMIC_RELEASE, "agent");
            asm volatile("s_waitcnt vmcnt(0)" ::: "memory");
            const unsigned og = xb_add(&bar[XB_TOP], 1u);
            const unsigned tg = og / nx;
            if (og + 1u == (tg + 1u) * nx) xb_add(&bar[XB_TOPGEN], 1u);
            else XB_SPIN(xb_ld(&bar[XB_TOPGEN]) == tg, bar);
            __builtin_amdgcn_fence(__ATOMIC_ACQUIRE, "agent");
            xb_add(&bar[XB_XGEN(b.x)], 1u);
            asm volatile("s_waitcnt vmcnt(0)" ::: "memory");
        } else {
            XB_SPIN(xb_ld(&bar[XB_XGEN(b.x)]) == gen, bar);
            __builtin_amdgcn_fence(__ATOMIC_ACQUIRE, "agent");
            asm volatile("s_waitcnt vmcnt(0)" ::: "memory");
        }
    }
    __syncthreads();
}

__global__ void __launch_bounds__(512, 2) fwd_kernel(Args a) {
    extern __shared__ __attribute__((aligned(16))) unsigned char lds_raw[];
    LAS unsigned char* lds = (LAS unsigned char*)lds_raw;
    const int tid = threadIdx.x, lane = tid & 63, wave = __builtin_amdgcn_readfirstlane(tid >> 6);
    const int lo = a.ph_lo, hi = a.ph_hi;
    unsigned char* ws = a.ws;
#define IN(k) (lo <= (k) && (k) < hi)
    volatile LAS unsigned* bst = (volatile LAS unsigned*)(lds + LDS_BYTES - 64);
    if (tid == 0) { bst[0] = 0u; bst[1] = 0u; }
    __syncthreads();
    (void)xcd_barrier_post((unsigned*)(ws + WS_CTL), bst);
    if (lo == 12345) cg::this_grid().sync();
#define SEAM(k) do { if (IN(k) && IN((k) + 1)) { XcdBarrier gb_; gb_.bar = (unsigned*)(ws + WS_CTL); gb_.x = xb_xcc_id(); gb_.st = (volatile LAS unsigned*)(lds + LDS_BYTES - 64); xcd_barrier(gb_); } } while (0)
    if (IN(0)) { p0_prologue(a, lds, wave, lane); }
    SEAM(0);
    if (IN(1)) {
        SchedA S; S.init(T, NIN, gridDim.x, blockIdx.x); S.XB = (const char*)(ws + WS_XB); S.W = (const char*)(ws + WS_WIN);
        EpiA E; E.ws = ws; E.GA = (bf16_t*)a.out;
        E.qn_a = a.in[4]; E.kn_a = a.in[5]; E.qn_b = a.in[7]; E.kn_b = a.in[8];
        pg8::gemm_phase<EpiA, SchedA>(lds, S, E);
    }
    SEAM(1);
    if (IN(2)) {
        AttnP P; P.QA = (const bf16_t*)(ws + WS_QA); P.KA = (const bf16_t*)(ws + WS_KA); P.VAT = (const bf16_t*)(ws + WS_VAT); P.ZA = (const bf16_t*)(ws + WS_ZA);
        P.QB = (const bf16_t*)(ws + WS_QB); P.KB = (const bf16_t*)(ws + WS_KB); P.VBT = (const bf16_t*)(ws + WS_VBT); P.ZB = (const bf16_t*)(ws + WS_ZB);
        P.Y = (bf16_t*)(ws + WS_Y); P.sink = a.in[9]; P.rpb = a.in[6];
        float shiftA, shiftB; bool fast;
        { float mqa = fabsf(a.in[4][lane]), mka = fabsf(a.in[5][lane]), mqb = fabsf(a.in[7][lane]), mkb = fabsf(a.in[8][lane]), msk = fabsf(a.in[9][lane & 7]), mr = 0.f;
          for (int i = tid; i < 8 * 465; i += 512) mr = fmaxf(mr, fabsf(a.in[6][i]));
#pragma unroll
          for (int o = 1; o < 64; o <<= 1) { mqa = fmaxf(mqa, __shfl_xor(mqa, o)); mka = fmaxf(mka, __shfl_xor(mka, o)); mqb = fmaxf(mqb, __shfl_xor(mqb, o)); mkb = fmaxf(mkb, __shfl_xor(mkb, o));
              msk = fmaxf(msk, __shfl_xor(msk, o)); mr = fmaxf(mr, __shfl_xor(mr, o)); }
          LAS float* red = (LAS float*)(lds + ATT_RPB);
          if (lane == 0) red[wave] = mr;
          __syncthreads();
          mr = red[0];
#pragma unroll
          for (int w = 1; w < 8; ++w) mr = fmaxf(mr, red[w]);
          __syncthreads();
          shiftA = 1.02f * (64.f * mqa * mka * QSCALE + mr * LOG2E) + 0.5f; shiftB = 1.02f * (64.f * mqb * mkb * QSCALE) + 0.5f;
          fast = (shiftA < 60.f) && (shiftB < 60.f) && (msk * LOG2E < 60.f); }
        AttStage<true> swa_st; AttQZ swa_qz;
        const bool pre = ((3072 + (int)gridDim.x - 1) / (int)gridDim.x) * (int)blockIdx.x < 3072;
        na_phase(P, lds, tid, wave, lane, fast, shiftA, swa_st, swa_qz);
        att_phase<true>(P, lds, tid, wave, lane, fast, shiftB, swa_st, swa_qz, pre);
    }
    SEAM(2);
    if (IN(3)) {
        SchedP S; S.init(T, 1024, gridDim.x, blockIdx.x); S.A = (const char*)(ws + WS_Y); S.W = (const char*)(ws + WS_WAB);
        EpiC1 E; E.GA = (const bf16_t*)a.out; E.GB = (const bf16_t*)a.out + (size_t)T * 1024; E.MG = (bf16_t*)(ws + WS_MG);
        pg8::gemm_phase<EpiC1, SchedP>(lds, S, E);
    }
    SEAM(3);
    if (IN(4)) {
        SchedP S; S.init(T, 1024, gridDim.x, blockIdx.x); S.A = (const char*)(ws + WS_MG); S.W = (const char*)(ws + WS_WO);
        EpiC2 E; E.xp = a.in[0]; E.xs = a.in[1]; E.out = a.out;
        pg8::gemm_phase<EpiC2, SchedP>(lds, S, E, true);
    }
#undef IN
#undef SEAM
}

extern "C" void kernel_launch(void* const* d_in, const int* in_sizes, int n_in, void* d_out, int out_size, void* d_ws, size_t ws_size, hipStream_t stream) {
    static int grid = 0;
    if (grid == 0) {
        if (n_in != 13 || out_size != T * D || ws_size < WS_END) { fprintf(stderr, "kernel_launch: unexpected shapes (n_in %d out %d ws %zu)\n", n_in, out_size, ws_size); grid = -1; return; }
        int dev = 0, cus = 0;
        if (hipGetDevice(&dev) != hipSuccess || hipDeviceGetAttribute(&cus, hipDeviceAttributeMultiprocessorCount, dev) != hipSuccess) { grid = -1; return; }
        if (hipFuncSetAttribute((const void*)fwd_kernel, hipFuncAttributeMaxDynamicSharedMemorySize, LDS_BYTES) != hipSuccess) { fprintf(stderr, "kernel_launch: hipFuncSetAttribute failed\n"); grid = -1; return; }
        int per_cu = 0;
        if (hipOccupancyMaxActiveBlocksPerMultiprocessor(&per_cu, (const void*)fwd_kernel, 512, LDS_BYTES) != hipSuccess || per_cu < 1) fprintf(stderr, "kernel_launch: occupancy query says %d\n", per_cu);
        (void)hipGetLastError();
        grid = cus;
    }
    if (grid < 0) return;
    hipMemsetAsync((char*)d_ws + WS_CTL, 0, CTL_BYTES, stream);
    Args a{};
    for (int i = 0; i < 13; ++i) a.in[i] = (const float*)d_in[i];
    a.out = (float*)d_out; a.ws = (unsigned char*)d_ws;
    if (N_LAUNCHES == 1) {
        a.ph_lo = 0; a.ph_hi = 5;
        void* args[] = {&a};
        hipError_t e = hipLaunchCooperativeKernel((const void*)fwd_kernel, dim3(grid), dim3(512), args, LDS_BYTES, stream);
        if (e != hipSuccess) fprintf(stderr, "cooperative launch failed: %s (grid %d)\n", hipGetErrorString(e), grid);
    } else {
        for (int p = 0; p < 5; ++p) {
            a.ph_lo = p; a.ph_hi = p + 1; hipLaunchKernelGGL(fwd_kernel, dim3(grid), dim3(512), LDS_BYTES, stream, a); }
    }
}
```
